# Optimizing an MI355X kernel written in HIP

```python
import math
import jax, jax.numpy as jnp
from jax import lax
import numpy as np

D_MODEL = 1024
BATCH = 2
SEQ = 8192
DEPTH = 4

CHUNK = 64
Q_BLOCK = 128
HEAD_DIM = 64
A_HEADS = 4
A_V = 2 * HEAD_DIM
A_WIDTH = A_HEADS * A_V
B_GROUPS = 4
B_GROUP_DIM = 64
B_WIDTH = B_GROUPS * B_GROUP_DIM
POOL_WINDOWS = (2, 4, 8, 16)
C_HEADS = 4
C_WIDTH = C_HEADS * HEAD_DIM
C_LEFT_CHUNKS = 8
C_BAND = (C_LEFT_CHUNKS + 1) * CHUNK
REL_CLIP = 256
MIX_WIDTH = A_WIDTH + B_WIDTH + C_WIDTH
IN_SPLITS = (A_WIDTH, 2 * A_WIDTH, 3 * A_WIDTH, 3 * A_WIDTH + B_WIDTH,
             3 * A_WIDTH + B_WIDTH + C_WIDTH, 3 * A_WIDTH + B_WIDTH + 2 * C_WIDTH)
IN_WIDTH = 3 * A_WIDTH + B_WIDTH + 3 * C_WIDTH
D_FF = 2816
CONV_WIDTH = 3
EPS = 1e-5
NEG = -1e30

kernel_name = "hybrid_diffattn_pool_chunkattn_convffn"


def rms_norm(x, g):
    xf = x.astype(jnp.float32)
    y = xf * lax.rsqrt(jnp.mean(xf * xf, axis=-1, keepdims=True) + EPS)
    return (y * g.astype(jnp.float32)).astype(x.dtype)


def diff_attention(q, k, v, lam, subln_g, lam_init):
    bsz, s_len, h = q.shape[:3]
    nb = s_len // Q_BLOCK
    q = q * (HEAD_DIM ** -0.5)
    qb = q.reshape(bsz, nb, Q_BLOCK, h, 2, HEAD_DIM).transpose(1, 0, 2, 3, 4, 5)
    k_chunk = jnp.arange(s_len) // CHUNK

    def block(args):
        q_i, i = args
        s = jnp.einsum('bqhmd,bkhmd->bhmqk', q_i, k).astype(jnp.float32)
        q_chunk = (i * Q_BLOCK + jnp.arange(Q_BLOCK)) // CHUNK
        mask = k_chunk[None, :] <= q_chunk[:, None]
        p = jax.nn.softmax(jnp.where(mask, s, NEG), axis=-1)
        a = p[:, :, 0] - lam * p[:, :, 1]
        return jnp.einsum('bhqk,bkhe->bqhe', a.astype(v.dtype), v)

    o = lax.map(block, (qb, jnp.arange(nb)))
    o = o.transpose(1, 0, 2, 3, 4).reshape(bsz, s_len, h, A_V)
    o = rms_norm(o, subln_g) * (1.0 - lam_init)
    return o.reshape(bsz, s_len, A_WIDTH)


def pool_mixer(u, pool_w, pool_scale):
    bsz, s_len, _ = u.shape
    uf = u.astype(jnp.float32).reshape(bsz, s_len, B_GROUPS, B_GROUP_DIM)
    cs = jnp.cumsum(uf, axis=1)
    t = jnp.arange(1, s_len + 1, dtype=jnp.float32)
    outs = []
    for g, w in enumerate(POOL_WINDOWS):
        c = cs[:, :, g]
        lagged = jnp.pad(c, ((0, 0), (w, 0), (0, 0)))[:, :s_len]
        cnt = jnp.minimum(t, float(w))[None, :, None]
        outs.append((c - lagged) / cnt - uf[:, :, g])
    d = jnp.stack(outs, axis=2)
    y = jnp.einsum('bsgc,gcd->bsgd', d, pool_w.astype(jnp.float32))
    y = y.reshape(bsz, s_len, B_WIDTH) * pool_scale.astype(jnp.float32)
    return y.astype(u.dtype)


def chunk_band_attention(q, k, v, rel_bias):
    bsz, s_len, h, d = q.shape
    nc = s_len // CHUNK
    qc = (q * (d ** -0.5)).reshape(bsz, nc, CHUNK, h, d)
    pad = ((0, 0), (C_LEFT_CHUNKS, 0), (0, 0), (0, 0), (0, 0))
    kp = jnp.pad(k.reshape(bsz, nc, CHUNK, h, d), pad)
    vp = jnp.pad(v.reshape(bsz, nc, CHUNK, h, d), pad)
    kb = jnp.concatenate([kp[:, j:j + nc] for j in range(C_LEFT_CHUNKS + 1)], axis=2)
    vb = jnp.concatenate([vp[:, j:j + nc] for j in range(C_LEFT_CHUNKS + 1)], axis=2)
    s = jnp.einsum('bcqhd,bckhd->bhcqk', qc, kb).astype(jnp.float32)
    slot = jnp.arange(C_BAND)
    rel = jnp.arange(CHUNK)[:, None] - (slot - C_LEFT_CHUNKS * CHUNK)[None, :]
    idx = jnp.clip(rel, -REL_CLIP, REL_CLIP) + REL_CLIP
    bias = rel_bias.astype(jnp.float32)[:, idx]
    valid = (jnp.arange(nc)[:, None] + slot[None, :] // CHUNK - C_LEFT_CHUNKS) >= 0
    s = jnp.where(valid[None, None, :, None, :], s + bias[None, :, None], NEG)
    p = jax.nn.softmax(s, axis=-1)
    o = jnp.einsum('bhcqk,bckhd->bcqhd', p.astype(v.dtype), vb)
    return o.reshape(bsz, s_len, C_WIDTH)


def conv_gated_ffn(h, w_up, conv_w, conv_b, w_down):
    s_len = h.shape[1]
    a, g = jnp.split(h @ w_up, 2, axis=-1)
    ap = jnp.pad(a, ((0, 0), (CONV_WIDTH - 1, 0), (0, 0)))
    a = conv_b + conv_w[0] * ap[:, 0:s_len]
    for j in range(1, CONV_WIDTH):
        a = a + conv_w[j] * ap[:, j:j + s_len]
    return (jax.nn.silu(a) * g) @ w_down


def setup_inputs(seed: int = 0) -> dict:
    key = jax.random.key(seed)
    ks = jax.random.split(key, 20)
    n = jax.random.normal
    f32 = jnp.float32
    return {
        "x": n(ks[0], (BATCH, SEQ, D_MODEL), f32),
        "attn_norm": 1.0 + 0.02 * n(ks[1], (DEPTH, D_MODEL), f32),
        "w_in": n(ks[2], (DEPTH, D_MODEL, IN_WIDTH), f32) * D_MODEL ** -0.5,
        "lam_q1": 0.1 * n(ks[3], (DEPTH, HEAD_DIM), f32),
        "lam_k1": 0.1 * n(ks[4], (DEPTH, HEAD_DIM), f32),
        "lam_q2": 0.1 * n(ks[5], (DEPTH, HEAD_DIM), f32),
        "lam_k2": 0.1 * n(ks[6], (DEPTH, HEAD_DIM), f32),
        "diff_subln": 1.0 + 0.02 * n(ks[7], (DEPTH, A_V), f32),
        "pool_w": n(ks[8], (DEPTH, B_GROUPS, B_GROUP_DIM, B_GROUP_DIM), f32) * B_GROUP_DIM ** -0.5,
        "pool_scale": 1.0 + 0.02 * n(ks[9], (DEPTH, B_WIDTH), f32),
        "rel_bias": 0.1 * n(ks[10], (DEPTH, C_HEADS, 2 * REL_CLIP + 1), f32),
        "w_out": n(ks[11], (DEPTH, MIX_WIDTH, D_MODEL), f32) * MIX_WIDTH ** -0.5,
        "ffn_norm": 1.0 + 0.02 * n(ks[12], (DEPTH, D_MODEL), f32),
        "w_up": n(ks[13], (DEPTH, D_MODEL, 2 * D_FF), f32) * D_MODEL ** -0.5,
        "conv_w": n(ks[14], (DEPTH, CONV_WIDTH, D_FF), f32) * CONV_WIDTH ** -0.5,
        "conv_b": 0.01 * n(ks[15], (DEPTH, D_FF), f32),
        "w_down": n(ks[16], (DEPTH, D_FF, D_MODEL), f32) * D_FF ** -0.5,
        "final_norm": 1.0 + 0.02 * n(ks[17], (D_MODEL,), f32),
    }


def reference(x, attn_norm, w_in, lam_q1, lam_k1, lam_q2, lam_k2, diff_subln, pool_w, pool_scale,
              rel_bias, w_out, ffn_norm, w_up, conv_w, conv_b, w_down, final_norm):
    bsz, s_len, _ = x.shape
    for l in range(DEPTH):
        h = rms_norm(x, attn_norm[l])
        proj = h @ w_in[l]
        qa, ka, va, ub, qc, kc, vc = jnp.split(proj, IN_SPLITS, axis=-1)
        lam_init = 0.8 - 0.6 * math.exp(-0.3 * l)
        lam = (jnp.exp(jnp.sum(lam_q1[l].astype(jnp.float32) * lam_k1[l].astype(jnp.float32)))
               - jnp.exp(jnp.sum(lam_q2[l].astype(jnp.float32) * lam_k2[l].astype(jnp.float32)))
               + lam_init)
        out_a = diff_attention(qa.reshape(bsz, s_len, A_HEADS, 2, HEAD_DIM),
                               ka.reshape(bsz, s_len, A_HEADS, 2, HEAD_DIM),
                               va.reshape(bsz, s_len, A_HEADS, A_V),
                               lam, diff_subln[l], lam_init)
        out_b = pool_mixer(ub, pool_w[l], pool_scale[l])
        out_c = chunk_band_attention(qc.reshape(bsz, s_len, C_HEADS, HEAD_DIM),
                                     kc.reshape(bsz, s_len, C_HEADS, HEAD_DIM),
                                     vc.reshape(bsz, s_len, C_HEADS, HEAD_DIM),
                                     rel_bias[l])
        mix = jnp.concatenate([out_a, out_b, out_c], axis=-1)
        x = x + mix @ w_out[l]
        x = x + conv_gated_ffn(rms_norm(x, ffn_norm[l]), w_up[l], conv_w[l], conv_b[l], w_down[l])
    return rms_norm(x, final_norm)
```

```cpp
#include <hip/hip_runtime.h>
#include <hip/hip_cooperative_groups.h>
#include <cstdint>
#include <cstdio>
#include <cmath>
namespace cg = cooperative_groups;

constexpr int BATCH = 2, SEQ = 8192, DM = 1024, DEPTH = 4, M = BATCH * SEQ;
constexpr int INW = 2560, DFF = 2816, UPW = 2 * DFF;
constexpr float EPS = 1e-5f;
constexpr float LOG2E = 1.4426950408889634f;
constexpr float C2 = 0.125f * LOG2E;
constexpr int COL_KA = 512, COL_VA = 1024, COL_UB = 1536, COL_QC = 1792, COL_KC = 2048, COL_VC = 2304;

typedef unsigned short bf16_t;
typedef unsigned u32x4 __attribute__((ext_vector_type(4)));
typedef unsigned u32x2 __attribute__((ext_vector_type(2)));
typedef float f32x4 __attribute__((ext_vector_type(4)));
typedef float f32x2_t __attribute__((ext_vector_type(2)));
typedef __bf16 bf16x2_t __attribute__((ext_vector_type(2)));

constexpr size_t MiB = 1u << 20;
constexpr size_t WS_ROWSS = 304 * MiB;
constexpr size_t WS_W = 2 * MiB;
constexpr size_t W_LAYER = 23 * MiB + 512 * 1024, W_IN = 0, W_OUT = 5 * MiB, W_UP = 7 * MiB, W_DOWN = 18 * MiB;
constexpr size_t WS_XG = 96 * MiB;
constexpr size_t WS_PROJ = 128 * MiB;
constexpr size_t WS_AO = WS_PROJ + 80 * MiB;
constexpr size_t WS_MIX = WS_AO + 32 * MiB;
constexpr size_t WS_ACT = 128 * MiB;
constexpr size_t WS_HEADA = 272 * MiB, WS_HEADG = 278 * MiB, WS_HALO = 284 * MiB;
constexpr size_t WS_END = WS_ROWSS + 9 * MiB;
constexpr int RSS = M * 16;

__device__ __forceinline__ unsigned cvtpk(float lo, float hi) { f32x2_t v = {lo, hi}; bf16x2_t b = __builtin_convertvector(v, bf16x2_t); return __builtin_bit_cast(unsigned, b); }
__device__ __forceinline__ float bflo(unsigned w) { return __uint_as_float(w << 16); }
__device__ __forceinline__ float bfhi(unsigned w) { return __uint_as_float(w & 0xffff0000u); }
__device__ __forceinline__ float bf1(bf16_t v) { return __uint_as_float(((unsigned)v) << 16); }
__device__ __forceinline__ float wave_sum(float v) {
#pragma unroll
    for (int o = 1; o < 64; o <<= 1) v += __shfl_xor(v, o);
    return v;
}

__device__ __forceinline__ float row_rs(const float* rowss, int row) {
    const f32x4* p = (const f32x4*)(rowss + (size_t)row * 16); const f32x4 a = p[0], b = p[1], c = p[2], d = p[3];
    const float s = ((a.x + a.y) + (a.z + a.w)) + ((b.x + b.y) + (b.z + b.w)) + ((c.x + c.y) + (c.z + c.w)) + ((d.x + d.y) + (d.z + d.w));
    return rsqrtf(s * (1.0f / DM) + EPS);
}
struct Args {
    const float* in[18];
    float* out; unsigned char* ws;
    float lam_init[4];
    int ph_lo, ph_hi;
};
constexpr int PH_FINAL = 1 + 10 * DEPTH;

__device__ __forceinline__ void norm0_phase(const float* x, bf16_t* XH, float* rowss, int gw, int NGW, int lane) {
    for (int m = gw; m < M; m += NGW) {
        const f32x4* xr = (const f32x4*)(x + (size_t)m * DM) + lane;
        f32x4 v[4]; float s = 0.f;
#pragma unroll
        for (int j = 0; j < 4; ++j) { v[j] = xr[64 * j]; s += (v[j].x * v[j].x + v[j].y * v[j].y) + (v[j].z * v[j].z + v[j].w * v[j].w); }
        s = wave_sum(s);
        if (lane < 16) rowss[(size_t)m * 16 + lane] = (lane == 0) ? s : 0.f;
#pragma unroll
        for (int j = 0; j < 4; ++j) { u32x2 w; w.x = cvtpk(v[j].x, v[j].y); w.y = cvtpk(v[j].z, v[j].w); *(u32x2*)(XH + (size_t)m * DM + (64 * j + lane) * 4) = w; }
    }
}
__device__ __forceinline__ void combine_phase(const Args& a, int l, const bf16_t* __restrict__ AO, bf16_t* __restrict__ MIX, int gw, int NGW, int lane) {
    const float s1 = wave_sum(a.in[3][l * 64 + lane] * a.in[4][l * 64 + lane]);
    const float s2 = wave_sum(a.in[5][l * 64 + lane] * a.in[6][l * 64 + lane]);
    const float li = a.lam_init[l];
    const float lam = expf(s1) - expf(s2) + li;
    const float sc = 1.0f - li;
    const int h = lane >> 4, j0 = (lane & 15) * 8;
    float g[8];
#pragma unroll
    for (int j = 0; j < 8; ++j) g[j] = a.in[7][l * 128 + j0 + j] * sc;
    for (int t = gw; t < M; t += 2 * NGW) {
        const int t2 = t + NGW; const bool two = t2 < M;
        const bf16_t* p = AO + (size_t)t * 1024 + h * 256 + j0; const bf16_t* q = AO + (size_t)(two ? t2 : t) * 1024 + h * 256 + j0;
        const u32x4 a1 = *(const u32x4*)p, a2 = *(const u32x4*)(p + 128), b1 = *(const u32x4*)q, b2 = *(const u32x4*)(q + 128);
        float da[8], db[8]; float sa = 0.f, sb = 0.f;
#pragma unroll
        for (int c = 0; c < 4; ++c) { da[2 * c] = bflo(a1[c]) - lam * bflo(a2[c]); da[2 * c + 1] = bfhi(a1[c]) - lam * bfhi(a2[c]); db[2 * c] = bflo(b1[c]) - lam * bflo(b2[c]); db[2 * c + 1] = bfhi(b1[c]) - lam * bfhi(b2[c]);
            sa += da[2 * c] * da[2 * c] + da[2 * c + 1] * da[2 * c + 1]; sb += db[2 * c] * db[2 * c] + db[2 * c + 1] * db[2 * c + 1]; }
#pragma unroll
        for (int o = 1; o < 16; o <<= 1) { sa += __shfl_xor(sa, o); sb += __shfl_xor(sb, o); }
        const float ra = rsqrtf(sa * (1.0f / 128.0f) + EPS), rb = rsqrtf(sb * (1.0f / 128.0f) + EPS);
        u32x4 oa, ob;
#pragma unroll
        for (int c = 0; c < 4; ++c) { oa[c] = cvtpk(da[2 * c] * ra * g[2 * c], da[2 * c + 1] * ra * g[2 * c + 1]); ob[c] = cvtpk(db[2 * c] * rb * g[2 * c], db[2 * c + 1] * rb * g[2 * c + 1]); }
        *(u32x4*)(MIX + (size_t)t * 1024 + h * 128 + j0) = oa;
        if (two) *(u32x4*)(MIX + (size_t)t2 * 1024 + h * 128 + j0) = ob;
    }
}
__device__ __forceinline__ void pool_phase(const Args& a, int l, const bf16_t* PROJ, bf16_t* MIX, float* lds, int blk, int G, int tid) {
    typedef short bf16x8_t __attribute__((ext_vector_type(8)));
    constexpr int DS = 260;
    float* U = lds; float* Dd = lds + 31 * 256;
    const float* pw = a.in[8] + (size_t)l * 4 * 64 * 64; const float* ps = a.in[9] + l * 256;
    const int lane = tid & 63, wv = tid >> 6, g = wv & 3, nb0 = (wv >> 2) * 2, col = lane & 15, quad = lane >> 4;
    bf16x8_t bfr[2][2];
#pragma unroll
    for (int nb = 0; nb < 2; ++nb) { const int dd = (nb0 + nb) * 16 + col; const float sc = ps[g * 64 + dd];
#pragma unroll
        for (int ks = 0; ks < 2; ++ks) { u32x4 w;
#pragma unroll
            for (int q = 0; q < 4; ++q) { const int c = ks * 32 + quad * 8 + 2 * q; w[q] = cvtpk(pw[(g * 64 + c) * 64 + dd] * sc, pw[(g * 64 + c + 1) * 64 + dd] * sc); }
            bfr[nb][ks] = __builtin_bit_cast(bf16x8_t, w); } }
    u32x4 st0, st1;
#define POOL_FETCH(unit_) do { const int t0_ = (unit_) * 16, b_ = t0_ / SEQ, s0_ = t0_ % SEQ; \
        { const int r = tid >> 5, c8 = tid & 31, srow = s0_ - 15 + r; st0 = (u32x4){0u, 0u, 0u, 0u}; if (srow >= 0) st0 = *(const u32x4*)(PROJ + (size_t)(b_ * SEQ + srow) * INW + COL_UB + c8 * 8); } \
        { const int i2 = tid + 512, r = i2 >> 5, c8 = i2 & 31, srow = s0_ - 15 + r; st1 = (u32x4){0u, 0u, 0u, 0u}; if (i2 < 31 * 32 && srow >= 0) st1 = *(const u32x4*)(PROJ + (size_t)(b_ * SEQ + srow) * INW + COL_UB + c8 * 8); } } while (0)
    if (blk < M / 16) POOL_FETCH(blk);
    for (int unit = blk; unit < M / 16; unit += G) {
        const int t0 = unit * 16, s0 = t0 % SEQ;
        { f32x4* d = (f32x4*)(U + (tid >> 5) * 256 + (tid & 31) * 8);
          d[0] = (f32x4){bflo(st0.x), bfhi(st0.x), bflo(st0.y), bfhi(st0.y)}; d[1] = (f32x4){bflo(st0.z), bfhi(st0.z), bflo(st0.w), bfhi(st0.w)};
          const int i2 = tid + 512; if (i2 < 31 * 32) { f32x4* d2 = (f32x4*)(U + (i2 >> 5) * 256 + (i2 & 31) * 8);
              d2[0] = (f32x4){bflo(st1.x), bfhi(st1.x), bflo(st1.y), bfhi(st1.y)}; d2[1] = (f32x4){bflo(st1.z), bfhi(st1.z), bflo(st1.w), bfhi(st1.w)}; } }
        __syncthreads();
        if (unit + G < M / 16) POOL_FETCH(unit + G);
        { const int ch = tid & 255, tt0 = (tid >> 8) * 8, gg = ch >> 6, w = 2 << gg;
          float sum = 0.f;
          for (int j = 0; j < w; ++j) sum += U[(15 + tt0 - j) * 256 + ch];
#pragma unroll
          for (int i = 0; i < 8; ++i) { const int tt = tt0 + i, s = s0 + tt; const int cnt = (s + 1 < w) ? s + 1 : w;
              const float cur = U[(15 + tt) * 256 + ch];
              Dd[tt * DS + ch] = sum / (float)cnt - cur;
              if (i < 7) sum += U[(16 + tt) * 256 + ch] - U[(16 + tt - w) * 256 + ch]; } }
        __syncthreads();
        { f32x4 acc[2]; acc[0] = (f32x4){0.f, 0.f, 0.f, 0.f}; acc[1] = acc[0];
#pragma unroll
          for (int ks = 0; ks < 2; ++ks) {
              const f32x4* dp = (const f32x4*)(Dd + col * DS + g * 64 + ks * 32 + quad * 8); const f32x4 d0 = dp[0], d1 = dp[1];
              u32x4 w; w.x = cvtpk(d0.x, d0.y); w.y = cvtpk(d0.z, d0.w); w.z = cvtpk(d1.x, d1.y); w.w = cvtpk(d1.z, d1.w);
              const bf16x8_t af = __builtin_bit_cast(bf16x8_t, w);
              acc[0] = __builtin_amdgcn_mfma_f32_16x16x32_bf16(af, bfr[0][ks], acc[0], 0, 0, 0);
              acc[1] = __builtin_amdgcn_mfma_f32_16x16x32_bf16(af, bfr[1][ks], acc[1], 0, 0, 0); }
#pragma unroll
          for (int nb = 0; nb < 2; ++nb)
#pragma unroll
              for (int jj = 0; jj < 4; ++jj) MIX[(size_t)(t0 + quad * 4 + jj) * 1024 + 512 + g * 64 + (nb0 + nb) * 16 + col] = (bf16_t)(cvtpk(acc[nb][jj], 0.f) & 0xffffu); }
        __syncthreads();
    }
#undef POOL_FETCH
}
__device__ __forceinline__ void final_phase(float* out, const bf16_t* XH, const float* rowss, const float* g, int gw, int NGW, int lane) {
    for (int m = gw; m < M; m += NGW) {
        const float r = row_rs(rowss, m);
        f32x4* orow = (f32x4*)(out + (size_t)m * DM) + lane;
#pragma unroll
        for (int j = 0; j < 4; ++j) { const f32x4 gg = ((const f32x4*)g)[64 * j + lane]; const u32x2 h = *(const u32x2*)(XH + (size_t)m * DM + (64 * j + lane) * 4);
            const f32x4 v = {bflo(h.x), bfhi(h.x), bflo(h.y), bfhi(h.y)}; orow[64 * j] = v * r * gg; }
    }
}

namespace pg8 {
#define PG8_LAS __attribute__((address_space(3)))
typedef unsigned short bf16_t;
typedef short bf16x8 __attribute__((ext_vector_type(8)));
typedef float f32x4 __attribute__((ext_vector_type(4)));
typedef unsigned u32x4 __attribute__((ext_vector_type(4)));
constexpr int BM = 256, BK = 64, HALF = 128, HTB = HALF * BK * 2  , STAGE_BYTES = 8 * HTB, NXCD = 8, WGM = 8;

__host__ __device__ __forceinline__ int lds_byte(int r, int c) { const int st = (r >> 4) * 2 + (c >> 5), rr = r & 15, cc = c & 31, ob = rr * 64 + cc * 2; return st * 1024 + (ob ^ (((ob >> 9) & 1) << 5)); }
__host__ __device__ __forceinline__ void stage_rc(int b, int& R, int& C) { const int st = b / 1024, sb = b % 1024, swz = sb ^ (((sb >> 9) & 1) << 5); R = (st >> 1) * 16 + swz / 64; C = (st & 1) * 32 + (swz % 64) / 2; }
__host__ __device__ __forceinline__ int lds_byte2(int r, int ch) { return (r >> 3) * 1024 + (r & 7) * 128 + ((ch ^ ((r >> 1) & 7)) * 16); }
__host__ __device__ __forceinline__ void stage_rc2(int b, int& R, int& C) { const int p = b / 1024, l = (b % 1024) / 16; R = p * 8 + (l >> 3); C = ((l & 7) ^ ((R >> 1) & 7)) * 8; }
__host__ __device__ __forceinline__ int perm32(int rho) { const int n = rho >> 4, i = rho & 15; return 8 * (i >> 2) + 4 * n + (i & 3); }

struct Unit { int pm, pn; };
struct Gemm { const bf16_t* A; const bf16_t* Bt; int M, N, K, lda; };

struct StaticOrder {
    int nM, nN, nwg, G, c;
    __host__ __device__ void init(int M, int N, int G_, int c_) { nM = M / BM; nN = N / BM; nwg = nM * nN; G = G_; c = c_; }
    __host__ __device__ bool next(int i, Unit& u) const {
        const long L = (long)i * G + c; if (L >= nwg) return false;
        int wgid = (int)L; { const int q = nwg / NXCD, r = nwg % NXCD, xcd = wgid % NXCD, off = wgid / NXCD; wgid = (xcd < r ? xcd * (q + 1) : r * (q + 1) + (xcd - r) * q) + off; }
        const int nig = WGM * nN, gid = wgid / nig, fm = gid * WGM, gsz = (nM - fm) < WGM ? (nM - fm) : WGM;
        u.pm = fm + ((wgid % nig) % gsz); u.pn = (wgid % nig) / gsz; return true;
    }
    __device__ __forceinline__ void a_ready(const Unit&) const {}
    __device__ __forceinline__ void done(const Unit&) const {}
};


__device__ __forceinline__ unsigned cvt_pk_bf16(float lo, float hi) { typedef float f2 __attribute__((ext_vector_type(2))); typedef __bf16 b2 __attribute__((ext_vector_type(2))); f2 v = {lo, hi}; b2 b = __builtin_convertvector(v, b2); return __builtin_bit_cast(unsigned, b); }
struct EpiScale {
    static constexpr bool PERM = true, AFTER_DRAIN = false;
    bf16_t* O; int ldc; const float* rowss; int qscale;
    __device__ __forceinline__ void operator()(const f32x4 (&acc)[2][2][4][2], const Unit& u, int wr, int wc, int fr, int fq) const {
        const int row0 = u.pm * BM + wr * 64 + fr, col0 = u.pn * BM + wc * 32 + 8 * fq;
        const float cs = (qscale && (u.pn < 2 || u.pn == 7)) ? ::C2 : 1.0f;
#pragma unroll
        for (int ai = 0; ai < 2; ++ai)
#pragma unroll
            for (int m = 0; m < 4; ++m) { const int row = row0 + ai * HALF + m * 16; const float s = ::row_rs(rowss, row) * cs; bf16_t* rowp = O + (size_t)row * ldc + col0;
#pragma unroll
                for (int bj = 0; bj < 2; ++bj) { const f32x4 v0 = acc[ai][bj][m][0] * s, v1 = acc[ai][bj][m][1] * s;
                    u32x4 w; w.x = cvt_pk_bf16(v0[0], v0[1]); w.y = cvt_pk_bf16(v0[2], v0[3]); w.z = cvt_pk_bf16(v1[0], v1[1]); w.w = cvt_pk_bf16(v1[2], v1[3]);
                    *(u32x4*)(rowp + bj * HALF) = w; } }
    }
};
struct EpiResid {
    static constexpr bool PERM = true, AFTER_DRAIN = false;
    bf16_t* xh; float* rowss_next;
    __device__ __forceinline__ void operator()(const f32x4 (&acc)[2][2][4][2], const Unit& u, int wr, int wc, int fr, int fq) const {
        const int col0 = u.pn * BM + wc * 32 + 8 * fq;
#pragma unroll
        for (int ai = 0; ai < 2; ++ai)
#pragma unroll
            for (int m = 0; m < 4; ++m) { const int row = u.pm * BM + ai * HALF + wr * 64 + m * 16 + fr; const size_t off = (size_t)row * 1024 + col0; float ss = 0.f;
#pragma unroll
                for (int bj = 0; bj < 2; ++bj) { const size_t o = off + bj * HALF; const u32x4 h = *(const u32x4*)(xh + o); u32x4 nh;
#pragma unroll
                    for (int q = 0; q < 4; ++q) { const float x0 = ::bflo(h[q]) + acc[ai][bj][m][q >> 1][(q & 1) * 2], x1 = ::bfhi(h[q]) + acc[ai][bj][m][q >> 1][(q & 1) * 2 + 1];
                        ss += x0 * x0 + x1 * x1; nh[q] = cvt_pk_bf16(x0, x1); }
                    *(u32x4*)(xh + o) = nh; }
                ss += __shfl_xor(ss, 16); ss += __shfl_xor(ss, 32);
                if (fq == 0) rowss_next[(size_t)row * 16 + u.pn * 4 + wc] = ss; }
    }
};
__device__ __forceinline__ float dpp_shr1(float old, float v) { return __int_as_float(__builtin_amdgcn_update_dpp(__float_as_int(old), __float_as_int(v), 0x111, 0xf, 0xf, false)); }
__device__ __forceinline__ float dpp_shr2(float old, float v) { return __int_as_float(__builtin_amdgcn_update_dpp(__float_as_int(old), __float_as_int(v), 0x112, 0xf, 0xf, false)); }
__device__ __forceinline__ float dpp_ror1(float v) { return __int_as_float(__builtin_amdgcn_update_dpp(0, __float_as_int(v), 0x121, 0xf, 0xf, false)); }
__device__ __forceinline__ float dpp_ror2(float v) { return __int_as_float(__builtin_amdgcn_update_dpp(0, __float_as_int(v), 0x122, 0xf, 0xf, false)); }
struct EpiConvAct {
    static constexpr bool PERM = true, AFTER_DRAIN = false;
    bf16_t* ACT; const float* rowss; const float* cw; const float* cb; float* HEADA; float* HEADG; float* HALO;
    __device__ __forceinline__ void operator()(const f32x4 (&acc)[2][2][4][2], const Unit& u, int wr, int wc, int fr, int fq) const {
        constexpr int FF = 2816;
        const int ca = u.pn * 128 + wc * 32 + 8 * fq;
        float w0[8], w1[8], w2[8], bb[8];
#pragma unroll
        for (int h = 0; h < 2; ++h) { const f32x4 t0 = *(const f32x4*)(cw + ca + 4 * h), t1 = *(const f32x4*)(cw + FF + ca + 4 * h), t2 = *(const f32x4*)(cw + 2 * FF + ca + 4 * h), t3 = *(const f32x4*)(cb + ca + 4 * h);
#pragma unroll
            for (int j = 0; j < 4; ++j) { w0[4 * h + j] = t0[j]; w1[4 * h + j] = t1[j]; w2[4 * h + j] = t2[j]; bb[4 * h + j] = t3[j]; } }
#pragma unroll
        for (int ai = 0; ai < 2; ++ai) {
            const int blk = u.pm * 4 + ai * 2 + wr;
            float ap[8];
#pragma unroll
            for (int j = 0; j < 8; ++j) ap[j] = 0.f;
#pragma unroll
            for (int m = 0; m < 4; ++m) {
                const int row = u.pm * BM + ai * HALF + wr * 64 + m * 16 + fr; const float rs = ::row_rs(rowss, row);
                float a8[8], g8[8], y[8];
#pragma unroll
                for (int j = 0; j < 8; ++j) { a8[j] = acc[ai][0][m][j >> 2][j & 3] * rs; g8[j] = acc[ai][1][m][j >> 2][j & 3] * rs; }
#pragma unroll
                for (int j = 0; j < 8; ++j) { const float p1 = dpp_shr1(dpp_ror1(ap[j]), a8[j]), p2 = dpp_shr2(dpp_ror2(ap[j]), a8[j]);
                    const float x = bb[j] + w0[j] * p2 + w1[j] * p1 + w2[j] * a8[j];
                    y[j] = x * __builtin_amdgcn_rcpf(1.0f + __expf(-x)) * g8[j]; }
                if (m == 0 && fr < 2) { float* pa = HEADA + ((size_t)blk * 2 + fr) * FF + ca; float* pg = HEADG + ((size_t)blk * 2 + fr) * FF + ca;
                    *(f32x4*)pa = (f32x4){a8[0], a8[1], a8[2], a8[3]}; *(f32x4*)(pa + 4) = (f32x4){a8[4], a8[5], a8[6], a8[7]};
                    *(f32x4*)pg = (f32x4){g8[0], g8[1], g8[2], g8[3]}; *(f32x4*)(pg + 4) = (f32x4){g8[4], g8[5], g8[6], g8[7]}; }
                else { u32x4 w; w.x = cvt_pk_bf16(y[0], y[1]); w.y = cvt_pk_bf16(y[2], y[3]); w.z = cvt_pk_bf16(y[4], y[5]); w.w = cvt_pk_bf16(y[6], y[7]);
                    *(u32x4*)(ACT + (size_t)row * FF + ca) = w; }
                if (m == 3 && fr >= 14) { float* ph = HALO + ((size_t)blk * 2 + (fr - 14)) * FF + ca;
                    *(f32x4*)ph = (f32x4){a8[0], a8[1], a8[2], a8[3]}; *(f32x4*)(ph + 4) = (f32x4){a8[4], a8[5], a8[6], a8[7]}; }
#pragma unroll
                for (int j = 0; j < 8; ++j) ap[j] = a8[j];
            }
        }
    }
};
template <class Epi, class Sched, bool ALIGN_EPI = false, bool SP2 = false>
__device__ __forceinline__ void gemm_phase(PG8_LAS unsigned char* lds, const Gemm g, const Sched& S, const Epi& E) {
    int tid_ = threadIdx.x; asm volatile("" : "+v"(tid_));
    const int tid = tid_, wid = __builtin_amdgcn_readfirstlane(tid >> 6), lane = tid & 63, wr = wid >> 2, wc = wid & 3, fr = lane & 15, fq = lane >> 4;
    const int K = g.K, nt = K / BK;
    unsigned voffA[2], voffB[2];
#pragma unroll
    for (int i = 0; i < 2; ++i) { int R, C; stage_rc2(tid * 16 + i * 8192, R, C); const int Rb = Epi::PERM ? ((R & ~31) + perm32(R & 31)) : R;
        voffA[i] = (unsigned)(R * g.lda + C) * 2u; voffB[i] = (unsigned)(Rb * K + C) * 2u; }
    const size_t kstep = (size_t)(BK * 2);
    const size_t hstepA = (size_t)HALF * g.lda * 2, hstepB = (size_t)HALF * K * 2;
    const size_t tstepA = 2 * hstepA, tstepB = 2 * hstepB;
    const unsigned ldsw = (unsigned)wid * 1024u;
    const int aoffk[2] = {lds_byte2(wr * 64 + fr, fq), lds_byte2(wr * 64 + fr, 4 + fq)}, boffk[2] = {lds_byte2(wc * 32 + fr, fq), lds_byte2(wc * 32 + fr, 4 + fq)};
#define PG8_SA(b, h) (((b) * 2 + (h)) * HTB)
#define PG8_SB(b, h) ((4 + (b) * 2 + (h)) * HTB)
#define PG8_STAGE(bufoff, gbase, voff) do { _Pragma("unroll") for (int _i = 0; _i < 2; ++_i) \
        __builtin_amdgcn_global_load_lds((const unsigned*)((const char*)(gbase) + (voff)[_i]), (PG8_LAS unsigned*)(lds + (bufoff) + ldsw + _i * 8192), 16, 0, 0); } while (0)
#define PG8_LDA(dst, b, h) do { _Pragma("unroll") for (int m = 0; m < 4; ++m) _Pragma("unroll") for (int k = 0; k < 2; ++k) dst[m][k] = *(const PG8_LAS bf16x8*)(lds + PG8_SA(b, h) + aoffk[k] + m * 2048); } while (0)
#define PG8_LDB(dst, b, h) do { _Pragma("unroll") for (int n = 0; n < 2; ++n) _Pragma("unroll") for (int k = 0; k < 2; ++k) dst[n][k] = *(const PG8_LAS bf16x8*)(lds + PG8_SB(b, h) + boffk[k] + n * 2048); } while (0)
#define PG8_MMA(ai, bj, At, Bt) do { __builtin_amdgcn_s_setprio(1); _Pragma("unroll") for (int m = 0; m < 4; ++m) _Pragma("unroll") for (int n = 0; n < 2; ++n) _Pragma("unroll") for (int k = 0; k < 2; ++k) \
        acc[ai][bj][m][n] = __builtin_amdgcn_mfma_f32_16x16x32_bf16(Bt[n][k], At[m][k], acc[ai][bj][m][n], 0, 0, 0); __builtin_amdgcn_s_setprio(0); } while (0)
#define PG8_WAIT_V(n) asm volatile("s_waitcnt vmcnt(" #n ")" ::: "memory")
#define PG8_WAIT_L(n) asm volatile("s_waitcnt lgkmcnt(" #n ")" ::: "memory")
#define PG8_BAR __builtin_amdgcn_s_barrier()
#define PG8_SCHED __builtin_amdgcn_sched_barrier(0)
    Unit cur, nxt; int ui = 0;
    if (!S.next(0, cur)) return;
    f32x4 acc[2][2][4][2];
#pragma unroll
    for (int a = 0; a < 2; ++a)
#pragma unroll
        for (int b = 0; b < 2; ++b)
#pragma unroll
            for (int m = 0; m < 4; ++m)
#pragma unroll
                for (int n = 0; n < 2; ++n) acc[a][b][m][n] = (f32x4){0.f, 0.f, 0.f, 0.f};
    bf16x8 At[4][2], B0[2][2], B1[2][2];
    const char* cA = (const char*)g.A + (size_t)cur.pm * tstepA; const char* cB = (const char*)g.Bt + (size_t)cur.pn * tstepB;
    S.a_ready(cur);
    if constexpr (SP2) {
        PG8_STAGE(PG8_SB(0, 0), cB, voffB); PG8_STAGE(PG8_SB(0, 1), cB + hstepB, voffB); PG8_STAGE(PG8_SA(0, 0), cA, voffA); PG8_STAGE(PG8_SA(0, 1), cA + hstepA, voffA);
        if (wr == 1) PG8_BAR;
        PG8_WAIT_V(2); PG8_BAR;
        PG8_STAGE(PG8_SB(1, 0), cB + kstep, voffB); PG8_STAGE(PG8_SA(1, 0), cA + kstep, voffA); PG8_STAGE(PG8_SB(1, 1), cB + hstepB + kstep, voffB);
        PG8_WAIT_V(6); PG8_BAR;
    } else {
        PG8_STAGE(PG8_SB(0, 0), cB, voffB); PG8_STAGE(PG8_SA(0, 0), cA, voffA); PG8_STAGE(PG8_SB(0, 1), cB + hstepB, voffB); PG8_STAGE(PG8_SA(0, 1), cA + hstepA, voffA);
        if (wr == 1) PG8_BAR;
        PG8_WAIT_V(4); PG8_BAR;
        PG8_STAGE(PG8_SB(1, 0), cB + kstep, voffB); PG8_STAGE(PG8_SA(1, 0), cA + kstep, voffA); PG8_STAGE(PG8_SB(1, 1), cB + hstepB + kstep, voffB);
        PG8_WAIT_V(6); PG8_BAR;
    }
    for (;;) {
        const bool has_next = S.next(ui + 1, nxt);
        const char* nA = has_next ? (const char*)g.A + (size_t)nxt.pm * tstepA : cA; const char* nB = has_next ? (const char*)g.Bt + (size_t)nxt.pn * tstepB : cB;
        for (int t = 0; t < nt; t += 2) {
            const bool last = (t == nt - 2);
            const char* a1 = cA + (size_t)(t + 1) * kstep;
            const char* a2 = last ? nA : cA + (size_t)(t + 2) * kstep; const char* b2 = last ? nB : cB + (size_t)(t + 2) * kstep;
            const char* a3 = a2 + kstep; const char* b3 = b2 + kstep;
            if (last && has_next) S.a_ready(nxt);
            if constexpr (SP2) {
            PG8_LDB(B0, 0, 0); PG8_LDB(B1, 0, 1); PG8_SCHED; PG8_LDA(At, 0, 0); PG8_STAGE(PG8_SA(1, 1), a1 + hstepA, voffA);
            PG8_WAIT_V(8); PG8_WAIT_L(0); PG8_BAR; PG8_MMA(0, 0, At, B0); PG8_MMA(0, 1, At, B1); PG8_BAR; PG8_SCHED;
            PG8_LDA(At, 0, 1); PG8_STAGE(PG8_SB(0, 0), b2, voffB); PG8_STAGE(PG8_SB(0, 1), b2 + hstepB, voffB); PG8_STAGE(PG8_SA(0, 0), a2, voffA);
            PG8_WAIT_V(8); PG8_WAIT_L(0); PG8_BAR; PG8_MMA(1, 0, At, B0); PG8_MMA(1, 1, At, B1); PG8_BAR; PG8_SCHED;
            PG8_LDB(B0, 1, 0); PG8_LDB(B1, 1, 1); PG8_SCHED; PG8_LDA(At, 1, 0); PG8_STAGE(PG8_SA(0, 1), a2 + hstepA, voffA);
            PG8_WAIT_V(8); PG8_WAIT_L(0); PG8_BAR; PG8_MMA(0, 0, At, B0); PG8_MMA(0, 1, At, B1); PG8_BAR; PG8_SCHED;
            PG8_LDA(At, 1, 1); PG8_STAGE(PG8_SB(1, 0), b3, voffB); PG8_STAGE(PG8_SB(1, 1), b3 + hstepB, voffB); PG8_STAGE(PG8_SA(1, 0), a3, voffA);
            PG8_WAIT_V(8); PG8_WAIT_L(0); PG8_BAR; PG8_MMA(1, 0, At, B0); PG8_MMA(1, 1, At, B1); PG8_BAR; PG8_SCHED;
            } else {
            PG8_LDB(B0, 0, 0); PG8_SCHED; PG8_LDA(At, 0, 0); PG8_STAGE(PG8_SA(1, 1), a1 + hstepA, voffA);
            PG8_WAIT_L(8); PG8_BAR; PG8_WAIT_L(0); PG8_MMA(0, 0, At, B0); PG8_BAR; PG8_SCHED;
            PG8_LDB(B1, 0, 1); PG8_STAGE(PG8_SB(0, 0), b2, voffB);
            PG8_BAR; PG8_WAIT_L(0); PG8_MMA(0, 1, At, B1); PG8_BAR;
            PG8_LDA(At, 0, 1); PG8_STAGE(PG8_SA(0, 0), a2, voffA);
            PG8_BAR; PG8_WAIT_L(0); PG8_MMA(1, 0, At, B0); PG8_BAR; PG8_SCHED;
            PG8_STAGE(PG8_SB(0, 1), b2 + hstepB, voffB);
            PG8_WAIT_V(6); PG8_BAR; PG8_MMA(1, 1, At, B1); PG8_BAR;
            PG8_LDB(B0, 1, 0); PG8_SCHED; PG8_LDA(At, 1, 0); PG8_STAGE(PG8_SA(0, 1), a2 + hstepA, voffA);
            PG8_WAIT_L(8); PG8_BAR; PG8_WAIT_L(0); PG8_MMA(0, 0, At, B0); PG8_BAR; PG8_SCHED;
            PG8_LDB(B1, 1, 1); PG8_STAGE(PG8_SB(1, 0), b3, voffB);
            PG8_BAR; PG8_WAIT_L(0); PG8_MMA(0, 1, At, B1); PG8_BAR;
            PG8_LDA(At, 1, 1); PG8_STAGE(PG8_SA(1, 0), a3, voffA);
            PG8_BAR; PG8_WAIT_L(0); PG8_MMA(1, 0, At, B0); PG8_BAR; PG8_SCHED;
            PG8_STAGE(PG8_SB(1, 1), b3 + hstepB, voffB);
            PG8_WAIT_V(6); PG8_BAR; PG8_MMA(1, 1, At, B1); PG8_BAR;
            }
        }
        if constexpr (ALIGN_EPI) { if (wr == 0) PG8_BAR; }
        if constexpr (!Epi::AFTER_DRAIN) { E(acc, cur, wr, wc, fr, fq); S.done(cur); }
        if (!has_next) break;
#pragma unroll
        for (int a = 0; a < 2; ++a)
#pragma unroll
            for (int b = 0; b < 2; ++b)
#pragma unroll
                for (int m = 0; m < 4; ++m)
#pragma unroll
                    for (int n = 0; n < 2; ++n) acc[a][b][m][n] = (f32x4){0.f, 0.f, 0.f, 0.f};
        cur = nxt; cA = nA; cB = nB; ++ui;
        if constexpr (ALIGN_EPI) { if (wr == 1) PG8_BAR; }
    }
    PG8_WAIT_V(0);
    if constexpr (!ALIGN_EPI) { if (wr == 0) PG8_BAR; }
    PG8_BAR;
    if constexpr (Epi::AFTER_DRAIN) { E.fused(acc, cur, wr, wc, fr, fq, lds, wid, lane); S.done(cur); }
#undef PG8_SA
#undef PG8_SB
#undef PG8_STAGE
#undef PG8_LDA
#undef PG8_LDB
#undef PG8_MMA
#undef PG8_WAIT_V
#undef PG8_WAIT_L
#undef PG8_BAR
#undef PG8_SCHED
}
}

#include <hip/hip_bf16.h>
namespace attn_body {
using bf16=__hip_bfloat16;
using bf16x8=__attribute__((ext_vector_type(8)))short;
using s16x4=__attribute__((ext_vector_type(4)))short;
using f32x16=__attribute__((ext_vector_type(16)))float;
using u32x4=__attribute__((ext_vector_type(4)))unsigned;
constexpr int SEQ=8192,D=64,PQ=2560,PO=1024;
constexpr int NW=8,QBLK=32,QB=QBLK*NW,KVBLK=64,NQB=SEQ/QB;
constexpr int ATTN_UNIT_ROWS=QB;
__device__ __forceinline__ int crow(int r,int hi){return (r&3)+8*(r>>2)+4*hi;}
#define SBAR() __builtin_amdgcn_sched_barrier(0)
__device__ __forceinline__ void cmask(f32x16&p0,f32x16&p1,int jb,int qrel,int hi){
  const float NEG=-INFINITY; (void)hi;
  if(jb>(qrel>>6)){
  #pragma unroll
  for(int r=0;r<16;++r){p0[r]=NEG;p1[r]=NEG;}}
}

constexpr int NSLOT=3, SLOTB=8192;
constexpr int LDS_K=0, LDS_V=NSLOT*SLOTB, LDS_WS=2*NSLOT*SLOTB, LDS_OST=LDS_WS+NW*64*4, LDS_BYTES=LDS_OST+NW*4096;
constexpr float C2=0.125f*1.4426950408889634f;
__device__ __forceinline__ void glds16(const void*gsrc,unsigned lds_dst){unsigned keep;
  asm volatile("s_mov_b32 %0, m0\n\ts_mov_b32 m0, %2\n\ts_nop 0\n\tglobal_load_lds_dwordx4 %1, off\n\ts_mov_b32 m0, %0":"=&s"(keep):"v"(gsrc),"s"(lds_dst):"memory");}
__device__ __forceinline__ float max3f(float a,float b,float c){float r;asm("v_max3_f32 %0, %1, %2, %3":"=v"(r):"v"(a),"v"(b),"v"(c));return r;}
__device__ __forceinline__ float max2f(float a,float b){float r;asm("v_max_f32_e32 %0, %1, %2":"=v"(r):"v"(a),"v"(b));return r;}
__device__ __forceinline__ float fadd_s(float a,float b){float r;asm("v_add_f32_e32 %0, %1, %2":"=v"(r):"v"(a),"v"(b));return r;}
__device__ __forceinline__ float fsub_s(float a,float b){float r;asm("v_sub_f32_e32 %0, %1, %2":"=v"(r):"v"(a),"v"(b));return r;}
typedef float f32x2_t __attribute__((ext_vector_type(2))); typedef __bf16 bf16x2_t __attribute__((ext_vector_type(2)));
__device__ __forceinline__ unsigned cvtpk_s(float lo,float hi){f32x2_t v={lo,hi};bf16x2_t b=__builtin_convertvector(v,bf16x2_t);return __builtin_bit_cast(unsigned,b);}
#define WAIT_BAR(N) asm volatile("s_waitcnt vmcnt(" #N ") lgkmcnt(0)\n\ts_barrier":::"memory")

__device__ __forceinline__ void qkt(f32x16&p0,f32x16&p1,const char*Kslot,const bf16x8*qr,const f32x16&negm,int r32,int hi){
  const char*kb=Kslot+hi*1024+r32*16;
  #pragma unroll
  for(int d0=0;d0<4;++d0){
    const bf16x8 b0=*reinterpret_cast<const bf16x8*>(kb+d0*2048);
    const bf16x8 b1=*reinterpret_cast<const bf16x8*>(kb+d0*2048+512);
    if(d0==0){p0=__builtin_amdgcn_mfma_f32_32x32x16_bf16(b0,qr[0],negm,0,0,0);p1=__builtin_amdgcn_mfma_f32_32x32x16_bf16(b1,qr[0],negm,0,0,0);}
    else{p0=__builtin_amdgcn_mfma_f32_32x32x16_bf16(b0,qr[d0],p0,0,0,0);p1=__builtin_amdgcn_mfma_f32_32x32x16_bf16(b1,qr[d0],p1,0,0,0);}}
}
typedef __attribute__((address_space(3))) const char* lds_cptr;
typedef short v4i16_t __attribute__((ext_vector_type(4)));
__device__ __forceinline__ void kload8(bf16x8*kf,lds_cptr kp){
  kf[0]=*(const __attribute__((address_space(3))) bf16x8*)(kp);      kf[1]=*(const __attribute__((address_space(3))) bf16x8*)(kp+512);
  kf[2]=*(const __attribute__((address_space(3))) bf16x8*)(kp+2048); kf[3]=*(const __attribute__((address_space(3))) bf16x8*)(kp+2560);
  kf[4]=*(const __attribute__((address_space(3))) bf16x8*)(kp+4096); kf[5]=*(const __attribute__((address_space(3))) bf16x8*)(kp+4608);
  kf[6]=*(const __attribute__((address_space(3))) bf16x8*)(kp+6144); kf[7]=*(const __attribute__((address_space(3))) bf16x8*)(kp+6656);
}
__device__ __forceinline__ void kload2(bf16x8*kf,lds_cptr kp,int j){ kf[2*j]=*(const __attribute__((address_space(3))) bf16x8*)(kp+j*2048); kf[2*j+1]=*(const __attribute__((address_space(3))) bf16x8*)(kp+j*2048+512); }
__device__ __forceinline__ s16x4 vtr(lds_cptr p){ return __builtin_bit_cast(s16x4,__builtin_amdgcn_ds_read_tr16_b64_v4i16((__attribute__((address_space(3))) v4i16_t*)p)); }
__device__ __forceinline__ float rowmax(const f32x16&p0,const f32x16&p1){
  float a=max3f(p0[0],p0[1],p1[0]),b=max3f(p0[2],p0[3],p1[1]);a=max3f(a,p1[2],p1[3]);
  #pragma unroll
  for(int r=4;r<16;r+=4){a=max3f(a,p0[r],p0[r+1]);b=max3f(b,p0[r+2],p0[r+3]);a=max3f(a,p1[r],p1[r+1]);b=max3f(b,p1[r+2],p1[r+3]);}
  const float m=max2f(a,b);
  auto rr=__builtin_amdgcn_permlane32_swap(__float_as_uint(m),__float_as_uint(m),false,false);
  return max2f(__uint_as_float(rr[0]),__uint_as_float(rr[1]));
}
__device__ __forceinline__ void pv(f32x16*o,int vb,bf16x8 pa0,bf16x8 pa1,bf16x8 pa2,bf16x8 pa3){
  #pragma unroll
  for(int d0=0;d0<2;++d0){s16x4 lo[4],hi[4];
    #pragma unroll
    for(int ks=0;ks<4;++ks){
      asm volatile("ds_read_b64_tr_b16 %0,%1 offset:%c2":"=&v"(lo[ks]):"v"(vb),"i"(d0*4096+ks*1024):"memory");
      asm volatile("ds_read_b64_tr_b16 %0,%1 offset:%c2":"=&v"(hi[ks]):"v"(vb),"i"(d0*4096+ks*1024+512):"memory");}
    asm volatile("s_waitcnt lgkmcnt(0)":::"memory");SBAR();
    #define PK(k) (bf16x8){lo[k][0],lo[k][1],lo[k][2],lo[k][3],hi[k][0],hi[k][1],hi[k][2],hi[k][3]}
    o[d0]=__builtin_amdgcn_mfma_f32_32x32x16_bf16(pa0,PK(0),o[d0],0,0,0);
    o[d0]=__builtin_amdgcn_mfma_f32_32x32x16_bf16(pa1,PK(1),o[d0],0,0,0);
    o[d0]=__builtin_amdgcn_mfma_f32_32x32x16_bf16(pa2,PK(2),o[d0],0,0,0);
    o[d0]=__builtin_amdgcn_mfma_f32_32x32x16_bf16(pa3,PK(3),o[d0],0,0,0);
    #undef PK
  }
}

#ifndef ATTN_STORE16
#define ATTN_STORE16(p,v) (*(u32x4*)(p)=(v))
#endif
template<int THRL> __device__ __forceinline__ void attn_unit(int b,int qb,const bf16*Q,const bf16*__restrict__ K,const bf16*__restrict__ V,bf16*O,char*shm){
  int tid_=threadIdx.x; asm volatile("":"+v"(tid_)); const int tid=tid_,lane=tid&63,r32=lane&31,hi=lane>>5; const int wid=__builtin_amdgcn_readfirstlane(tid>>6);
  const long rowbase=(long)b*SEQ; const int q0=qb*QB;
  const bf16*Qw=Q+(rowbase+q0+wid*QBLK)*PQ;
  const bf16*Kh=K+rowbase*PQ,*Vh=V+rowbase*PQ;
  const unsigned lds0=(unsigned)(uintptr_t)shm;
  float*wsf=(float*)(shm+LDS_WS)+wid*64;
  const bf16*ksrc=Kh+(long)lane*PQ+wid*8;
  const bf16*vsrc=Vh+(long)(16*(wid&3)+(lane>>2))*PQ+(wid>>2)*32+(lane&3)*8;
  const unsigned kdst=lds0+LDS_K+wid*1024, vdst=lds0+LDS_V+wid*1024;
  #define DMA_K(t,slot) glds16(ksrc+(long)(t)*KVBLK*PQ,(unsigned)__builtin_amdgcn_readfirstlane(kdst+(slot)))
  #define DMA_V(t,slot) glds16(vsrc+(long)(t)*KVBLK*PQ,(unsigned)__builtin_amdgcn_readfirstlane(vdst+(slot)))
  const int vb0=(int)(lds0+LDS_V)+((lane>>4)&1)*32+(lane&3)*8+(4*hi+((lane&15)>>2))*64;
  const char*Kbase=shm+LDS_K; bf16x8 kf[8];
  const lds_cptr shm3=(lds_cptr)shm; const lds_cptr kp0=shm3+LDS_K+hi*1024+r32*16; const lds_cptr vp0=shm3+LDS_V+((lane>>4)&1)*32+(lane&3)*8+(4*hi+((lane&15)>>2))*64;
  const int NT=(q0+QB)/KVBLK;
  DMA_K(0,0);DMA_V(0,0);DMA_K(1,SLOTB);
  bf16x8 qr[4];
  #pragma unroll
  for(int d0=0;d0<4;++d0)qr[d0]=*reinterpret_cast<const bf16x8*>(&Qw[(long)r32*PQ+d0*16+hi*8]);
  float mhat=0.f,l_reg=0.f;f32x16 o[2];o[0]=f32x16{};o[1]=f32x16{};f32x16 negm=f32x16{};asm volatile("":"+v"(negm));
  const int qrel=wid*QBLK+r32;
  #define CMASK(P0,P1,t) do{int jb_=(t)-(NT-4); if(jb_>=0)cmask(P0,P1,jb_,qrel,hi);}while(0)
  bool resc=false;
  #define START(P0,P1) do{ const float rm=rowmax(P0,P1); resc=false; \
    { const float dl=rm; mhat=fadd_s(mhat,dl); \
      _Pragma("unroll") for(int r=0;r<16;++r){P0[r]=fsub_s(P0[r],dl);P1[r]=fsub_s(P1[r],dl);} \
      _Pragma("unroll") for(int r=0;r<16;++r)negm[r]=-mhat; asm volatile("":"+v"(negm)); } \
    _Pragma("unroll") for(int r=0;r<16;++r)P0[r]=__builtin_amdgcn_exp2f(P0[r]); }while(0)
  #define RESC() do{ if(resc){ asm volatile("s_waitcnt lgkmcnt(0)":::"memory"); \
      _Pragma("unroll") for(int d_=0;d_<2;++d_) _Pragma("unroll") for(int r=0;r<16;++r)o[d_][r]*=wsf[crow(r,hi)]; } }while(0)
  f32x16 pA0,pA1,pB0,pB1;
  int sl_prev=0,sl_cur=0,sl_next=SLOTB;
  #define ROT() do{sl_prev=sl_cur;sl_cur=sl_next;sl_next=(sl_next==(NSLOT-1)*SLOTB)?0:sl_next+SLOTB;}while(0)
  DMA_K(2,2*SLOTB);
  WAIT_BAR(3);
  qkt(pA0,pA1,Kbase,qr,negm,r32,hi);asm volatile("s_nop 15\n\ts_nop 7":"+v"(pA0),"+v"(pA1));CMASK(pA0,pA1,0);
  START(pA0,pA1);
  _Pragma("unroll") for(int r=0;r<16;++r)pA1[r]=__builtin_amdgcn_exp2f(pA1[r]);
  WAIT_BAR(0);
  DMA_K(3,0);DMA_V(1,SLOTB);
  ROT();
  kload8(kf,kp0+sl_cur);
  WAIT_BAR(2);
  s16x4 vlo[8],vhi[8]; u32x4 pw0,pw1,pw2,pw3;
  #define PKW(P,B) cvtpk_s(P[B],P[B+1])
  #define PAF(k) __builtin_bit_cast(bf16x8,pw##k)
  #define VFR(i) (bf16x8){vlo[i][0],vlo[i][1],vlo[i][2],vlo[i][3],vhi[i][0],vhi[i][1],vhi[i][2],vhi[i][3]}
  #define PIN(x) asm volatile("":"+v"(x))
  #define MX3(a,b,c) __builtin_fmaxf(__builtin_fmaxf((a),(b)),(c))
  #define GAPA(MF,A0,A1,A2,A3,W0,W1,PW) do{ MF; sacc+=A0; sacc+=A1; sacc+=A2; sacc+=A3; PIN(sacc); W0; W1; PIN(PW); SBAR(); }while(0)
  #define EX(v) __builtin_amdgcn_exp2f(v)
  #define GAPB(MF,X,B) do{ MF; X[B]=EX(X[B]); X[B+1]=EX(X[B+1]); X[B+2]=EX(X[B+2]); X[B+3]=EX(X[B+3]); PIN(X); SBAR(); }while(0)
  #define VRD(i) do{ vlo[i]=vtr(vp_+(((i)>>2)*4096+((i)&3)*1024)); vhi[i]=vtr(vp_+(((i)>>2)*4096+((i)&3)*1024+512)); }while(0)
  #define KRD(G,j) do{ if(G){ kload2(kf,kp0+sl_next,j); SBAR(); } }while(0)
  #define STEP(C0,C1,P0,P1,t,GK,GV,GL) do{ SBAR(); \
    const lds_cptr vp_=vp0+sl_prev; \
    VRD(0); SBAR(); float sacc=(P0[0]+P0[1]); \
    GAPA(C0=__builtin_amdgcn_mfma_f32_32x32x16_bf16(kf[0],qr[0],negm,0,0,0), P0[2],P0[3],P0[4],P0[5],     pw0[0]=PKW(P0,0), pw0[1]=PKW(P0,2), pw0); \
    VRD(4); SBAR(); GAPA(C1=__builtin_amdgcn_mfma_f32_32x32x16_bf16(kf[1],qr[0],negm,0,0,0), P0[6],P0[7],P0[8],P0[9],     pw0[2]=PKW(P0,4), pw0[3]=PKW(P0,6), pw0); \
    VRD(1); SBAR(); GAPA(C0=__builtin_amdgcn_mfma_f32_32x32x16_bf16(kf[2],qr[1],C0,0,0,0),   P0[10],P0[11],P0[12],P0[13], pw1[0]=PKW(P0,8), pw1[1]=PKW(P0,10), pw1); \
    VRD(5); SBAR(); GAPA(C1=__builtin_amdgcn_mfma_f32_32x32x16_bf16(kf[3],qr[1],C1,0,0,0),   P0[14],P0[15],P1[0],P1[1],   pw1[2]=PKW(P0,12),pw1[3]=PKW(P0,14), pw1); \
    VRD(2); SBAR(); GAPA(C0=__builtin_amdgcn_mfma_f32_32x32x16_bf16(kf[4],qr[2],C0,0,0,0),   P1[2],P1[3],P1[4],P1[5],     pw2[0]=PKW(P1,0), pw2[1]=PKW(P1,2), pw2); \
    VRD(6); SBAR(); GAPA(C1=__builtin_amdgcn_mfma_f32_32x32x16_bf16(kf[5],qr[2],C1,0,0,0),   P1[6],P1[7],P1[8],P1[9],     pw2[2]=PKW(P1,4), pw2[3]=PKW(P1,6), pw2); \
    VRD(3); SBAR(); GAPA(C0=__builtin_amdgcn_mfma_f32_32x32x16_bf16(kf[6],qr[3],C0,0,0,0),   P1[10],P1[11],P1[12],P1[13], pw3[0]=PKW(P1,8), pw3[1]=PKW(P1,10), pw3); \
    VRD(7); SBAR(); GAPA(C1=__builtin_amdgcn_mfma_f32_32x32x16_bf16(kf[7],qr[3],C1,0,0,0),   P1[14],P1[15],0.f,0.f,       pw3[2]=PKW(P1,12),pw3[3]=PKW(P1,14), pw3); \
    l_reg+=sacc; \
    if(GK){DMA_K((t)+3,sl_cur);} if(GV){DMA_V((t)+1,sl_next);} \
    CMASK(C0,C1,t); \
    { float a=MX3(C0[0],C0[1],C1[0]),b=MX3(C0[2],C0[3],C1[1]); a=MX3(a,C1[2],C1[3]); \
      _Pragma("unroll") for(int r=4;r<16;r+=4){a=MX3(a,C0[r],C0[r+1]);b=MX3(b,C0[r+2],C0[r+3]);a=MX3(a,C1[r],C1[r+1]);b=MX3(b,C1[r+2],C1[r+3]);} \
      float rm=__builtin_fmaxf(a,b); { auto rr=__builtin_amdgcn_permlane32_swap(__float_as_uint(rm),__float_as_uint(rm),false,false); rm=__builtin_fmaxf(__uint_as_float(rr[0]),__uint_as_float(rr[1])); } \
      resc=false; \
      if(__builtin_expect(__any(rm>(float)THRL),0)){ const float dl=__builtin_fmaxf(rm,0.f); mhat+=dl; \
        _Pragma("unroll") for(int r=0;r<16;++r){C0[r]-=dl;C1[r]-=dl;} \
        _Pragma("unroll") for(int r=0;r<16;++r)negm[r]=-mhat; asm volatile("":"+v"(negm)); \
        const float f=__builtin_amdgcn_exp2f(-dl); l_reg*=f; if(hi==0)wsf[r32]=f; resc=true; } } \
    SBAR(); \
    GAPB(o[0]=__builtin_amdgcn_mfma_f32_32x32x16_bf16(PAF(0),VFR(0),o[0],0,0,0), C0,0); \
    GAPB(o[1]=__builtin_amdgcn_mfma_f32_32x32x16_bf16(PAF(0),VFR(4),o[1],0,0,0), C0,4); \
    KRD(GL,0); GAPB(o[0]=__builtin_amdgcn_mfma_f32_32x32x16_bf16(PAF(1),VFR(1),o[0],0,0,0), C0,8); \
    KRD(GL,1); GAPB(o[1]=__builtin_amdgcn_mfma_f32_32x32x16_bf16(PAF(1),VFR(5),o[1],0,0,0), C0,12); \
    KRD(GL,2); GAPB(o[0]=__builtin_amdgcn_mfma_f32_32x32x16_bf16(PAF(2),VFR(2),o[0],0,0,0), C1,0); \
    KRD(GL,3); GAPB(o[1]=__builtin_amdgcn_mfma_f32_32x32x16_bf16(PAF(2),VFR(6),o[1],0,0,0), C1,4); \
    GAPB(o[0]=__builtin_amdgcn_mfma_f32_32x32x16_bf16(PAF(3),VFR(3),o[0],0,0,0), C1,8); \
    GAPB(o[1]=__builtin_amdgcn_mfma_f32_32x32x16_bf16(PAF(3),VFR(7),o[1],0,0,0), C1,12); \
    }while(0)
  int t=1;
  #undef CMASK
  #define CMASK(P0,P1,t) do{}while(0)
  for(;t+5<NT;t+=2){
    STEP(pB0,pB1,pA0,pA1,t,true,true,true);     WAIT_BAR(2); RESC(); ROT();
    STEP(pA0,pA1,pB0,pB1,t+1,true,true,true);   WAIT_BAR(2); RESC(); ROT();
  }
  #undef CMASK
  #define CMASK(P0,P1,t) do{int jb_=(t)-(NT-4); if(jb_>=0)cmask(P0,P1,jb_,qrel,hi);}while(0)
  #define ENDW(tt) do{ if((tt)+3<NT){WAIT_BAR(2);} else if((tt)+2<NT){WAIT_BAR(1);} else {WAIT_BAR(0);} }while(0)
  for(;t+1<NT;t+=2){
    STEP(pB0,pB1,pA0,pA1,t,(t+3<NT),(t+1<NT),(t+1<NT));       ENDW(t);   RESC(); ROT();
    STEP(pA0,pA1,pB0,pB1,t+1,(t+4<NT),(t+2<NT),(t+2<NT));     ENDW(t+1); RESC(); ROT();
  }
  STEP(pB0,pB1,pA0,pA1,NT-1,false,false,false); RESC();
  { float sacc=pB0[0]+pB0[1]; _Pragma("unroll") for(int r=2;r<16;++r)sacc+=pB0[r]; _Pragma("unroll") for(int r=0;r<16;++r)sacc+=pB1[r]; l_reg+=sacc;
    pw0=(u32x4){PKW(pB0,0),PKW(pB0,2),PKW(pB0,4),PKW(pB0,6)};pw1=(u32x4){PKW(pB0,8),PKW(pB0,10),PKW(pB0,12),PKW(pB0,14)};pw2=(u32x4){PKW(pB1,0),PKW(pB1,2),PKW(pB1,4),PKW(pB1,6)};pw3=(u32x4){PKW(pB1,8),PKW(pB1,10),PKW(pB1,12),PKW(pB1,14)};
    SBAR(); pv(o,vb0+sl_cur,PAF(0),PAF(1),PAF(2),PAF(3)); }
  #undef PKW
  #undef PAF
  #undef VFR
  #undef PIN
  #undef MX3
  #undef GAPA
  #undef GAPB
  #undef EX
  #undef VRD
  #undef KRD
  #undef STEP
  #undef ENDW
  {auto rr=__builtin_amdgcn_permlane32_swap(__float_as_uint(l_reg),__float_as_uint(l_reg),false,false);l_reg=__uint_as_float(rr[0])+__uint_as_float(rr[1]);}
  if(hi==0)wsf[32+r32]=l_reg;asm volatile("s_waitcnt lgkmcnt(0)":::"memory");
  float rli[16];
  #pragma unroll
  for(int r=0;r<16;++r)rli[r]=__builtin_amdgcn_rcpf(wsf[32+crow(r,hi)]);
  bf16*Ow=O+(rowbase+q0+wid*QBLK)*PO;
  { bf16*stg=(bf16*)(shm+LDS_OST)+wid*2048;
    #pragma unroll
    for(int r=0;r<16;++r){const int orow=crow(r,hi);
      #pragma unroll
      for(int d0=0;d0<2;++d0)stg[orow*64+d0*32+r32]=__float2bfloat16(o[d0][r]*rli[r]);}
    asm volatile("s_waitcnt lgkmcnt(0)":::"memory");
    #pragma unroll
    for(int i=0;i<4;++i){const int row=i*8+(lane>>3),ch=lane&7; const u32x4 v=*(const u32x4*)(stg+row*64+ch*8); ATTN_STORE16(Ow+(long)row*PO+ch*8,v);} }
  asm volatile("s_waitcnt lgkmcnt(0)\n\ts_barrier":::"memory");
  #undef DMA_K
  #undef DMA_V
  #undef CMASK
  #undef START
  #undef RESC
  #undef ROT
}


#define PV128_RD(LO,HI,vp,goff) do{ _Pragma("unroll") for(int ks=0;ks<4;++ks){ LO[ks]=vtr((vp)+((goff)+ks*1024)); HI[ks]=vtr((vp)+((goff)+ks*1024+512)); } }while(0)
#define PV128_MM(O,LO,HI) do{ \
    O=__builtin_amdgcn_mfma_f32_32x32x16_bf16(pa0,(bf16x8){LO[0][0],LO[0][1],LO[0][2],LO[0][3],HI[0][0],HI[0][1],HI[0][2],HI[0][3]},O,0,0,0); \
    O=__builtin_amdgcn_mfma_f32_32x32x16_bf16(pa1,(bf16x8){LO[1][0],LO[1][1],LO[1][2],LO[1][3],HI[1][0],HI[1][1],HI[1][2],HI[1][3]},O,0,0,0); \
    O=__builtin_amdgcn_mfma_f32_32x32x16_bf16(pa2,(bf16x8){LO[2][0],LO[2][1],LO[2][2],LO[2][3],HI[2][0],HI[2][1],HI[2][2],HI[2][3]},O,0,0,0); \
    O=__builtin_amdgcn_mfma_f32_32x32x16_bf16(pa3,(bf16x8){LO[3][0],LO[3][1],LO[3][2],LO[3][3],HI[3][0],HI[3][1],HI[3][2],HI[3][3]},O,0,0,0); }while(0)
__device__ __forceinline__ void pv128(f32x16*o,lds_cptr vp,s16x4 (&loA)[4],s16x4 (&hiA)[4],bf16x8 pa0,bf16x8 pa1,bf16x8 pa2,bf16x8 pa3){
  s16x4 loB[4],hiB[4];
  PV128_RD(loB,hiB,vp,4096);      SBAR(); PV128_MM(o[0],loA,hiA); SBAR();
  PV128_RD(loA,hiA,vp,8192);      SBAR(); PV128_MM(o[1],loB,hiB); SBAR();
  PV128_RD(loB,hiB,vp,8192+4096); SBAR(); PV128_MM(o[2],loA,hiA); SBAR();
  PV128_MM(o[3],loB,hiB);
}
namespace dfa { constexpr int DK=0, DV=3*8192, DWS=DV+3*16384, DOST=0, BYTES=DWS+2048; }
template<int THR> __device__ __forceinline__ void diff_unit(int b,int qb,const bf16*Q,const bf16*__restrict__ K,const bf16*__restrict__ V,bf16*O,char*shm){
  int tid_=threadIdx.x; asm volatile("":"+v"(tid_)); const int tid=tid_,lane=tid&63,r32=lane&31,hi=lane>>5; const int wid=__builtin_amdgcn_readfirstlane(tid>>6);
  const long rowbase=(long)b*SEQ; const int q0=qb*QB;
  const bf16*Qw=Q+(rowbase+q0+wid*QBLK)*PQ;
  const bf16*Kh=K+rowbase*PQ,*Vh=V+rowbase*PQ;
  const unsigned lds0=(unsigned)(uintptr_t)shm;
  float*wsf=(float*)(shm+dfa::DWS)+wid*64;
  const bf16*ksrc=Kh+(long)lane*PQ+wid*8;
  const bf16*vsrc=Vh+(long)(16*(wid&3)+(lane>>2))*PQ+(wid>>2)*32+(lane&3)*8;
  const unsigned kdst=lds0+dfa::DK+wid*1024, vdst=lds0+dfa::DV+wid*1024;
  #define DFA_DMA(t,sK,sV) do{ glds16(ksrc+(long)(t)*KVBLK*PQ,(unsigned)__builtin_amdgcn_readfirstlane(kdst+(sK))); \
      glds16(vsrc+(long)(t)*KVBLK*PQ,(unsigned)__builtin_amdgcn_readfirstlane(vdst+(sV))); glds16(vsrc+(long)(t)*KVBLK*PQ+64,(unsigned)__builtin_amdgcn_readfirstlane(vdst+(sV)+8192)); }while(0)
  const lds_cptr vp0=(lds_cptr)shm+dfa::DV+((lane>>4)&1)*32+(lane&3)*8+(4*hi+((lane&15)>>2))*64;
  const int NT=(q0+QB)/KVBLK, tlast=NT-4+(wid>>1);
  DFA_DMA(0,0,0); DFA_DMA(1,8192,16384);
  bf16x8 qr[4];
  #pragma unroll
  for(int d0=0;d0<4;++d0)qr[d0]=*reinterpret_cast<const bf16x8*>(&Qw[(long)r32*PQ+d0*16+hi*8]);
  asm volatile("":"+v"(qr[0]),"+v"(qr[1]),"+v"(qr[2]),"+v"(qr[3]));
  float l_reg=0.f; f32x16 o[4]; o[0]=f32x16{}; o[1]=f32x16{}; o[2]=f32x16{}; o[3]=f32x16{}; f32x16 negm=f32x16{};
  int sK=0,sV=0,sK2=2*8192,sV2=2*16384;
  for(int t=0;t<NT;++t){
    if(t+1<NT){WAIT_BAR(3);}else{WAIT_BAR(0);}
    if(t+2<NT){DFA_DMA(t+2,sK2,sV2);}
    if(t<=tlast){
      f32x16 p0,p1; qkt(p0,p1,shm+dfa::DK+sK,qr,negm,r32,hi);
      const lds_cptr vpt=vp0+sV; s16x4 vlo0[4],vhi0[4]; PV128_RD(vlo0,vhi0,vpt,0); SBAR();
      float rm=p0[0];
      #pragma unroll
      for(int r=0;r<16;++r){rm=__builtin_fmaxf(rm,p0[r]);rm=__builtin_fmaxf(rm,p1[r]);}
      { auto rr=__builtin_amdgcn_permlane32_swap(__float_as_uint(rm),__float_as_uint(rm),false,false); rm=__builtin_fmaxf(__uint_as_float(rr[0]),__uint_as_float(rr[1])); }
      if(t==0||__any(rm>(float)THR)){
        const float dl=(t==0)?rm:__builtin_fmaxf(rm,0.f);
        #pragma unroll
        for(int r=0;r<16;++r){p0[r]-=dl;p1[r]-=dl;negm[r]-=dl;}
        if(t!=0){ const float f=__builtin_amdgcn_exp2f(-dl); l_reg*=f; if(hi==0)wsf[r32]=f; asm volatile("s_waitcnt lgkmcnt(0)":::"memory");
          #pragma unroll
          for(int r=0;r<16;++r){const float fr_=wsf[crow(r,hi)]; o[0][r]*=fr_; o[1][r]*=fr_; o[2][r]*=fr_; o[3][r]*=fr_;} }
      }
      float sacc=0.f;
      #pragma unroll
      for(int r=0;r<16;++r){p0[r]=__builtin_amdgcn_exp2f(p0[r]);p1[r]=__builtin_amdgcn_exp2f(p1[r]);sacc+=p0[r]+p1[r];}
      l_reg+=sacc;
      u32x4 pw0,pw1,pw2,pw3;
      pw0=(u32x4){cvtpk_s(p0[0],p0[1]),cvtpk_s(p0[2],p0[3]),cvtpk_s(p0[4],p0[5]),cvtpk_s(p0[6],p0[7])};
      pw1=(u32x4){cvtpk_s(p0[8],p0[9]),cvtpk_s(p0[10],p0[11]),cvtpk_s(p0[12],p0[13]),cvtpk_s(p0[14],p0[15])};
      pw2=(u32x4){cvtpk_s(p1[0],p1[1]),cvtpk_s(p1[2],p1[3]),cvtpk_s(p1[4],p1[5]),cvtpk_s(p1[6],p1[7])};
      pw3=(u32x4){cvtpk_s(p1[8],p1[9]),cvtpk_s(p1[10],p1[11]),cvtpk_s(p1[12],p1[13]),cvtpk_s(p1[14],p1[15])};
      SBAR(); pv128(o,vpt,vlo0,vhi0,__builtin_bit_cast(bf16x8,pw0),__builtin_bit_cast(bf16x8,pw1),__builtin_bit_cast(bf16x8,pw2),__builtin_bit_cast(bf16x8,pw3));
    }
    sK2=sK; sV2=sV; sK=(sK==2*8192)?0:sK+8192; sV=(sV==2*16384)?0:sV+16384;
  }
  asm volatile("s_waitcnt lgkmcnt(0)\n\ts_barrier":::"memory");
  {auto rr=__builtin_amdgcn_permlane32_swap(__float_as_uint(l_reg),__float_as_uint(l_reg),false,false);l_reg=__uint_as_float(rr[0])+__uint_as_float(rr[1]);}
  if(hi==0)wsf[32+r32]=l_reg;asm volatile("s_waitcnt lgkmcnt(0)":::"memory");
  float rli[16];
  #pragma unroll
  for(int r=0;r<16;++r)rli[r]=__builtin_amdgcn_rcpf(wsf[32+crow(r,hi)]);
  bf16*Ow=O+(rowbase+q0+wid*QBLK)*PO;
  { bf16*stg=(bf16*)(shm+dfa::DOST)+wid*4096;
    #pragma unroll
    for(int r=0;r<16;++r){const int orow=crow(r,hi);
      #pragma unroll
      for(int d0=0;d0<4;++d0)stg[orow*128+d0*32+r32]=__float2bfloat16(o[d0][r]*rli[r]);}
    asm volatile("s_waitcnt lgkmcnt(0)":::"memory");
    #pragma unroll
    for(int i=0;i<8;++i){const int idx=i*64+lane,row=idx>>4,ch=idx&15; const u32x4 v=*(const u32x4*)(stg+row*128+ch*8); ATTN_STORE16(Ow+(long)row*PO+ch*8,v);} }
  asm volatile("s_waitcnt lgkmcnt(0)\n\ts_barrier":::"memory");
  #undef DFA_DMA
}

namespace dfb { constexpr int NS=5, DK=0, DV=NS*8192, DWS=DV+NS*16384, DOST=0, BYTES=DWS+2048; }
template<int THR> __device__ __forceinline__ void diff_unit2(int b,int qb,const bf16*Q,const bf16*__restrict__ K,const bf16*__restrict__ V,bf16*O,char*shm){
  int tid_=threadIdx.x; asm volatile("":"+v"(tid_)); const int tid=tid_,lane=tid&63,r32=lane&31,hi=lane>>5; const int wid=__builtin_amdgcn_readfirstlane(tid>>6);
  const long rowbase=(long)b*SEQ; const int q0=qb*QB;
  const bf16*Qw=Q+(rowbase+q0+wid*QBLK)*PQ;
  const bf16*Kh=K+rowbase*PQ,*Vh=V+rowbase*PQ;
  const unsigned lds0=(unsigned)(uintptr_t)shm;
  float*wsf=(float*)(shm+dfb::DWS)+wid*64;
  const bf16*ksrc=Kh+(long)lane*PQ+wid*8;
  const bf16*vsrc=Vh+(long)(16*(wid&3)+(lane>>2))*PQ+(wid>>2)*32+(lane&3)*8;
  const unsigned kdst=lds0+dfb::DK+wid*1024, vdst=lds0+dfb::DV+wid*1024;
  #define DFB_DMA(t,s_) do{ glds16(ksrc+(long)(t)*KVBLK*PQ,(unsigned)__builtin_amdgcn_readfirstlane(kdst+s_*8192)); \
      glds16(vsrc+(long)(t)*KVBLK*PQ,(unsigned)__builtin_amdgcn_readfirstlane(vdst+s_*16384)); glds16(vsrc+(long)(t)*KVBLK*PQ+64,(unsigned)__builtin_amdgcn_readfirstlane(vdst+s_*16384+8192)); }while(0)
  const int vb0=(int)(lds0+dfb::DV)+((lane>>4)&1)*32+(lane&3)*8+(4*hi+((lane&15)>>2))*64;
  const int NT=(q0+QB)/KVBLK, tlast=NT-4+(wid>>1);
  const lds_cptr kp0=(lds_cptr)shm+dfb::DK+hi*1024+r32*16;
  DFB_DMA(0,0); DFB_DMA(1,1); DFB_DMA(2,2);
  bf16x8 qr[4];
  #pragma unroll
  for(int d0=0;d0<4;++d0)qr[d0]=*reinterpret_cast<const bf16x8*>(&Qw[(long)r32*PQ+d0*16+hi*8]);
  asm volatile("":"+v"(qr[0]),"+v"(qr[1]),"+v"(qr[2]),"+v"(qr[3]));
  float l_reg=0.f; f32x16 o[4]; o[0]=f32x16{}; o[1]=f32x16{}; o[2]=f32x16{}; o[3]=f32x16{}; f32x16 negm=f32x16{};
  f32x16 s0,s1;
  u32x4 pw0,pw1,pw2,pw3;
  #define DFB_SOFTMAX() do{ float sacc=0.f; _Pragma("unroll") for(int r=0;r<16;++r){s0[r]=__builtin_amdgcn_exp2f(s0[r]);s1[r]=__builtin_amdgcn_exp2f(s1[r]);sacc+=s0[r]+s1[r];} l_reg+=sacc; \
      pw0=(u32x4){cvtpk_s(s0[0],s0[1]),cvtpk_s(s0[2],s0[3]),cvtpk_s(s0[4],s0[5]),cvtpk_s(s0[6],s0[7])}; \
      pw1=(u32x4){cvtpk_s(s0[8],s0[9]),cvtpk_s(s0[10],s0[11]),cvtpk_s(s0[12],s0[13]),cvtpk_s(s0[14],s0[15])}; \
      pw2=(u32x4){cvtpk_s(s1[0],s1[1]),cvtpk_s(s1[2],s1[3]),cvtpk_s(s1[4],s1[5]),cvtpk_s(s1[6],s1[7])}; \
      pw3=(u32x4){cvtpk_s(s1[8],s1[9]),cvtpk_s(s1[10],s1[11]),cvtpk_s(s1[12],s1[13]),cvtpk_s(s1[14],s1[15])}; }while(0)
  #define DFB_PV(sv) do{ const int vbt=vb0+(sv)*16384; \
      pv(o,vbt,__builtin_bit_cast(bf16x8,pw0),__builtin_bit_cast(bf16x8,pw1),__builtin_bit_cast(bf16x8,pw2),__builtin_bit_cast(bf16x8,pw3)); \
      pv(o+2,vbt+8192,__builtin_bit_cast(bf16x8,pw0),__builtin_bit_cast(bf16x8,pw1),__builtin_bit_cast(bf16x8,pw2),__builtin_bit_cast(bf16x8,pw3)); }while(0)
  #define DFB_REF(FIRST) do{ float rm=s0[0]; _Pragma("unroll") for(int r=0;r<16;++r){rm=__builtin_fmaxf(rm,s0[r]);rm=__builtin_fmaxf(rm,s1[r]);} \
      { auto rr=__builtin_amdgcn_permlane32_swap(__float_as_uint(rm),__float_as_uint(rm),false,false); rm=__builtin_fmaxf(__uint_as_float(rr[0]),__uint_as_float(rr[1])); } \
      if((FIRST)||__any(rm>(float)THR)){ const float dl=(FIRST)?rm:__builtin_fmaxf(rm,0.f); \
        _Pragma("unroll") for(int r=0;r<16;++r){s0[r]-=dl;s1[r]-=dl;negm[r]-=dl;} \
        if(!(FIRST)){ const float f=__builtin_amdgcn_exp2f(-dl); l_reg*=f; if(hi==0)wsf[r32]=f; asm volatile("s_waitcnt lgkmcnt(0)":::"memory"); \
          _Pragma("unroll") for(int r=0;r<16;++r){const float fr_=wsf[crow(r,hi)]; o[0][r]*=fr_; o[1][r]*=fr_; o[2][r]*=fr_; o[3][r]*=fr_;} } } }while(0)
  WAIT_BAR(6); DFB_DMA(3,3);
  qkt(s0,s1,shm+dfb::DK,qr,negm,r32,hi);
  DFB_REF(true);
  int sc=1,sp=0,sn=4;
  for(int t=1;t<NT;++t){
    if(t+2<NT){WAIT_BAR(6);}else if(t+1<NT){WAIT_BAR(3);}else{WAIT_BAR(0);}
    if(t+3<NT){DFB_DMA(t+3,sn);}
    if(t<=tlast+1){
      DFB_SOFTMAX(); SBAR();
      if(t<=tlast){ qkt(s0,s1,shm+dfb::DK+sc*8192,qr,negm,r32,hi); SBAR(); }
      DFB_PV(sp); SBAR();
      if(t<=tlast){ DFB_REF(false); }
    }
    sp=sc; sc=(sc==4)?0:sc+1; sn=(sn==4)?0:sn+1;
  }
  if(tlast==NT-1){ DFB_SOFTMAX(); SBAR(); DFB_PV(sp); }
  asm volatile("s_waitcnt lgkmcnt(0)\n\ts_barrier":::"memory");
  {auto rr=__builtin_amdgcn_permlane32_swap(__float_as_uint(l_reg),__float_as_uint(l_reg),false,false);l_reg=__uint_as_float(rr[0])+__uint_as_float(rr[1]);}
  if(hi==0)wsf[32+r32]=l_reg;asm volatile("s_waitcnt lgkmcnt(0)":::"memory");
  float rli[16];
  #pragma unroll
  for(int r=0;r<16;++r)rli[r]=__builtin_amdgcn_rcpf(wsf[32+crow(r,hi)]);
  bf16*Ow=O+(rowbase+q0+wid*QBLK)*PO;
  { bf16*stg=(bf16*)(shm+dfb::DOST)+wid*4096;
    #pragma unroll
    for(int r=0;r<16;++r){const int orow=crow(r,hi);
      #pragma unroll
      for(int d0=0;d0<4;++d0)stg[orow*128+d0*32+r32]=__float2bfloat16(o[d0][r]*rli[r]);}
    asm volatile("s_waitcnt lgkmcnt(0)":::"memory");
    #pragma unroll
    for(int i=0;i<8;++i){const int idx=i*64+lane,row=idx>>4,ch=idx&15; const u32x4 v=*(const u32x4*)(stg+row*128+ch*8); ATTN_STORE16(Ow+(long)row*PO+ch*8,v);} }
  asm volatile("s_waitcnt lgkmcnt(0)\n\ts_barrier":::"memory");
  #undef DFB_DMA
  #undef DFB_SOFTMAX
  #undef DFB_PV
  #undef DFB_REF
}
constexpr int LDS_BIAS=LDS_BYTES;
__device__ __forceinline__ void band_unit(int b,int h,int qb,const bf16*Q,const bf16*__restrict__ K,const bf16*__restrict__ V,bf16*O,const float*__restrict__ relb,char*shm){
  int tid_=threadIdx.x; asm volatile("":"+v"(tid_)); const int tid=tid_,lane=tid&63,r32=lane&31,hi=lane>>5; const int wid=__builtin_amdgcn_readfirstlane(tid>>6);
  const long rowbase=(long)b*SEQ; const int q0=qb*QB;
  const bf16*Qw=Q+(rowbase+q0+wid*QBLK)*PQ;
  const bf16*Kh=K+rowbase*PQ,*Vh=V+rowbase*PQ;
  const unsigned lds0=(unsigned)(uintptr_t)shm;
  float*wsf=(float*)(shm+LDS_WS)+wid*64;
  float*biasL=(float*)(shm+LDS_BIAS);
  for(int i=tid;i<640;i+=512)biasL[i]=relb[h*513+(i<512?i:512)]*1.4426950408889634f;
  const bf16*ksrc=Kh+(long)lane*PQ+wid*8;
  const bf16*vsrc=Vh+(long)(16*(wid&3)+(lane>>2))*PQ+(wid>>2)*32+(lane&3)*8;
  const unsigned kdst=lds0+LDS_K+wid*1024, vdst=lds0+LDS_V+wid*1024;
  #define DMA_K(t,slot) glds16(ksrc+(long)(t)*KVBLK*PQ,(unsigned)__builtin_amdgcn_readfirstlane(kdst+(slot)))
  #define DMA_V(t,slot) glds16(vsrc+(long)(t)*KVBLK*PQ,(unsigned)__builtin_amdgcn_readfirstlane(vdst+(slot)))
  const int vb0=(int)(lds0+LDS_V)+((lane>>4)&1)*32+(lane&3)*8+(4*hi+((lane&15)>>2))*64;
  const char*Kbase=shm+LDS_K;
  const int c0=q0/KVBLK, cw=c0+(wid>>1);
  const int tlo=(c0<8)?0:c0-8, thi=c0+3;
  bf16x8 qr[4];
  #pragma unroll
  for(int d0=0;d0<4;++d0)qr[d0]=*reinterpret_cast<const bf16x8*>(&Qw[(long)r32*PQ+d0*16+hi*8]);
  asm volatile("":"+v"(qr[0]),"+v"(qr[1]),"+v"(qr[2]),"+v"(qr[3]));
  float m_run=-INFINITY,l_reg=0.f; f32x16 o[2]; o[0]=f32x16{}; o[1]=f32x16{}; const f32x16 zero=f32x16{};
  const int qabs=q0+wid*QBLK+r32;
  DMA_K(tlo,0);DMA_V(tlo,0);
  int sl=0;
  for(int t=tlo;t<=thi;++t){
    if(t<thi){DMA_K(t+1,sl^SLOTB);DMA_V(t+1,sl^SLOTB);WAIT_BAR(2);}else{WAIT_BAR(0);}
    if(t>=cw-8&&t<=cw){
      f32x16 p0,p1; qkt(p0,p1,Kbase+sl,qr,zero,r32,hi);
      if(cw-t>=5){ const float bc=biasL[512];
        #pragma unroll
        for(int r=0;r<16;++r){p0[r]+=bc;p1[r]+=bc;} }
      else{ const float*bp=biasL+(qabs-(t*KVBLK+4*hi)+256);
        #pragma unroll
        for(int r=0;r<16;++r){ p0[r]+=bp[-((r&3)+8*(r>>2))]; p1[r]+=bp[-((r&3)+8*(r>>2))-32]; } }
      float rm=p0[0];
      #pragma unroll
      for(int r=0;r<16;++r){rm=__builtin_fmaxf(rm,p0[r]);rm=__builtin_fmaxf(rm,p1[r]);}
      { auto rr=__builtin_amdgcn_permlane32_swap(__float_as_uint(rm),__float_as_uint(rm),false,false); rm=__builtin_fmaxf(__uint_as_float(rr[0]),__uint_as_float(rr[1])); }
      const float mn=__builtin_fmaxf(m_run,rm); const float f=__builtin_amdgcn_exp2f(m_run-mn); m_run=mn;
      float sacc=0.f;
      #pragma unroll
      for(int r=0;r<16;++r){p0[r]=__builtin_amdgcn_exp2f(p0[r]-mn);p1[r]=__builtin_amdgcn_exp2f(p1[r]-mn);sacc+=p0[r]+p1[r];}
      l_reg=l_reg*f+sacc;
      if(__any(f!=1.0f)){
      if(hi==0)wsf[r32]=f;
      asm volatile("s_waitcnt lgkmcnt(0)":::"memory");
      #pragma unroll
      for(int r=0;r<16;++r){const float fr_=wsf[crow(r,hi)]; o[0][r]*=fr_; o[1][r]*=fr_;} }
      u32x4 pw0,pw1,pw2,pw3;
      pw0=(u32x4){cvtpk_s(p0[0],p0[1]),cvtpk_s(p0[2],p0[3]),cvtpk_s(p0[4],p0[5]),cvtpk_s(p0[6],p0[7])};
      pw1=(u32x4){cvtpk_s(p0[8],p0[9]),cvtpk_s(p0[10],p0[11]),cvtpk_s(p0[12],p0[13]),cvtpk_s(p0[14],p0[15])};
      pw2=(u32x4){cvtpk_s(p1[0],p1[1]),cvtpk_s(p1[2],p1[3]),cvtpk_s(p1[4],p1[5]),cvtpk_s(p1[6],p1[7])};
      pw3=(u32x4){cvtpk_s(p1[8],p1[9]),cvtpk_s(p1[10],p1[11]),cvtpk_s(p1[12],p1[13]),cvtpk_s(p1[14],p1[15])};
      SBAR(); pv(o,vb0+sl,__builtin_bit_cast(bf16x8,pw0),__builtin_bit_cast(bf16x8,pw1),__builtin_bit_cast(bf16x8,pw2),__builtin_bit_cast(bf16x8,pw3));
    }
    asm volatile("s_waitcnt lgkmcnt(0)\n\ts_barrier":::"memory");
    sl^=SLOTB;
  }
  {auto rr=__builtin_amdgcn_permlane32_swap(__float_as_uint(l_reg),__float_as_uint(l_reg),false,false);l_reg=__uint_as_float(rr[0])+__uint_as_float(rr[1]);}
  if(hi==0)wsf[32+r32]=l_reg;asm volatile("s_waitcnt lgkmcnt(0)":::"memory");
  float rli[16];
  #pragma unroll
  for(int r=0;r<16;++r)rli[r]=__builtin_amdgcn_rcpf(wsf[32+crow(r,hi)]);
  bf16*Ow=O+(rowbase+q0+wid*QBLK)*PO;
  { bf16*stg=(bf16*)(shm+LDS_OST)+wid*2048;
    #pragma unroll
    for(int r=0;r<16;++r){const int orow=crow(r,hi);
      #pragma unroll
      for(int d0=0;d0<2;++d0)stg[orow*64+d0*32+r32]=__float2bfloat16(o[d0][r]*rli[r]);}
    asm volatile("s_waitcnt lgkmcnt(0)":::"memory");
    #pragma unroll
    for(int i=0;i<4;++i){const int row=i*8+(lane>>3),ch=lane&7; const u32x4 v=*(const u32x4*)(stg+row*64+ch*8); ATTN_STORE16(Ow+(long)row*PO+ch*8,v);} }
  asm volatile("s_waitcnt lgkmcnt(0)\n\ts_barrier":::"memory");
  #undef DMA_K
  #undef DMA_V
}
constexpr int ATTN_LDS_BYTES=LDS_BYTES+2560;
#undef SBAR
#undef WAIT_BAR
}


#define CFG_ONE_LAUNCH 1
#define CFG_ATTN 2
#define CFG_BAND 1
#define PROBE_REP_MASK 0x0

#define LAS __attribute__((address_space(3)))
__device__ __forceinline__ void p0_transpose_item(const float* W, int K, int N, bf16_t* WT, LAS float* scr, int item, int lane, bool up_il, const float* gain) {
    const int nblk = N / 32, kb = item / nblk, nb = item % nblk, k0 = 64 * kb, n0 = 32 * nb;
    const int rb = !up_il ? n0 : (n0 < DFF ? (n0 >> 7) * 256 + (n0 & 127) : ((n0 - DFF) >> 7) * 256 + 128 + ((n0 - DFF) & 127));
#pragma unroll 8
    for (int i = 0; i < 32; ++i) { const int kk = 2 * i + (lane >> 5); const float gk = gain ? gain[k0 + kk] : 1.0f; scr[kk * 33 + (lane & 31)] = W[(size_t)(k0 + kk) * N + n0 + (lane & 31)] * gk; }
    asm volatile("s_waitcnt lgkmcnt(0)" ::: "memory");
    const int c = lane & 7;
#pragma unroll
    for (int j = 0; j < 4; ++j) { const int n = (lane >> 3) + 8 * j; const LAS float* s = scr + (8 * c) * 33 + n;
        u32x4 o; o.x = cvtpk(s[0 * 33], s[1 * 33]); o.y = cvtpk(s[2 * 33], s[3 * 33]); o.z = cvtpk(s[4 * 33], s[5 * 33]); o.w = cvtpk(s[6 * 33], s[7 * 33]);
        *(u32x4*)(WT + (size_t)(rb + n) * K + k0 + 8 * c) = o; }
    asm volatile("s_waitcnt lgkmcnt(0)" ::: "memory");
}
__device__ __forceinline__ void transpose_phase(const Args& a, unsigned char* ws, LAS unsigned char* lds, int gw, int NGW, int wave, int lane) {
    LAS float* scr = (LAS float*)(lds + wave * 16384);
    constexpr int I_IN = (DM / 64) * (INW / 32), I_OUT = (DM / 64) * (DM / 32), I_UP = (DM / 64) * (UPW / 32), I_DN = (DFF / 64) * (DM / 32), I_L = I_IN + I_OUT + I_UP + I_DN;
    for (int it = gw; it < DEPTH * I_L; it += NGW) {
        const int l = it / I_L; int r = it % I_L; unsigned char* wl = ws + WS_W + (size_t)l * W_LAYER;
        if (r < I_IN) { p0_transpose_item(a.in[2] + (size_t)l * DM * INW, DM, INW, (bf16_t*)(wl + W_IN), scr, r, lane, false, a.in[1] + (size_t)l * DM); continue; } r -= I_IN;
        if (r < I_OUT) { p0_transpose_item(a.in[11] + (size_t)l * DM * DM, DM, DM, (bf16_t*)(wl + W_OUT), scr, r, lane, false, nullptr); continue; } r -= I_OUT;
        if (r < I_UP) { p0_transpose_item(a.in[13] + (size_t)l * DM * UPW, DM, UPW, (bf16_t*)(wl + W_UP), scr, r, lane, true, a.in[12] + (size_t)l * DM); continue; } r -= I_UP;
        p0_transpose_item(a.in[16] + (size_t)l * DFF * DM, DFF, DM, (bf16_t*)(wl + W_DOWN), scr, r, lane, false, nullptr);
    }
}

__device__ __forceinline__ void n_diff_item(const bf16_t* PROJ, bf16_t* AO, int chunk, int vh, int lane) {
    const int h = vh >> 2, m = (vh >> 1) & 1, e = vh & 1;
    const int t = chunk * 64 + lane, b = t / SEQ, kbeg = b * SEQ, kend = (chunk + 1) * 64;
    float q[64], o[64];
    { const u32x4* qp = (const u32x4*)(PROJ + (size_t)t * INW + h * 128 + m * 64);
#pragma unroll
      for (int i = 0; i < 8; ++i) { const u32x4 w = qp[i];
#pragma unroll
          for (int c = 0; c < 4; ++c) { q[i * 8 + 2 * c] = bflo(w[c]); q[i * 8 + 2 * c + 1] = bfhi(w[c]); } } }
#pragma unroll
    for (int d = 0; d < 64; ++d) o[d] = 0.f;
    float mx = -INFINITY, lsum = 0.f;
    for (int k = kbeg; k < kend; ++k) {
        const u32x4* kp = (const u32x4*)(PROJ + (size_t)k * INW + COL_KA + h * 128 + m * 64);
        const u32x4* vp = (const u32x4*)(PROJ + (size_t)k * INW + COL_VA + h * 128 + e * 64);
        float s = 0.f;
#pragma unroll
        for (int i = 0; i < 8; ++i) { const u32x4 w = kp[i];
#pragma unroll
            for (int c = 0; c < 4; ++c) { s += q[i * 8 + 2 * c] * bflo(w[c]); s += q[i * 8 + 2 * c + 1] * bfhi(w[c]); } }
        const float mn = fmaxf(mx, s), f = exp2f(mx - mn), p = exp2f(s - mn);
        lsum = lsum * f + p; mx = mn;
#pragma unroll
        for (int i = 0; i < 8; ++i) { const u32x4 w = vp[i];
#pragma unroll
            for (int c = 0; c < 4; ++c) { o[i * 8 + 2 * c] = o[i * 8 + 2 * c] * f + p * bflo(w[c]); o[i * 8 + 2 * c + 1] = o[i * 8 + 2 * c + 1] * f + p * bfhi(w[c]); } }
    }
    const float inv = 1.0f / lsum;
    u32x4* op = (u32x4*)(AO + (size_t)t * 1024 + vh * 64);
#pragma unroll
    for (int i = 0; i < 8; ++i) { u32x4 w;
#pragma unroll
        for (int c = 0; c < 4; ++c) w[c] = cvtpk(o[i * 8 + 2 * c] * inv, o[i * 8 + 2 * c + 1] * inv);
        op[i] = w; }
}
__device__ __forceinline__ void n_band_item(const bf16_t* PROJ, const float* relb, bf16_t* MIX, int chunk, int h, int lane) {
    const int t = chunk * 64 + lane, b = t / SEQ, cin = chunk % (SEQ / 64);
    const float* rb = relb + h * 513;
    float q[64], o[64];
    { const u32x4* qp = (const u32x4*)(PROJ + (size_t)t * INW + COL_QC + h * 64);
#pragma unroll
      for (int i = 0; i < 8; ++i) { const u32x4 w = qp[i];
#pragma unroll
          for (int c = 0; c < 4; ++c) { q[i * 8 + 2 * c] = bflo(w[c]); q[i * 8 + 2 * c + 1] = bfhi(w[c]); } } }
#pragma unroll
    for (int d = 0; d < 64; ++d) o[d] = 0.f;
    float mx = -INFINITY, lsum = 0.f;
    for (int j = 0; j < 9; ++j) {
        const int kc = cin - 8 + j; if (kc < 0) continue;
        for (int kk = 0; kk < 64; ++kk) {
            const int k = b * SEQ + kc * 64 + kk;
            int rel = t - k; rel = rel < -256 ? -256 : (rel > 256 ? 256 : rel);
            const u32x4* kp = (const u32x4*)(PROJ + (size_t)k * INW + COL_KC + h * 64);
            const u32x4* vp = (const u32x4*)(PROJ + (size_t)k * INW + COL_VC + h * 64);
            float s = rb[rel + 256] * LOG2E;
#pragma unroll
            for (int i = 0; i < 8; ++i) { const u32x4 w = kp[i];
#pragma unroll
                for (int c = 0; c < 4; ++c) { s += q[i * 8 + 2 * c] * bflo(w[c]); s += q[i * 8 + 2 * c + 1] * bfhi(w[c]); } }
            const float mn = fmaxf(mx, s), f = exp2f(mx - mn), p = exp2f(s - mn);
            lsum = lsum * f + p; mx = mn;
#pragma unroll
            for (int i = 0; i < 8; ++i) { const u32x4 w = vp[i];
#pragma unroll
                for (int c = 0; c < 4; ++c) { o[i * 8 + 2 * c] = o[i * 8 + 2 * c] * f + p * bflo(w[c]); o[i * 8 + 2 * c + 1] = o[i * 8 + 2 * c + 1] * f + p * bfhi(w[c]); } }
        }
    }
    const float inv = 1.0f / lsum;
    u32x4* op = (u32x4*)(MIX + (size_t)t * 1024 + 768 + h * 64);
#pragma unroll
    for (int i = 0; i < 8; ++i) { u32x4 w;
#pragma unroll
        for (int c = 0; c < 4; ++c) w[c] = cvtpk(o[i * 8 + 2 * c] * inv, o[i * 8 + 2 * c + 1] * inv);
        op[i] = w; }
}


__device__ __forceinline__ void convfix_rows(const Args& a, int l, unsigned char* ws, int pm, int tid) {
    const float* cw = a.in[14] + (size_t)l * 3 * DFF; const float* cb = a.in[15] + (size_t)l * DFF;
    const float* HA = (const float*)(ws + WS_HEADA); const float* HG = (const float*)(ws + WS_HEADG); const float* HL = (const float*)(ws + WS_HALO); bf16_t* ACT = (bf16_t*)(ws + WS_ACT);
    for (int i = tid; i < 4 * DFF; i += 512) { const int b4 = i / DFF, c = i % DFF, blk = pm * 4 + b4;
        const float a0 = HA[((size_t)blk * 2) * DFF + c], a1 = HA[((size_t)blk * 2 + 1) * DFF + c], g0 = HG[((size_t)blk * 2) * DFF + c], g1 = HG[((size_t)blk * 2 + 1) * DFF + c];
        float h0 = 0.f, h1 = 0.f; if ((blk % (SEQ / 64)) != 0) { h0 = HL[((size_t)(blk - 1) * 2) * DFF + c]; h1 = HL[((size_t)(blk - 1) * 2 + 1) * DFF + c]; }
        const float w0 = cw[c], w1 = cw[DFF + c], w2 = cw[2 * DFF + c], bb = cb[c];
        const float x0 = bb + w0 * h0 + w1 * h1 + w2 * a0, x1 = bb + w0 * h1 + w1 * a0 + w2 * a1;
        const float y0 = x0 * __builtin_amdgcn_rcpf(1.0f + __expf(-x0)) * g0, y1 = x1 * __builtin_amdgcn_rcpf(1.0f + __expf(-x1)) * g1;
        ACT[(size_t)(blk * 64) * DFF + c] = (bf16_t)(cvtpk(y0, 0.f) & 0xffffu); ACT[(size_t)(blk * 64 + 1) * DFF + c] = (bf16_t)(cvtpk(y1, 0.f) & 0xffffu); }
}
#define XB_TMO      128
#define XB_XCNT(j)  (256  + 64 * (j))
#define XB_XSUB(j)  (1280 + 64 * (j))
#define XB_XGEN(j)  (2304 + 64 * (j))
#define XB_TOP      3328
#define XB_TOPGEN   3392
#define XCD_BAR_WORDS 3456
#define XB_SPIN_CAP (1u << 18)

__device__ __forceinline__ unsigned xb_ld(unsigned* p)              { return __hip_atomic_load(p, __ATOMIC_RELAXED, __HIP_MEMORY_SCOPE_AGENT); }
__device__ __forceinline__ unsigned xb_add(unsigned* p, unsigned v) { return __hip_atomic_fetch_add(p, v, __ATOMIC_RELAXED, __HIP_MEMORY_SCOPE_AGENT); }
__device__ __forceinline__ unsigned xb_xcc_id() { return (unsigned)__builtin_amdgcn_s_getreg((3 << 11) | 20) & 0xFu; }
#define XB_SPIN(cond, bar) do { unsigned _sp = 0; while (cond) { __builtin_amdgcn_s_sleep(1); \
    if ((++_sp & 255u) == 0u) { if (xb_ld(&(bar)[XB_TMO])) break; if (_sp > XB_SPIN_CAP) { atomicAdd(&(bar)[XB_TMO], 1u); break; } } } } while (0)

struct XcdBarrier {
    unsigned* bar; unsigned x;
    volatile LAS unsigned* st;
};

__device__ __forceinline__ XcdBarrier xcd_barrier_post(unsigned* bar, volatile LAS unsigned* st) {
    XcdBarrier b; b.bar = bar; b.x = xb_xcc_id(); b.st = st;
    if (threadIdx.x == 0) (void)xb_add(&bar[XB_XCNT(b.x)], 1u);
    return b;
}
__device__ __forceinline__ void xcd_barrier_complete(unsigned* bar, unsigned x, unsigned& nloc, unsigned& nx) {
    const unsigned G = gridDim.x * gridDim.y * gridDim.z;
    unsigned sum, cnt, mine, sp = 0u;
    for (;;) {
        sum = 0u; cnt = 0u; mine = 0u;
#pragma unroll
        for (unsigned j = 0; j < 16; ++j) { const unsigned c = xb_ld(&bar[XB_XCNT(j)]); sum += c; cnt += (c > 0u) ? 1u : 0u; mine = (j == x) ? c : mine; }
        if (sum == G) break;
        __builtin_amdgcn_s_sleep(1);
        if ((++sp & 255u) == 0u) { if (xb_ld(&bar[XB_TMO])) break; if (sp > XB_SPIN_CAP) { atomicAdd(&bar[XB_TMO], 1u); break; } }
    }
    nloc = mine > 0u ? mine : 1u; nx = cnt > 0u ? cnt : 1u;
}

__device__ __forceinline__ void xcd_barrier(const XcdBarrier& b) {
    asm volatile("s_waitcnt vmcnt(0)" ::: "memory");
    __syncthreads();
    if (threadIdx.x == 0) {
        unsigned* bar = b.bar;
        __builtin_amdgcn_s_waitcnt(0);
        unsigned nloc = b.st[0], nx = b.st[1];
        if (nloc == 0u) { xcd_barrier_complete(bar, b.x, nloc, nx); b.st[0] = nloc; b.st[1] = nx; }
        const unsigned old = xb_add(&bar[XB_XSUB(b.x)], 1u);
        const unsigned gen = old / nloc;
        if (old + 1u == (gen + 1u) * nloc) {
            __builtin_amdgcn_fence(__ATOMIC_RELEASE, "agent");
            asm volatile("s_waitcnt vmcnt(0)" ::: "memory");
            const unsigned og = xb_add(&bar[XB_TOP], 1u);
            const unsigned tg = og / nx;
            if (og + 1u == (tg + 1u) * nx) xb_add(&bar[XB_TOPGEN], 1u);
            else XB_SPIN(xb_ld(&bar[XB_TOPGEN]) == tg, bar);
            __builtin_amdgcn_fence(__ATOMIC_ACQUIRE, "agent");
            xb_add(&bar[XB_XGEN(b.x)], 1u);
            asm volatile("s_waitcnt vmcnt(0)" ::: "memory");
        } else {
            XB_SPIN(xb_ld(&bar[XB_XGEN(b.x)]) == gen, bar);
            __builtin_amdgcn_fence(__ATOMIC_ACQUIRE, "agent");
            asm volatile("s_waitcnt vmcnt(0)" ::: "memory");
        }
    }
    __syncthreads();
}

constexpr int LDS_BYTES = 147456;
__device__ __forceinline__ bool phase_exists(int p) { if (p == 0 || p == PH_FINAL) return true; const int s = (p - 1) % 10; return s != 9 && s != 7; }
__device__ __forceinline__ bool sync_after(int p) { if (p == 0) return true; const int s = (p - 1) % 10; return !(s == 1 || s == 2); }
__global__ void __launch_bounds__(512, 2) mega(Args a) {
    extern __shared__ __attribute__((aligned(16))) unsigned char lds[];
    cg::grid_group grid = cg::this_grid();
    const int G = gridDim.x, blk = blockIdx.x;
    const int vcu = (G % 8 == 0) ? (blk % 8) * (G / 8) + blk / 8 : blk;
    const int NGW = G * 8, NT = G * 512;
    unsigned char* ws = a.ws;
    float* rowss = (float*)(ws + WS_ROWSS);
    bf16_t* XG = (bf16_t*)(ws + WS_XG); bf16_t* PROJ = (bf16_t*)(ws + WS_PROJ); bf16_t* AO = (bf16_t*)(ws + WS_AO); bf16_t* MIX = (bf16_t*)(ws + WS_MIX);
    LAS unsigned char* lds3 = (LAS unsigned char*)lds;
    volatile LAS unsigned* bst = (volatile LAS unsigned*)(lds3 + 131072 + 64);
    if (threadIdx.x < 2) bst[threadIdx.x] = 0u;
    unsigned* barw = (unsigned*)ws;
    __syncthreads();
    XcdBarrier bar; bar.bar = barw; bar.x = 0; bar.st = bst;
    if (a.ph_hi - a.ph_lo > 1) bar = xcd_barrier_post(barw, bst);
    if (a.ph_lo < 0) grid.sync();
    for (int p = a.ph_lo; p < a.ph_hi; ++p) {
        if (!phase_exists(p)) continue;
        const int nrep = (p != 0 && p != PH_FINAL && ((PROBE_REP_MASK >> ((p - 1) % 10)) & 1)) ? 2 : ((p == 0 && (PROBE_REP_MASK & 0x400)) ? 2 : 1);
        for (int rep = 0; rep < nrep; ++rep) {
        if (rep) __syncthreads();
        int tid = threadIdx.x; asm volatile("" : "+v"(tid));
        const int lane = tid & 63, wave = __builtin_amdgcn_readfirstlane(tid >> 6), gw = blk * 8 + wave, gtid = blk * 512 + tid;
        if (p == 0) { transpose_phase(a, ws, lds3, gw, NGW, wave, lane); norm0_phase(a.in[0], XG, rowss, gw, NGW, lane); }
        else if (p == PH_FINAL) { final_phase(a.out, XG, rowss + (size_t)8 * RSS, a.in[17], gw, NGW, lane); }
        else {
            const int l = (p - 1) / 10, s = (p - 1) % 10;
            unsigned char* wl = ws + WS_W + (size_t)l * W_LAYER;
            if (s == 0) {
                pg8::Gemm g{XG, (const bf16_t*)(wl + W_IN), M, INW, DM, DM}; pg8::StaticOrder S; S.init(M, INW, G, blk);
                pg8::EpiScale E{PROJ, INW, rowss + (size_t)(2 * l) * RSS, 1};
                pg8::gemm_phase<pg8::EpiScale, pg8::StaticOrder, true, true>(lds3, g, S, E);
            } else if (s == 1) {
#if CFG_ATTN == 2
                for (int i = vcu; i < 512; i += G) { const int r = i >> 8, v = i & 255, combo = v >> 4, sI = v & 15;
                    const int qb = (r == 0) ? sI : 31 - sI, b = combo >> 3, hm = combo & 7, h = hm >> 1, m = hm & 1;
                    attn_body::diff_unit2<8>(b, qb, (const attn_body::bf16*)(PROJ + h * 128 + m * 64), (const attn_body::bf16*)(PROJ + COL_KA + h * 128 + m * 64),
                                            (const attn_body::bf16*)(PROJ + COL_VA + h * 128), (attn_body::bf16*)(AO + h * 256 + m * 128), (char*)lds); }
#elif CFG_ATTN
                for (int i = vcu; i < 1024; i += G) { const int r = i >> 8, v = i & 255, bh = v >> 3, sI = v & 7;
                    const int qb = (r == 0) ? sI : (r == 1) ? 15 - sI : (r == 2) ? 16 + sI : 31 - sI;
                    const int b = bh >> 4, vh = bh & 15, h = vh >> 2, m = (vh >> 1) & 1, e = vh & 1;
                    attn_body::attn_unit<8>(b, qb, (const attn_body::bf16*)(PROJ + h * 128 + m * 64), (const attn_body::bf16*)(PROJ + COL_KA + h * 128 + m * 64),
                                            (const attn_body::bf16*)(PROJ + COL_VA + h * 128 + e * 64), (attn_body::bf16*)(AO + vh * 64), (char*)lds); }
#else
                for (int it = gw; it < 4096; it += NGW) n_diff_item(PROJ, AO, 255 - (it >> 4), it & 15, lane);
#endif
                __syncthreads();
            } else if (s == 2) {
#if CFG_BAND
                for (int i = vcu; i < 256; i += G) { const int b = i >> 7, h = (i >> 5) & 3, qb = i & 31;
                    attn_body::band_unit(b, h, qb, (const attn_body::bf16*)(PROJ + COL_QC + h * 64), (const attn_body::bf16*)(PROJ + COL_KC + h * 64),
                                         (const attn_body::bf16*)(PROJ + COL_VC + h * 64), (attn_body::bf16*)(MIX + 768 + h * 64), a.in[10] + (size_t)l * 4 * 513, (char*)lds); }
#else
                for (int it = gw; it < 1024; it += NGW) n_band_item(PROJ, a.in[10] + (size_t)l * 4 * 513, MIX, it >> 2, it & 3, lane);
#endif
                __syncthreads();
            } else if (s == 3) pool_phase(a, l, PROJ, MIX, (float*)lds, blk, G, tid);
            else if (s == 4) combine_phase(a, l, AO, MIX, gw, NGW, lane);
            else if (s == 5) {
                pg8::Gemm g{MIX, (const bf16_t*)(wl + W_OUT), M, DM, DM, DM}; pg8::StaticOrder S; S.init(M, DM, G, blk);
                pg8::EpiResid E{XG, rowss + (size_t)(2 * l + 1) * RSS};
                pg8::gemm_phase<pg8::EpiResid, pg8::StaticOrder, true, true>(lds3, g, S, E);
            } else if (s == 6) {
                pg8::Gemm g{XG, (const bf16_t*)(wl + W_UP), M, UPW, DM, DM}; pg8::StaticOrder S; S.init(M, UPW, G, blk);
                pg8::EpiConvAct E{(bf16_t*)(ws + WS_ACT), rowss + (size_t)(2 * l + 1) * RSS, a.in[14] + (size_t)l * 3 * DFF, a.in[15] + (size_t)l * DFF, (float*)(ws + WS_HEADA), (float*)(ws + WS_HEADG), (float*)(ws + WS_HALO)};
                pg8::gemm_phase<pg8::EpiConvAct, pg8::StaticOrder, true, true>(lds3, g, S, E);
            }
            else if (s == 8) {
                pg8::Gemm g{(const bf16_t*)(ws + WS_ACT), (const bf16_t*)(wl + W_DOWN), M, DM, DFF, DFF}; pg8::StaticOrder S; S.init(M, DM, G, blk);
                { pg8::Unit u; for (int i = 0; S.next(i, u); ++i) convfix_rows(a, l, ws, u.pm, tid); }
                asm volatile("s_waitcnt vmcnt(0)" ::: "memory"); __syncthreads();
                pg8::EpiResid E{XG, rowss + (size_t)(2 * l + 2) * RSS};
                pg8::gemm_phase<pg8::EpiResid, pg8::StaticOrder, true, true>(lds3, g, S, E);
            }
        }
        }
        if (p + 1 < a.ph_hi) { if (sync_after(p)) xcd_barrier(bar); else __syncthreads(); }
    }
}

extern "C" void kernel_launch(void* const* d_in, const int* in_sizes, int n_in, void* d_out, int out_size, void* d_ws, size_t ws_size, hipStream_t stream) {
    static int grid = 0;
    if (grid == 0) {
        if (n_in != 18 || out_size != M * DM || ws_size < WS_END) { fprintf(stderr, "kernel_launch: unexpected shapes / workspace (n_in %d out %d ws %zu)\n", n_in, out_size, ws_size); grid = -1; return; }
        int dev = 0, cus = 0, per_cu = 0;
        (void)hipGetDevice(&dev); (void)hipDeviceGetAttribute(&cus, hipDeviceAttributeMultiprocessorCount, dev);
        if (hipFuncSetAttribute((const void*)mega, hipFuncAttributeMaxDynamicSharedMemorySize, LDS_BYTES) != hipSuccess) { fprintf(stderr, "hipFuncSetAttribute failed\n"); grid = -1; return; }
        if (hipOccupancyMaxActiveBlocksPerMultiprocessor(&per_cu, (const void*)mega, 512, LDS_BYTES) != hipSuccess || per_cu < 1) { fprintf(stderr, "occupancy query: %d\n", per_cu); per_cu = 1; }
        (void)hipGetLastError();
        grid = (cus > 0 ? cus : 256) * per_cu;
    }
    if (grid < 0) return;
    Args a{};
    for (int i = 0; i < 18; ++i) a.in[i] = (const float*)d_in[i];
    a.out = (float*)d_out; a.ws = (unsigned char*)d_ws;
    for (int l = 0; l < DEPTH; ++l) a.lam_init[l] = (float)(0.8 - 0.6 * exp(-0.3 * (double)l));
#if CFG_ONE_LAUNCH
    a.ph_lo = 0; a.ph_hi = PH_FINAL + 1;
    if (hipMemsetAsync(d_ws, 0, XCD_BAR_WORDS * sizeof(unsigned), stream) != hipSuccess) { fprintf(stderr, "kernel_launch: hipMemsetAsync of the barrier words failed\n"); return; }
    void* args[] = {&a};
    hipError_t e = hipLaunchCooperativeKernel((const void*)mega, dim3(grid), dim3(512), args, LDS_BYTES, stream);
    if (e != hipSuccess) fprintf(stderr, "cooperative launch failed: %s (grid %d)\n", hipGetErrorString(e), grid);
#else
    for (int p = 0; p <= PH_FINAL; ++p) { if (p != 0 && p != PH_FINAL && (((p - 1) % 10) == 9 || ((p - 1) % 10) == 7)) continue; a.ph_lo = p; a.ph_hi = p + 1; hipLaunchKernelGGL(mega, dim3(grid), dim3(512), LDS_BYTES, stream, a); }
#endif
}
```

```cpp
#include <hip/hip_runtime.h>
#include <hip/hip_cooperative_groups.h>
#include <cstdint>
#include <cstdio>
#include <cmath>
namespace cg = cooperative_groups;

constexpr int BATCH = 2, SEQ = 8192, DM = 1024, DEPTH = 4, M = BATCH * SEQ;
constexpr int INW = 2560, DFF = 2816, UPW = 2 * DFF;
constexpr float EPS = 1e-5f;
constexpr float LOG2E = 1.4426950408889634f;
constexpr float C2 = 0.125f * LOG2E;
constexpr int COL_KA = 512, COL_VA = 1024, COL_UB = 1536, COL_QC = 1792, COL_KC = 2048, COL_VC = 2304;

typedef unsigned short bf16_t;
typedef unsigned u32x4 __attribute__((ext_vector_type(4)));
typedef unsigned u32x2 __attribute__((ext_vector_type(2)));
typedef float f32x4 __attribute__((ext_vector_type(4)));
typedef float f32x2_t __attribute__((ext_vector_type(2)));
typedef __bf16 bf16x2_t __attribute__((ext_vector_type(2)));

constexpr size_t MiB = 1u << 20;
constexpr size_t WS_ROWSS = 304 * MiB;
constexpr size_t WS_W = 2 * MiB;
constexpr size_t W_LAYER = 23 * MiB + 512 * 1024, W_IN = 0, W_OUT = 5 * MiB, W_UP = 7 * MiB, W_DOWN = 18 * MiB;
constexpr size_t WS_XG = 96 * MiB;
constexpr size_t WS_PROJ = 128 * MiB;
constexpr size_t WS_AO = WS_PROJ + 80 * MiB;
constexpr size_t WS_MIX = WS_AO + 32 * MiB;
constexpr size_t WS_ACT = 128 * MiB;
constexpr size_t WS_HEADA = 272 * MiB, WS_HEADG = 278 * MiB, WS_HALO = 284 * MiB;
constexpr size_t WS_END = WS_ROWSS + 9 * MiB;
constexpr int RSS = M * 16;

__device__ __forceinline__ unsigned cvtpk(float lo, float hi) { f32x2_t v = {lo, hi}; bf16x2_t b = __builtin_convertvector(v, bf16x2_t); return __builtin_bit_cast(unsigned, b); }
__device__ __forceinline__ float bflo(unsigned w) { return __uint_as_float(w << 16); }
__device__ __forceinline__ float bfhi(unsigned w) { return __uint_as_float(w & 0xffff0000u); }
__device__ __forceinline__ float bf1(bf16_t v) { return __uint_as_float(((unsigned)v) << 16); }
__device__ __forceinline__ float wave_sum(float v) {
#pragma unroll
    for (int o = 1; o < 64; o <<= 1) v += __shfl_xor(v, o);
    return v;
}

__device__ __forceinline__ float row_rs(const float* rowss, int row) {
    const f32x4* p = (const f32x4*)(rowss + (size_t)row * 16); const f32x4 a = p[0], b = p[1], c = p[2], d = p[3];
    const float s = ((a.x + a.y) + (a.z + a.w)) + ((b.x + b.y) + (b.z + b.w)) + ((c.x + c.y) + (c.z + c.w)) + ((d.x + d.y) + (d.z + d.w));
    return rsqrtf(s * (1.0f / DM) + EPS);
}
struct Args {
    const float* in[18];
    float* out; unsigned char* ws;
    float lam_init[4];
    int ph_lo, ph_hi;
};
constexpr int PH_FINAL = 1 + 10 * DEPTH;

__device__ __forceinline__ void norm0_phase(const float* x, bf16_t* XH, float* rowss, int gw, int NGW, int lane) {
    for (int m = gw; m < M; m += NGW) {
        const f32x4* xr = (const f32x4*)(x + (size_t)m * DM) + lane;
        f32x4 v[4]; float s = 0.f;
#pragma unroll
        for (int j = 0; j < 4; ++j) { v[j] = xr[64 * j]; s += (v[j].x * v[j].x + v[j].y * v[j].y) + (v[j].z * v[j].z + v[j].w * v[j].w); }
        s = wave_sum(s);
        if (lane < 16) rowss[(size_t)m * 16 + lane] = (lane == 0) ? s : 0.f;
#pragma unroll
        for (int j = 0; j < 4; ++j) { u32x2 w; w.x = cvtpk(v[j].x, v[j].y); w.y = cvtpk(v[j].z, v[j].w); *(u32x2*)(XH + (size_t)m * DM + (64 * j + lane) * 4) = w; }
    }
}
__device__ __forceinline__ void combine_phase(const Args& a, int l, const bf16_t* __restrict__ AO, bf16_t* __restrict__ MIX, int gw, int NGW, int lane) {
    const float s1 = wave_sum(a.in[3][l * 64 + lane] * a.in[4][l * 64 + lane]);
    const float s2 = wave_sum(a.in[5][l * 64 + lane] * a.in[6][l * 64 + lane]);
    const float li = a.lam_init[l];
    const float lam = expf(s1) - expf(s2) + li;
    const float sc = 1.0f - li;
    const int h = lane >> 4, j0 = (lane & 15) * 8;
    float g[8];
#pragma unroll
    for (int j = 0; j < 8; ++j) g[j] = a.in[7][l * 128 + j0 + j] * sc;
    for (int t = gw; t < M; t += 2 * NGW) {
        const int t2 = t + NGW; const bool two = t2 < M;
        const bf16_t* p = AO + (size_t)t * 1024 + h * 256 + j0; const bf16_t* q = AO + (size_t)(two ? t2 : t) * 1024 + h * 256 + j0;
        const u32x4 a1 = *(const u32x4*)p, a2 = *(const u32x4*)(p + 128), b1 = *(const u32x4*)q, b2 = *(const u32x4*)(q + 128);
        float da[8], db[8]; float sa = 0.f, sb = 0.f;
#pragma unroll
        for (int c = 0; c < 4; ++c) { da[2 * c] = bflo(a1[c]) - lam * bflo(a2[c]); da[2 * c + 1] = bfhi(a1[c]) - lam * bfhi(a2[c]); db[2 * c] = bflo(b1[c]) - lam * bflo(b2[c]); db[2 * c + 1] = bfhi(b1[c]) - lam * bfhi(b2[c]);
            sa += da[2 * c] * da[2 * c] + da[2 * c + 1] * da[2 * c + 1]; sb += db[2 * c] * db[2 * c] + db[2 * c + 1] * db[2 * c + 1]; }
#pragma unroll
        for (int o = 1; o < 16; o <<= 1) { sa += __shfl_xor(sa, o); sb += __shfl_xor(sb, o); }
        const float ra = rsqrtf(sa * (1.0f / 128.0f) + EPS), rb = rsqrtf(sb * (1.0f / 128.0f) + EPS);
        u32x4 oa, ob;
#pragma unroll
        for (int c = 0; c < 4; ++c) { oa[c] = cvtpk(da[2 * c] * ra * g[2 * c], da[2 * c + 1] * ra * g[2 * c + 1]); ob[c] = cvtpk(db[2 * c] * rb * g[2 * c], db[2 * c + 1] * rb * g[2 * c + 1]); }
        *(u32x4*)(MIX + (size_t)t * 1024 + h * 128 + j0) = oa;
        if (two) *(u32x4*)(MIX + (size_t)t2 * 1024 + h * 128 + j0) = ob;
    }
}
__device__ __forceinline__ void pool_phase(const Args& a, int l, const bf16_t* PROJ, bf16_t* MIX, float* lds, int blk, int G, int tid) {
    typedef short bf16x8_t __attribute__((ext_vector_type(8)));
    constexpr int DS = 260;
    float* U = lds; float* Dd = lds + 31 * 256;
    const float* pw = a.in[8] + (size_t)l * 4 * 64 * 64; const float* ps = a.in[9] + l * 256;
    const int lane = tid & 63, wv = tid >> 6, g = wv & 3, nb0 = (wv >> 2) * 2, col = lane & 15, quad = lane >> 4;
    bf16x8_t bfr[2][2];
#pragma unroll
    for (int nb = 0; nb < 2; ++nb) { const int dd = (nb0 + nb) * 16 + col; const float sc = ps[g * 64 + dd];
#pragma unroll
        for (int ks = 0; ks < 2; ++ks) { u32x4 w;
#pragma unroll
            for (int q = 0; q < 4; ++q) { const int c = ks * 32 + quad * 8 + 2 * q; w[q] = cvtpk(pw[(g * 64 + c) * 64 + dd] * sc, pw[(g * 64 + c + 1) * 64 + dd] * sc); }
            bfr[nb][ks] = __builtin_bit_cast(bf16x8_t, w); } }
    u32x4 st0, st1;
#define POOL_FETCH(unit_) do { const int t0_ = (unit_) * 16, b_ = t0_ / SEQ, s0_ = t0_ % SEQ; \
        { const int r = tid >> 5, c8 = tid & 31, srow = s0_ - 15 + r; st0 = (u32x4){0u, 0u, 0u, 0u}; if (srow >= 0) st0 = *(const u32x4*)(PROJ + (size_t)(b_ * SEQ + srow) * INW + COL_UB + c8 * 8); } \
        { const int i2 = tid + 512, r = i2 >> 5, c8 = i2 & 31, srow = s0_ - 15 + r; st1 = (u32x4){0u, 0u, 0u, 0u}; if (i2 < 31 * 32 && srow >= 0) st1 = *(const u32x4*)(PROJ + (size_t)(b_ * SEQ + srow) * INW + COL_UB + c8 * 8); } } while (0)
    if (blk < M / 16) POOL_FETCH(blk);
    for (int unit = blk; unit < M / 16; unit += G) {
        const int t0 = unit * 16, s0 = t0 % SEQ;
        { f32x4* d = (f32x4*)(U + (tid >> 5) * 256 + (tid & 31) * 8);
          d[0] = (f32x4){bflo(st0.x), bfhi(st0.x), bflo(st0.y), bfhi(st0.y)}; d[1] = (f32x4){bflo(st0.z), bfhi(st0.z), bflo(st0.w), bfhi(st0.w)};
          const int i2 = tid + 512; if (i2 < 31 * 32) { f32x4* d2 = (f32x4*)(U + (i2 >> 5) * 256 + (i2 & 31) * 8);
              d2[0] = (f32x4){bflo(st1.x), bfhi(st1.x), bflo(st1.y), bfhi(st1.y)}; d2[1] = (f32x4){bflo(st1.z), bfhi(st1.z), bflo(st1.w), bfhi(st1.w)}; } }
        __syncthreads();
        if (unit + G < M / 16) POOL_FETCH(unit + G);
        { const int ch = tid & 255, tt0 = (tid >> 8) * 8, gg = ch >> 6, w = 2 << gg;
          float sum = 0.f;
          for (int j = 0; j < w; ++j) sum += U[(15 + tt0 - j) * 256 + ch];
#pragma unroll
          for (int i = 0; i < 8; ++i) { const int tt = tt0 + i, s = s0 + tt; const int cnt = (s + 1 < w) ? s + 1 : w;
              const float cur = U[(15 + tt) * 256 + ch];
              Dd[tt * DS + ch] = sum / (float)cnt - cur;
              if (i < 7) sum += U[(16 + tt) * 256 + ch] - U[(16 + tt - w) * 256 + ch]; } }
        __syncthreads();
        { f32x4 acc[2]; acc[0] = (f32x4){0.f, 0.f, 0.f, 0.f}; acc[1] = acc[0];
#pragma unroll
          for (int ks = 0; ks < 2; ++ks) {
              const f32x4* dp = (const f32x4*)(Dd + col * DS + g * 64 + ks * 32 + quad * 8); const f32x4 d0 = dp[0], d1 = dp[1];
              u32x4 w; w.x = cvtpk(d0.x, d0.y); w.y = cvtpk(d0.z, d0.w); w.z = cvtpk(d1.x, d1.y); w.w = cvtpk(d1.z, d1.w);
              const bf16x8_t af = __builtin_bit_cast(bf16x8_t, w);
              acc[0] = __builtin_amdgcn_mfma_f32_16x16x32_bf16(af, bfr[0][ks], acc[0], 0, 0, 0);
              acc[1] = __builtin_amdgcn_mfma_f32_16x16x32_bf16(af, bfr[1][ks], acc[1], 0, 0, 0); }
#pragma unroll
          for (int nb = 0; nb < 2; ++nb)
#pragma unroll
              for (int jj = 0; jj < 4; ++jj) MIX[(size_t)(t0 + quad * 4 + jj) * 1024 + 512 + g * 64 + (nb0 + nb) * 16 + col] = (bf16_t)(cvtpk(acc[nb][jj], 0.f) & 0xffffu); }
        __syncthreads();
    }
#undef POOL_FETCH
}
__device__ __forceinline__ void final_phase(float* out, const bf16_t* XH, const float* rowss, const float* g, int gw, int NGW, int lane) {
    for (int m = gw; m < M; m += NGW) {
        const float r = row_rs(rowss, m);
        f32x4* orow = (f32x4*)(out + (size_t)m * DM) + lane;
#pragma unroll
        for (int j = 0; j < 4; ++j) { const f32x4 gg = ((const f32x4*)g)[64 * j + lane]; const u32x2 h = *(const u32x2*)(XH + (size_t)m * DM + (64 * j + lane) * 4);
            const f32x4 v = {bflo(h.x), bfhi(h.x), bflo(h.y), bfhi(h.y)}; orow[64 * j] = v * r * gg; }
    }
}

namespace pg8 {
#define PG8_LAS __attribute__((address_space(3)))
typedef unsigned short bf16_t;
typedef short bf16x8 __attribute__((ext_vector_type(8)));
typedef float f32x4 __attribute__((ext_vector_type(4)));
typedef unsigned u32x4 __attribute__((ext_vector_type(4)));
constexpr int BM = 256, BK = 64, HALF = 128, HTB = HALF * BK * 2  , STAGE_BYTES = 8 * HTB, NXCD = 8, WGM = 8;

__host__ __device__ __forceinline__ int lds_byte(int r, int c) { const int st = (r >> 4) * 2 + (c >> 5), rr = r & 15, cc = c & 31, ob = rr * 64 + cc * 2; return st * 1024 + (ob ^ (((ob >> 9) & 1) << 5)); }
__host__ __device__ __forceinline__ void stage_rc(int b, int& R, int& C) { const int st = b / 1024, sb = b % 1024, swz = sb ^ (((sb >> 9) & 1) << 5); R = (st >> 1) * 16 + swz / 64; C = (st & 1) * 32 + (swz % 64) / 2; }
__host__ __device__ __forceinline__ int lds_byte2(int r, int ch) { return (r >> 3) * 1024 + (r & 7) * 128 + ((ch ^ ((r >> 1) & 7)) * 16); }
__host__ __device__ __forceinline__ void stage_rc2(int b, int& R, int& C) { const int p = b / 1024, l = (b % 1024) / 16; R = p * 8 + (l >> 3); C = ((l & 7) ^ ((R >> 1) & 7)) * 8; }
__host__ __device__ __forceinline__ int perm32(int rho) { const int n = rho >> 4, i = rho & 15; return 8 * (i >> 2) + 4 * n + (i & 3); }

struct Unit { int pm, pn; };
struct Gemm { const bf16_t* A; const bf16_t* Bt; int M, N, K, lda; };

struct StaticOrder {
    int nM, nN, nwg, G, c;
    __host__ __device__ void init(int M, int N, int G_, int c_) { nM = M / BM; nN = N / BM; nwg = nM * nN; G = G_; c = c_; }
    __host__ __device__ bool next(int i, Unit& u) const {
        const long L = (long)i * G + c; if (L >= nwg) return false;
        int wgid = (int)L; { const int q = nwg / NXCD, r = nwg % NXCD, xcd = wgid % NXCD, off = wgid / NXCD; wgid = (xcd < r ? xcd * (q + 1) : r * (q + 1) + (xcd - r) * q) + off; }
        const int nig = WGM * nN, gid = wgid / nig, fm = gid * WGM, gsz = (nM - fm) < WGM ? (nM - fm) : WGM;
        u.pm = fm + ((wgid % nig) % gsz); u.pn = (wgid % nig) / gsz; return true;
    }
    __device__ __forceinline__ void a_ready(const Unit&) const {}
    __device__ __forceinline__ void done(const Unit&) const {}
};


__device__ __forceinline__ unsigned cvt_pk_bf16(float lo, float hi) { typedef float f2 __attribute__((ext_vector_type(2))); typedef __bf16 b2 __attribute__((ext_vector_type(2))); f2 v = {lo, hi}; b2 b = __builtin_convertvector(v, b2); return __builtin_bit_cast(unsigned, b); }
struct EpiScale {
    static constexpr bool PERM = true, AFTER_DRAIN = false;
    bf16_t* O; int ldc; const float* rowss; int qscale;
    __device__ __forceinline__ void operator()(const f32x4 (&acc)[2][2][4][2], const Unit& u, int wr, int wc, int fr, int fq) const {
        const int row0 = u.pm * BM + wr * 64 + fr, col0 = u.pn * BM + wc * 32 + 8 * fq;
        const float cs = (qscale && (u.pn < 2 || u.pn == 7)) ? ::C2 : 1.0f;
#pragma unroll
        for (int ai = 0; ai < 2; ++ai)
#pragma unroll
            for (int m = 0; m < 4; ++m) { const int row = row0 + ai * HALF + m * 16; const float s = ::row_rs(rowss, row) * cs; bf16_t* rowp = O + (size_t)row * ldc + col0;
#pragma unroll
                for (int bj = 0; bj < 2; ++bj) { const f32x4 v0 = acc[ai][bj][m][0] * s, v1 = acc[ai][bj][m][1] * s;
                    u32x4 w; w.x = cvt_pk_bf16(v0[0], v0[1]); w.y = cvt_pk_bf16(v0[2], v0[3]); w.z = cvt_pk_bf16(v1[0], v1[1]); w.w = cvt_pk_bf16(v1[2], v1[3]);
                    *(u32x4*)(rowp + bj * HALF) = w; } }
    }
};
struct EpiResid {
    static constexpr bool PERM = true, AFTER_DRAIN = false;
    bf16_t* xh; float* rowss_next;
    __device__ __forceinline__ void operator()(const f32x4 (&acc)[2][2][4][2], const Unit& u, int wr, int wc, int fr, int fq) const {
        const int col0 = u.pn * BM + wc * 32 + 8 * fq;
#pragma unroll
        for (int ai = 0; ai < 2; ++ai)
#pragma unroll
            for (int m = 0; m < 4; ++m) { const int row = u.pm * BM + ai * HALF + wr * 64 + m * 16 + fr; const size_t off = (size_t)row * 1024 + col0; float ss = 0.f;
#pragma unroll
                for (int bj = 0; bj < 2; ++bj) { const size_t o = off + bj * HALF; const u32x4 h = *(const u32x4*)(xh + o); u32x4 nh;
#pragma unroll
                    for (int q = 0; q < 4; ++q) { const float x0 = ::bflo(h[q]) + acc[ai][bj][m][q >> 1][(q & 1) * 2], x1 = ::bfhi(h[q]) + acc[ai][bj][m][q >> 1][(q & 1) * 2 + 1];
                        ss += x0 * x0 + x1 * x1; nh[q] = cvt_pk_bf16(x0, x1); }
                    *(u32x4*)(xh + o) = nh; }
                ss += __shfl_xor(ss, 16); ss += __shfl_xor(ss, 32);
                if (fq == 0) rowss_next[(size_t)row * 16 + u.pn * 4 + wc] = ss; }
    }
};
__device__ __forceinline__ float dpp_shr1(float old, float v) { return __int_as_float(__builtin_amdgcn_update_dpp(__float_as_int(old), __float_as_int(v), 0x111, 0xf, 0xf, false)); }
__device__ __forceinline__ float dpp_shr2(float old, float v) { return __int_as_float(__builtin_amdgcn_update_dpp(__float_as_int(old), __float_as_int(v), 0x112, 0xf, 0xf, false)); }
__device__ __forceinline__ float dpp_ror1(float v) { return __int_as_float(__builtin_amdgcn_update_dpp(0, __float_as_int(v), 0x121, 0xf, 0xf, false)); }
__device__ __forceinline__ float dpp_ror2(float v) { return __int_as_float(__builtin_amdgcn_update_dpp(0, __float_as_int(v), 0x122, 0xf, 0xf, false)); }
struct EpiConvAct {
    static constexpr bool PERM = true, AFTER_DRAIN = false;
    bf16_t* ACT; const float* rowss; const float* cw; const float* cb; float* HEADA; float* HEADG; float* HALO;
    __device__ __forceinline__ void operator()(const f32x4 (&acc)[2][2][4][2], const Unit& u, int wr, int wc, int fr, int fq) const {
        constexpr int FF = 2816;
        const int ca = u.pn * 128 + wc * 32 + 8 * fq;
        float w0[8], w1[8], w2[8], bb[8];
#pragma unroll
        for (int h = 0; h < 2; ++h) { const f32x4 t0 = *(const f32x4*)(cw + ca + 4 * h), t1 = *(const f32x4*)(cw + FF + ca + 4 * h), t2 = *(const f32x4*)(cw + 2 * FF + ca + 4 * h), t3 = *(const f32x4*)(cb + ca + 4 * h);
#pragma unroll
            for (int j = 0; j < 4; ++j) { w0[4 * h + j] = t0[j]; w1[4 * h + j] = t1[j]; w2[4 * h + j] = t2[j]; bb[4 * h + j] = t3[j]; } }
#pragma unroll
        for (int ai = 0; ai < 2; ++ai) {
            const int blk = u.pm * 4 + ai * 2 + wr;
            float ap[8];
#pragma unroll
            for (int j = 0; j < 8; ++j) ap[j] = 0.f;
#pragma unroll
            for (int m = 0; m < 4; ++m) {
                const int row = u.pm * BM + ai * HALF + wr * 64 + m * 16 + fr; const float rs = ::row_rs(rowss, row);
                float a8[8], g8[8], y[8];
#pragma unroll
                for (int j = 0; j < 8; ++j) { a8[j] = acc[ai][0][m][j >> 2][j & 3] * rs; g8[j] = acc[ai][1][m][j >> 2][j & 3] * rs; }
#pragma unroll
                for (int j = 0; j < 8; ++j) { const float p1 = dpp_shr1(dpp_ror1(ap[j]), a8[j]), p2 = dpp_shr2(dpp_ror2(ap[j]), a8[j]);
                    const float x = bb[j] + w0[j] * p2 + w1[j] * p1 + w2[j] * a8[j];
                    y[j] = x * __builtin_amdgcn_rcpf(1.0f + __expf(-x)) * g8[j]; }
                if (m == 0 && fr < 2) { float* pa = HEADA + ((size_t)blk * 2 + fr) * FF + ca; float* pg = HEADG + ((size_t)blk * 2 + fr) * FF + ca;
                    *(f32x4*)pa = (f32x4){a8[0], a8[1], a8[2], a8[3]}; *(f32x4*)(pa + 4) = (f32x4){a8[4], a8[5], a8[6], a8[7]};
                    *(f32x4*)pg = (f32x4){g8[0], g8[1], g8[2], g8[3]}; *(f32x4*)(pg + 4) = (f32x4){g8[4], g8[5], g8[6], g8[7]}; }
                else { u32x4 w; w.x = cvt_pk_bf16(y[0], y[1]); w.y = cvt_pk_bf16(y[2], y[3]); w.z = cvt_pk_bf16(y[4], y[5]); w.w = cvt_pk_bf16(y[6], y[7]);
                    *(u32x4*)(ACT + (size_t)row * FF + ca) = w; }
                if (m == 3 && fr >= 14) { float* ph = HALO + ((size_t)blk * 2 + (fr - 14)) * FF + ca;
                    *(f32x4*)ph = (f32x4){a8[0], a8[1], a8[2], a8[3]}; *(f32x4*)(ph + 4) = (f32x4){a8[4], a8[5], a8[6], a8[7]}; }
#pragma unroll
                for (int j = 0; j < 8; ++j) ap[j] = a8[j];
            }
        }
    }
};
template <class Epi, class Sched, bool ALIGN_EPI = false, bool SP2 = false>
__device__ __forceinline__ void gemm_phase(PG8_LAS unsigned char* lds, const Gemm g, const Sched& S, const Epi& E) {
    int tid_ = threadIdx.x; asm volatile("" : "+v"(tid_));
    const int tid = tid_, wid = __builtin_amdgcn_readfirstlane(tid >> 6), lane = tid & 63, wr = wid >> 2, wc = wid & 3, fr = lane & 15, fq = lane >> 4;
    const int K = g.K, nt = K / BK;
    unsigned voffA[2], voffB[2];
#pragma unroll
    for (int i = 0; i < 2; ++i) { int R, C; stage_rc2(tid * 16 + i * 8192, R, C); const int Rb = Epi::PERM ? ((R & ~31) + perm32(R & 31)) : R;
        voffA[i] = (unsigned)(R * g.lda + C) * 2u; voffB[i] = (unsigned)(Rb * K + C) * 2u; }
    const size_t kstep = (size_t)(BK * 2);
    const size_t hstepA = (size_t)HALF * g.lda * 2, hstepB = (size_t)HALF * K * 2;
    const size_t tstepA = 2 * hstepA, tstepB = 2 * hstepB;
    const unsigned ldsw = (unsigned)wid * 1024u;
    const int aoffk[2] = {lds_byte2(wr * 64 + fr, fq), lds_byte2(wr * 64 + fr, 4 + fq)}, boffk[2] = {lds_byte2(wc * 32 + fr, fq), lds_byte2(wc * 32 + fr, 4 + fq)};
#define PG8_SA(b, h) (((b) * 2 + (h)) * HTB)
#define PG8_SB(b, h) ((4 + (b) * 2 + (h)) * HTB)
#define PG8_STAGE(bufoff, gbase, voff) do { _Pragma("unroll") for (int _i = 0; _i < 2; ++_i) \
        __builtin_amdgcn_global_load_lds((const unsigned*)((const char*)(gbase) + (voff)[_i]), (PG8_LAS unsigned*)(lds + (bufoff) + ldsw + _i * 8192), 16, 0, 0); } while (0)
#define PG8_LDA(dst, b, h) do { _Pragma("unroll") for (int m = 0; m < 4; ++m) _Pragma("unroll") for (int k = 0; k < 2; ++k) dst[m][k] = *(const PG8_LAS bf16x8*)(lds + PG8_SA(b, h) + aoffk[k] + m * 2048); } while (0)
#define PG8_LDB(dst, b, h) do { _Pragma("unroll") for (int n = 0; n < 2; ++n) _Pragma("unroll") for (int k = 0; k < 2; ++k) dst[n][k] = *(const PG8_LAS bf16x8*)(lds + PG8_SB(b, h) + boffk[k] + n * 2048); } while (0)
#define PG8_MMA(ai, bj, At, Bt) do { __builtin_amdgcn_s_setprio(1); _Pragma("unroll") for (int m = 0; m < 4; ++m) _Pragma("unroll") for (int n = 0; n < 2; ++n) _Pragma("unroll") for (int k = 0; k < 2; ++k) \
        acc[ai][bj][m][n] = __builtin_amdgcn_mfma_f32_16x16x32_bf16(Bt[n][k], At[m][k], acc[ai][bj][m][n], 0, 0, 0); __builtin_amdgcn_s_setprio(0); } while (0)
#define PG8_WAIT_V(n) asm volatile("s_waitcnt vmcnt(" #n ")" ::: "memory")
#define PG8_WAIT_L(n) asm volatile("s_waitcnt lgkmcnt(" #n ")" ::: "memory")
#define PG8_BAR __builtin_amdgcn_s_barrier()
#define PG8_SCHED __builtin_amdgcn_sched_barrier(0)
    Unit cur, nxt; int ui = 0;
    if (!S.next(0, cur)) return;
    f32x4 acc[2][2][4][2];
#pragma unroll
    for (int a = 0; a < 2; ++a)
#pragma unroll
        for (int b = 0; b < 2; ++b)
#pragma unroll
            for (int m = 0; m < 4; ++m)
#pragma unroll
                for (int n = 0; n < 2; ++n) acc[a][b][m][n] = (f32x4){0.f, 0.f, 0.f, 0.f};
    bf16x8 At[4][2], B0[2][2], B1[2][2];
    const char* cA = (const char*)g.A + (size_t)cur.pm * tstepA; const char* cB = (const char*)g.Bt + (size_t)cur.pn * tstepB;
    S.a_ready(cur);
    if constexpr (SP2) {
        PG8_STAGE(PG8_SB(0, 0), cB, voffB); PG8_STAGE(PG8_SB(0, 1), cB + hstepB, voffB); PG8_STAGE(PG8_SA(0, 0), cA, voffA); PG8_STAGE(PG8_SA(0, 1), cA + hstepA, voffA);
        if (wr == 1) PG8_BAR;
        PG8_WAIT_V(2); PG8_BAR;
        PG8_STAGE(PG8_SB(1, 0), cB + kstep, voffB); PG8_STAGE(PG8_SA(1, 0), cA + kstep, voffA); PG8_STAGE(PG8_SB(1, 1), cB + hstepB + kstep, voffB);
        PG8_WAIT_V(6); PG8_BAR;
    } else {
        PG8_STAGE(PG8_SB(0, 0), cB, voffB); PG8_STAGE(PG8_SA(0, 0), cA, voffA); PG8_STAGE(PG8_SB(0, 1), cB + hstepB, voffB); PG8_STAGE(PG8_SA(0, 1), cA + hstepA, voffA);
        if (wr == 1) PG8_BAR;
        PG8_WAIT_V(4); PG8_BAR;
        PG8_STAGE(PG8_SB(1, 0), cB + kstep, voffB); PG8_STAGE(PG8_SA(1, 0), cA + kstep, voffA); PG8_STAGE(PG8_SB(1, 1), cB + hstepB + kstep, voffB);
        PG8_WAIT_V(6); PG8_BAR;
    }
    for (;;) {
        const bool has_next = S.next(ui + 1, nxt);
        const char* nA = has_next ? (const char*)g.A + (size_t)nxt.pm * tstepA : cA; const char* nB = has_next ? (const char*)g.Bt + (size_t)nxt.pn * tstepB : cB;
        for (int t = 0; t < nt; t += 2) {
            const bool last = (t == nt - 2);
            const char* a1 = cA + (size_t)(t + 1) * kstep;
            const char* a2 = last ? nA : cA + (size_t)(t + 2) * kstep; const char* b2 = last ? nB : cB + (size_t)(t + 2) * kstep;
            const char* a3 = a2 + kstep; const char* b3 = b2 + kstep;
            if (last && has_next) S.a_ready(nxt);
            if constexpr (SP2) {
            PG8_LDB(B0, 0, 0); PG8_LDB(B1, 0, 1); PG8_SCHED; PG8_LDA(At, 0, 0); PG8_STAGE(PG8_SA(1, 1), a1 + hstepA, voffA);
            PG8_WAIT_V(8); PG8_WAIT_L(0); PG8_BAR; PG8_MMA(0, 0, At, B0); PG8_MMA(0, 1, At, B1); PG8_BAR; PG8_SCHED;
            PG8_LDA(At, 0, 1); PG8_STAGE(PG8_SB(0, 0), b2, voffB); PG8_STAGE(PG8_SB(0, 1), b2 + hstepB, voffB); PG8_STAGE(PG8_SA(0, 0), a2, voffA);
            PG8_WAIT_V(8); PG8_WAIT_L(0); PG8_BAR; PG8_MMA(1, 0, At, B0); PG8_MMA(1, 1, At, B1); PG8_BAR; PG8_SCHED;
            PG8_LDB(B0, 1, 0); PG8_LDB(B1, 1, 1); PG8_SCHED; PG8_LDA(At, 1, 0); PG8_STAGE(PG8_SA(0, 1), a2 + hstepA, voffA);
            PG8_WAIT_V(8); PG8_WAIT_L(0); PG8_BAR; PG8_MMA(0, 0, At, B0); PG8_MMA(0, 1, At, B1); PG8_BAR; PG8_SCHED;
            PG8_LDA(At, 1, 1); PG8_STAGE(PG8_SB(1, 0), b3, voffB); PG8_STAGE(PG8_SB(1, 1), b3 + hstepB, voffB); PG8_STAGE(PG8_SA(1, 0), a3, voffA);
            PG8_WAIT_V(8); PG8_WAIT_L(0); PG8_BAR; PG8_MMA(1, 0, At, B0); PG8_MMA(1, 1, At, B1); PG8_BAR; PG8_SCHED;
            } else {
            PG8_LDB(B0, 0, 0); PG8_SCHED; PG8_LDA(At, 0, 0); PG8_STAGE(PG8_SA(1, 1), a1 + hstepA, voffA);
            PG8_WAIT_L(8); PG8_BAR; PG8_WAIT_L(0); PG8_MMA(0, 0, At, B0); PG8_BAR; PG8_SCHED;
            PG8_LDB(B1, 0, 1); PG8_STAGE(PG8_SB(0, 0), b2, voffB);
            PG8_BAR; PG8_WAIT_L(0); PG8_MMA(0, 1, At, B1); PG8_BAR;
            PG8_LDA(At, 0, 1); PG8_STAGE(PG8_SA(0, 0), a2, voffA);
            PG8_BAR; PG8_WAIT_L(0); PG8_MMA(1, 0, At, B0); PG8_BAR; PG8_SCHED;
            PG8_STAGE(PG8_SB(0, 1), b2 + hstepB, voffB);
            PG8_WAIT_V(6); PG8_BAR; PG8_MMA(1, 1, At, B1); PG8_BAR;
            PG8_LDB(B0, 1, 0); PG8_SCHED; PG8_LDA(At, 1, 0); PG8_STAGE(PG8_SA(0, 1), a2 + hstepA, voffA);
            PG8_WAIT_L(8); PG8_BAR; PG8_WAIT_L(0); PG8_MMA(0, 0, At, B0); PG8_BAR; PG8_SCHED;
            PG8_LDB(B1, 1, 1); PG8_STAGE(PG8_SB(1, 0), b3, voffB);
            PG8_BAR; PG8_WAIT_L(0); PG8_MMA(0, 1, At, B1); PG8_BAR;
            PG8_LDA(At, 1, 1); PG8_STAGE(PG8_SA(1, 0), a3, voffA);
            PG8_BAR; PG8_WAIT_L(0); PG8_MMA(1, 0, At, B0); PG8_BAR; PG8_SCHED;
            PG8_STAGE(PG8_SB(1, 1), b3 + hstepB, voffB);
            PG8_WAIT_V(6); PG8_BAR; PG8_MMA(1, 1, At, B1); PG8_BAR;
            }
        }
        if constexpr (ALIGN_EPI) { if (wr == 0) PG8_BAR; }
        if constexpr (!Epi::AFTER_DRAIN) { E(acc, cur, wr, wc, fr, fq); S.done(cur); }
        if (!has_next) break;
#pragma unroll
        for (int a = 0; a < 2; ++a)
#pragma unroll
            for (int b = 0; b < 2; ++b)
#pragma unroll
                for (int m = 0; m < 4; ++m)
#pragma unroll
                    for (int n = 0; n < 2; ++n) acc[a][b][m][n] = (f32x4){0.f, 0.f, 0.f, 0.f};
        cur = nxt; cA = nA; cB = nB; ++ui;
        if constexpr (ALIGN_EPI) { if (wr == 1) PG8_BAR; }
    }
    PG8_WAIT_V(0);
    if constexpr (!ALIGN_EPI) { if (wr == 0) PG8_BAR; }
    PG8_BAR;
    if constexpr (Epi::AFTER_DRAIN) { E.fused(acc, cur, wr, wc, fr, fq, lds, wid, lane); S.done(cur); }
#undef PG8_SA
#undef PG8_SB
#undef PG8_STAGE
#undef PG8_LDA
#undef PG8_LDB
#undef PG8_MMA
#undef PG8_WAIT_V
#undef PG8_WAIT_L
#undef PG8_BAR
#undef PG8_SCHED
}
}

#include <hip/hip_bf16.h>
namespace attn_body {
using bf16=__hip_bfloat16;
using bf16x8=__attribute__((ext_vector_type(8)))short;
using s16x4=__attribute__((ext_vector_type(4)))short;
using f32x16=__attribute__((ext_vector_type(16)))float;
using u32x4=__attribute__((ext_vector_type(4)))unsigned;
constexpr int SEQ=8192,D=64,PQ=2560,PO=1024;
constexpr int NW=8,QBLK=32,QB=QBLK*NW,KVBLK=64,NQB=SEQ/QB;
constexpr int ATTN_UNIT_ROWS=QB;
__device__ __forceinline__ int crow(int r,int hi){return (r&3)+8*(r>>2)+4*hi;}
#define SBAR() __builtin_amdgcn_sched_barrier(0)
__device__ __forceinline__ void cmask(f32x16&p0,f32x16&p1,int jb,int qrel,int hi){
  const float NEG=-INFINITY; (void)hi;
  if(jb>(qrel>>6)){
  #pragma unroll
  for(int r=0;r<16;++r){p0[r]=NEG;p1[r]=NEG;}}
}

constexpr int NSLOT=3, SLOTB=8192;
constexpr int LDS_K=0, LDS_V=NSLOT*SLOTB, LDS_WS=2*NSLOT*SLOTB, LDS_OST=LDS_WS+NW*64*4, LDS_BYTES=LDS_OST+NW*4096;
constexpr float C2=0.125f*1.4426950408889634f;
__device__ __forceinline__ void glds16(const void*gsrc,unsigned lds_dst){unsigned keep;
  asm volatile("s_mov_b32 %0, m0\n\ts_mov_b32 m0, %2\n\ts_nop 0\n\tglobal_load_lds_dwordx4 %1, off\n\ts_mov_b32 m0, %0":"=&s"(keep):"v"(gsrc),"s"(lds_dst):"memory");}
__device__ __forceinline__ float max3f(float a,float b,float c){float r;asm("v_max3_f32 %0, %1, %2, %3":"=v"(r):"v"(a),"v"(b),"v"(c));return r;}
__device__ __forceinline__ float max2f(float a,float b){float r;asm("v_max_f32_e32 %0, %1, %2":"=v"(r):"v"(a),"v"(b));return r;}
__device__ __forceinline__ float fadd_s(float a,float b){float r;asm("v_add_f32_e32 %0, %1, %2":"=v"(r):"v"(a),"v"(b));return r;}
__device__ __forceinline__ float fsub_s(float a,float b){float r;asm("v_sub_f32_e32 %0, %1, %2":"=v"(r):"v"(a),"v"(b));return r;}
typedef float f32x2_t __attribute__((ext_vector_type(2))); typedef __bf16 bf16x2_t __attribute__((ext_vector_type(2)));
__device__ __forceinline__ unsigned cvtpk_s(float lo,float hi){f32x2_t v={lo,hi};bf16x2_t b=__builtin_convertvector(v,bf16x2_t);return __builtin_bit_cast(unsigned,b);}
#define WAIT_BAR(N) asm volatile("s_waitcnt vmcnt(" #N ") lgkmcnt(0)\n\ts_barrier":::"memory")

__device__ __forceinline__ void qkt(f32x16&p0,f32x16&p1,const char*Kslot,const bf16x8*qr,const f32x16&negm,int r32,int hi){
  const char*kb=Kslot+hi*1024+r32*16;
  #pragma unroll
  for(int d0=0;d0<4;++d0){
    const bf16x8 b0=*reinterpret_cast<const bf16x8*>(kb+d0*2048);
    const bf16x8 b1=*reinterpret_cast<const bf16x8*>(kb+d0*2048+512);
    if(d0==0){p0=__builtin_amdgcn_mfma_f32_32x32x16_bf16(b0,qr[0],negm,0,0,0);p1=__builtin_amdgcn_mfma_f32_32x32x16_bf16(b1,qr[0],negm,0,0,0);}
    else{p0=__builtin_amdgcn_mfma_f32_32x32x16_bf16(b0,qr[d0],p0,0,0,0);p1=__builtin_amdgcn_mfma_f32_32x32x16_bf16(b1,qr[d0],p1,0,0,0);}}
}
typedef __attribute__((address_space(3))) const char* lds_cptr;
typedef short v4i16_t __attribute__((ext_vector_type(4)));
__device__ __forceinline__ void kload8(bf16x8*kf,lds_cptr kp){
  kf[0]=*(const __attribute__((address_space(3))) bf16x8*)(kp);      kf[1]=*(const __attribute__((address_space(3))) bf16x8*)(kp+512);
  kf[2]=*(const __attribute__((address_space(3))) bf16x8*)(kp+2048); kf[3]=*(const __attribute__((address_space(3))) bf16x8*)(kp+2560);
  kf[4]=*(const __attribute__((address_space(3))) bf16x8*)(kp+4096); kf[5]=*(const __attribute__((address_space(3))) bf16x8*)(kp+4608);
  kf[6]=*(const __attribute__((address_space(3))) bf16x8*)(kp+6144); kf[7]=*(const __attribute__((address_space(3))) bf16x8*)(kp+6656);
}
__device__ __forceinline__ void kload2(bf16x8*kf,lds_cptr kp,int j){ kf[2*j]=*(const __attribute__((address_space(3))) bf16x8*)(kp+j*2048); kf[2*j+1]=*(const __attribute__((address_space(3))) bf16x8*)(kp+j*2048+512); }
__device__ __forceinline__ s16x4 vtr(lds_cptr p){ return __builtin_bit_cast(s16x4,__builtin_amdgcn_ds_read_tr16_b64_v4i16((__attribute__((address_space(3))) v4i16_t*)p)); }
__device__ __forceinline__ float rowmax(const f32x16&p0,const f32x16&p1){
  float a=max3f(p0[0],p0[1],p1[0]),b=max3f(p0[2],p0[3],p1[1]);a=max3f(a,p1[2],p1[3]);
  #pragma unroll
  for(int r=4;r<16;r+=4){a=max3f(a,p0[r],p0[r+1]);b=max3f(b,p0[r+2],p0[r+3]);a=max3f(a,p1[r],p1[r+1]);b=max3f(b,p1[r+2],p1[r+3]);}
  const float m=max2f(a,b);
  auto rr=__builtin_amdgcn_permlane32_swap(__float_as_uint(m),__float_as_uint(m),false,false);
  return max2f(__uint_as_float(rr[0]),__uint_as_float(rr[1]));
}
__device__ __forceinline__ void pv(f32x16*o,int vb,bf16x8 pa0,bf16x8 pa1,bf16x8 pa2,bf16x8 pa3){
  #pragma unroll
  for(int d0=0;d0<2;++d0){s16x4 lo[4],hi[4];
    #pragma unroll
    for(int ks=0;ks<4;++ks){
      asm volatile("ds_read_b64_tr_b16 %0,%1 offset:%c2":"=&v"(lo[ks]):"v"(vb),"i"(d0*4096+ks*1024):"memory");
      asm volatile("ds_read_b64_tr_b16 %0,%1 offset:%c2":"=&v"(hi[ks]):"v"(vb),"i"(d0*4096+ks*1024+512):"memory");}
    asm volatile("s_waitcnt lgkmcnt(0)":::"memory");SBAR();
    #define PK(k) (bf16x8){lo[k][0],lo[k][1],lo[k][2],lo[k][3],hi[k][0],hi[k][1],hi[k][2],hi[k][3]}
    o[d0]=__builtin_amdgcn_mfma_f32_32x32x16_bf16(pa0,PK(0),o[d0],0,0,0);
    o[d0]=__builtin_amdgcn_mfma_f32_32x32x16_bf16(pa1,PK(1),o[d0],0,0,0);
    o[d0]=__builtin_amdgcn_mfma_f32_32x32x16_bf16(pa2,PK(2),o[d0],0,0,0);
    o[d0]=__builtin_amdgcn_mfma_f32_32x32x16_bf16(pa3,PK(3),o[d0],0,0,0);
    #undef PK
  }
}

#ifndef ATTN_STORE16
#define ATTN_STORE16(p,v) (*(u32x4*)(p)=(v))
#endif
template<int THRL> __device__ __forceinline__ void attn_unit(int b,int qb,const bf16*Q,const bf16*__restrict__ K,const bf16*__restrict__ V,bf16*O,char*shm){
  int tid_=threadIdx.x; asm volatile("":"+v"(tid_)); const int tid=tid_,lane=tid&63,r32=lane&31,hi=lane>>5; const int wid=__builtin_amdgcn_readfirstlane(tid>>6);
  const long rowbase=(long)b*SEQ; const int q0=qb*QB;
  const bf16*Qw=Q+(rowbase+q0+wid*QBLK)*PQ;
  const bf16*Kh=K+rowbase*PQ,*Vh=V+rowbase*PQ;
  const unsigned lds0=(unsigned)(uintptr_t)shm;
  float*wsf=(float*)(shm+LDS_WS)+wid*64;
  const bf16*ksrc=Kh+(long)lane*PQ+wid*8;
  const bf16*vsrc=Vh+(long)(16*(wid&3)+(lane>>2))*PQ+(wid>>2)*32+(lane&3)*8;
  const unsigned kdst=lds0+LDS_K+wid*1024, vdst=lds0+LDS_V+wid*1024;
  #define DMA_K(t,slot) glds16(ksrc+(long)(t)*KVBLK*PQ,(unsigned)__builtin_amdgcn_readfirstlane(kdst+(slot)))
  #define DMA_V(t,slot) glds16(vsrc+(long)(t)*KVBLK*PQ,(unsigned)__builtin_amdgcn_readfirstlane(vdst+(slot)))
  const int vb0=(int)(lds0+LDS_V)+((lane>>4)&1)*32+(lane&3)*8+(4*hi+((lane&15)>>2))*64;
  const char*Kbase=shm+LDS_K; bf16x8 kf[8];
  const lds_cptr shm3=(lds_cptr)shm; const lds_cptr kp0=shm3+LDS_K+hi*1024+r32*16; const lds_cptr vp0=shm3+LDS_V+((lane>>4)&1)*32+(lane&3)*8+(4*hi+((lane&15)>>2))*64;
  const int NT=(q0+QB)/KVBLK;
  DMA_K(0,0);DMA_V(0,0);DMA_K(1,SLOTB);
  bf16x8 qr[4];
  #pragma unroll
  for(int d0=0;d0<4;++d0)qr[d0]=*reinterpret_cast<const bf16x8*>(&Qw[(long)r32*PQ+d0*16+hi*8]);
  float mhat=0.f,l_reg=0.f;f32x16 o[2];o[0]=f32x16{};o[1]=f32x16{};f32x16 negm=f32x16{};asm volatile("":"+v"(negm));
  const int qrel=wid*QBLK+r32;
  #define CMASK(P0,P1,t) do{int jb_=(t)-(NT-4); if(jb_>=0)cmask(P0,P1,jb_,qrel,hi);}while(0)
  bool resc=false;
  #define START(P0,P1) do{ const float rm=rowmax(P0,P1); resc=false; \
    { const float dl=rm; mhat=fadd_s(mhat,dl); \
      _Pragma("unroll") for(int r=0;r<16;++r){P0[r]=fsub_s(P0[r],dl);P1[r]=fsub_s(P1[r],dl);} \
      _Pragma("unroll") for(int r=0;r<16;++r)negm[r]=-mhat; asm volatile("":"+v"(negm)); } \
    _Pragma("unroll") for(int r=0;r<16;++r)P0[r]=__builtin_amdgcn_exp2f(P0[r]); }while(0)
  #define RESC() do{ if(resc){ asm volatile("s_waitcnt lgkmcnt(0)":::"memory"); \
      _Pragma("unroll") for(int d_=0;d_<2;++d_) _Pragma("unroll") for(int r=0;r<16;++r)o[d_][r]*=wsf[crow(r,hi)]; } }while(0)
  f32x16 pA0,pA1,pB0,pB1;
  int sl_prev=0,sl_cur=0,sl_next=SLOTB;
  #define ROT() do{sl_prev=sl_cur;sl_cur=sl_next;sl_next=(sl_next==(NSLOT-1)*SLOTB)?0:sl_next+SLOTB;}while(0)
  DMA_K(2,2*SLOTB);
  WAIT_BAR(3);
  qkt(pA0,pA1,Kbase,qr,negm,r32,hi);asm volatile("s_nop 15\n\ts_nop 7":"+v"(pA0),"+v"(pA1));CMASK(pA0,pA1,0);
  START(pA0,pA1);
  _Pragma("unroll") for(int r=0;r<16;++r)pA1[r]=__builtin_amdgcn_exp2f(pA1[r]);
  WAIT_BAR(0);
  DMA_K(3,0);DMA_V(1,SLOTB);
  ROT();
  kload8(kf,kp0+sl_cur);
  WAIT_BAR(2);
  s16x4 vlo[8],vhi[8]; u32x4 pw0,pw1,pw2,pw3;
  #define PKW(P,B) cvtpk_s(P[B],P[B+1])
  #define PAF(k) __builtin_bit_cast(bf16x8,pw##k)
  #define VFR(i) (bf16x8){vlo[i][0],vlo[i][1],vlo[i][2],vlo[i][3],vhi[i][0],vhi[i][1],vhi[i][2],vhi[i][3]}
  #define PIN(x) asm volatile("":"+v"(x))
  #define MX3(a,b,c) __builtin_fmaxf(__builtin_fmaxf((a),(b)),(c))
  #define GAPA(MF,A0,A1,A2,A3,W0,W1,PW) do{ MF; sacc+=A0; sacc+=A1; sacc+=A2; sacc+=A3; PIN(sacc); W0; W1; PIN(PW); SBAR(); }while(0)
  #define EX(v) __builtin_amdgcn_exp2f(v)
  #define GAPB(MF,X,B) do{ MF; X[B]=EX(X[B]); X[B+1]=EX(X[B+1]); X[B+2]=EX(X[B+2]); X[B+3]=EX(X[B+3]); PIN(X); SBAR(); }while(0)
  #define VRD(i) do{ vlo[i]=vtr(vp_+(((i)>>2)*4096+((i)&3)*1024)); vhi[i]=vtr(vp_+(((i)>>2)*4096+((i)&3)*1024+512)); }while(0)
  #define KRD(G,j) do{ if(G){ kload2(kf,kp0+sl_next,j); SBAR(); } }while(0)
  #define STEP(C0,C1,P0,P1,t,GK,GV,GL) do{ SBAR(); \
    const lds_cptr vp_=vp0+sl_prev; \
    VRD(0); SBAR(); float sacc=(P0[0]+P0[1]); \
    GAPA(C0=__builtin_amdgcn_mfma_f32_32x32x16_bf16(kf[0],qr[0],negm,0,0,0), P0[2],P0[3],P0[4],P0[5],     pw0[0]=PKW(P0,0), pw0[1]=PKW(P0,2), pw0); \
    VRD(4); SBAR(); GAPA(C1=__builtin_amdgcn_mfma_f32_32x32x16_bf16(kf[1],qr[0],negm,0,0,0), P0[6],P0[7],P0[8],P0[9],     pw0[2]=PKW(P0,4), pw0[3]=PKW(P0,6), pw0); \
    VRD(1); SBAR(); GAPA(C0=__builtin_amdgcn_mfma_f32_32x32x16_bf16(kf[2],qr[1],C0,0,0,0),   P0[10],P0[11],P0[12],P0[13], pw1[0]=PKW(P0,8), pw1[1]=PKW(P0,10), pw1); \
    VRD(5); SBAR(); GAPA(C1=__builtin_amdgcn_mfma_f32_32x32x16_bf16(kf[3],qr[1],C1,0,0,0),   P0[14],P0[15],P1[0],P1[1],   pw1[2]=PKW(P0,12),pw1[3]=PKW(P0,14), pw1); \
    VRD(2); SBAR(); GAPA(C0=__builtin_amdgcn_mfma_f32_32x32x16_bf16(kf[4],qr[2],C0,0,0,0),   P1[2],P1[3],P1[4],P1[5],     pw2[0]=PKW(P1,0), pw2[1]=PKW(P1,2), pw2); \
    VRD(6); SBAR(); GAPA(C1=__builtin_amdgcn_mfma_f32_32x32x16_bf16(kf[5],qr[2],C1,0,0,0),   P1[6],P1[7],P1[8],P1[9],     pw2[2]=PKW(P1,4), pw2[3]=PKW(P1,6), pw2); \
    VRD(3); SBAR(); GAPA(C0=__builtin_amdgcn_mfma_f32_32x32x16_bf16(kf[6],qr[3],C0,0,0,0),   P1[10],P1[11],P1[12],P1[13], pw3[0]=PKW(P1,8), pw3[1]=PKW(P1,10), pw3); \
    VRD(7); SBAR(); GAPA(C1=__builtin_amdgcn_mfma_f32_32x32x16_bf16(kf[7],qr[3],C1,0,0,0),   P1[14],P1[15],0.f,0.f,       pw3[2]=PKW(P1,12),pw3[3]=PKW(P1,14), pw3); \
    l_reg+=sacc; \
    if(GK){DMA_K((t)+3,sl_cur);} if(GV){DMA_V((t)+1,sl_next);} \
    CMASK(C0,C1,t); \
    { float a=MX3(C0[0],C0[1],C1[0]),b=MX3(C0[2],C0[3],C1[1]); a=MX3(a,C1[2],C1[3]); \
      _Pragma("unroll") for(int r=4;r<16;r+=4){a=MX3(a,C0[r],C0[r+1]);b=MX3(b,C0[r+2],C0[r+3]);a=MX3(a,C1[r],C1[r+1]);b=MX3(b,C1[r+2],C1[r+3]);} \
      float rm=__builtin_fmaxf(a,b); { auto rr=__builtin_amdgcn_permlane32_swap(__float_as_uint(rm),__float_as_uint(rm),false,false); rm=__builtin_fmaxf(__uint_as_float(rr[0]),__uint_as_float(rr[1])); } \
      resc=false; \
      if(__builtin_expect(__any(rm>(float)THRL),0)){ const float dl=__builtin_fmaxf(rm,0.f); mhat+=dl; \
        _Pragma("unroll") for(int r=0;r<16;++r){C0[r]-=dl;C1[r]-=dl;} \
        _Pragma("unroll") for(int r=0;r<16;++r)negm[r]=-mhat; asm volatile("":"+v"(negm)); \
        const float f=__builtin_amdgcn_exp2f(-dl); l_reg*=f; if(hi==0)wsf[r32]=f; resc=true; } } \
    SBAR(); \
    GAPB(o[0]=__builtin_amdgcn_mfma_f32_32x32x16_bf16(PAF(0),VFR(0),o[0],0,0,0), C0,0); \
    GAPB(o[1]=__builtin_amdgcn_mfma_f32_32x32x16_bf16(PAF(0),VFR(4),o[1],0,0,0), C0,4); \
    KRD(GL,0); GAPB(o[0]=__builtin_amdgcn_mfma_f32_32x32x16_bf16(PAF(1),VFR(1),o[0],0,0,0), C0,8); \
    KRD(GL,1); GAPB(o[1]=__builtin_amdgcn_mfma_f32_32x32x16_bf16(PAF(1),VFR(5),o[1],0,0,0), C0,12); \
    KRD(GL,2); GAPB(o[0]=__builtin_amdgcn_mfma_f32_32x32x16_bf16(PAF(2),VFR(2),o[0],0,0,0), C1,0); \
    KRD(GL,3); GAPB(o[1]=__builtin_amdgcn_mfma_f32_32x32x16_bf16(PAF(2),VFR(6),o[1],0,0,0), C1,4); \
    GAPB(o[0]=__builtin_amdgcn_mfma_f32_32x32x16_bf16(PAF(3),VFR(3),o[0],0,0,0), C1,8); \
    GAPB(o[1]=__builtin_amdgcn_mfma_f32_32x32x16_bf16(PAF(3),VFR(7),o[1],0,0,0), C1,12); \
    }while(0)
  int t=1;
  #undef CMASK
  #define CMASK(P0,P1,t) do{}while(0)
  for(;t+5<NT;t+=2){
    STEP(pB0,pB1,pA0,pA1,t,true,true,true);     WAIT_BAR(2); RESC(); ROT();
    STEP(pA0,pA1,pB0,pB1,t+1,true,true,true);   WAIT_BAR(2); RESC(); ROT();
  }
  #undef CMASK
  #define CMASK(P0,P1,t) do{int jb_=(t)-(NT-4); if(jb_>=0)cmask(P0,P1,jb_,qrel,hi);}while(0)
  #define ENDW(tt) do{ if((tt)+3<NT){WAIT_BAR(2);} else if((tt)+2<NT){WAIT_BAR(1);} else {WAIT_BAR(0);} }while(0)
  for(;t+1<NT;t+=2){
    STEP(pB0,pB1,pA0,pA1,t,(t+3<NT),(t+1<NT),(t+1<NT));       ENDW(t);   RESC(); ROT();
    STEP(pA0,pA1,pB0,pB1,t+1,(t+4<NT),(t+2<NT),(t+2<NT));     ENDW(t+1); RESC(); ROT();
  }
  STEP(pB0,pB1,pA0,pA1,NT-1,false,false,false); RESC();
  { float sacc=pB0[0]+pB0[1]; _Pragma("unroll") for(int r=2;r<16;++r)sacc+=pB0[r]; _Pragma("unroll") for(int r=0;r<16;++r)sacc+=pB1[r]; l_reg+=sacc;
    pw0=(u32x4){PKW(pB0,0),PKW(pB0,2),PKW(pB0,4),PKW(pB0,6)};pw1=(u32x4){PKW(pB0,8),PKW(pB0,10),PKW(pB0,12),PKW(pB0,14)};pw2=(u32x4){PKW(pB1,0),PKW(pB1,2),PKW(pB1,4),PKW(pB1,6)};pw3=(u32x4){PKW(pB1,8),PKW(pB1,10),PKW(pB1,12),PKW(pB1,14)};
    SBAR(); pv(o,vb0+sl_cur,PAF(0),PAF(1),PAF(2),PAF(3)); }
  #undef PKW
  #undef PAF
  #undef VFR
  #undef PIN
  #undef MX3
  #undef GAPA
  #undef GAPB
  #undef EX
  #undef VRD
  #undef KRD
  #undef STEP
  #undef ENDW
  {auto rr=__builtin_amdgcn_permlane32_swap(__float_as_uint(l_reg),__float_as_uint(l_reg),false,false);l_reg=__uint_as_float(rr[0])+__uint_as_float(rr[1]);}
  if(hi==0)wsf[32+r32]=l_reg;asm volatile("s_waitcnt lgkmcnt(0)":::"memory");
  float rli[16];
  #pragma unroll
  for(int r=0;r<16;++r)rli[r]=__builtin_amdgcn_rcpf(wsf[32+crow(r,hi)]);
  bf16*Ow=O+(rowbase+q0+wid*QBLK)*PO;
  { bf16*stg=(bf16*)(shm+LDS_OST)+wid*2048;
    #pragma unroll
    for(int r=0;r<16;++r){const int orow=crow(r,hi);
      #pragma unroll
      for(int d0=0;d0<2;++d0)stg[orow*64+d0*32+r32]=__float2bfloat16(o[d0][r]*rli[r]);}
    asm volatile("s_waitcnt lgkmcnt(0)":::"memory");
    #pragma unroll
    for(int i=0;i<4;++i){const int row=i*8+(lane>>3),ch=lane&7; const u32x4 v=*(const u32x4*)(stg+row*64+ch*8); ATTN_STORE16(Ow+(long)row*PO+ch*8,v);} }
  asm volatile("s_waitcnt lgkmcnt(0)\n\ts_barrier":::"memory");
  #undef DMA_K
  #undef DMA_V
  #undef CMASK
  #undef START
  #undef RESC
  #undef ROT
}


#define PV128_RD(LO,HI,vp,goff) do{ _Pragma("unroll") for(int ks=0;ks<4;++ks){ LO[ks]=vtr((vp)+((goff)+ks*1024)); HI[ks]=vtr((vp)+((goff)+ks*1024+512)); } }while(0)
#define PV128_MM(O,LO,HI) do{ \
    O=__builtin_amdgcn_mfma_f32_32x32x16_bf16(pa0,(bf16x8){LO[0][0],LO[0][1],LO[0][2],LO[0][3],HI[0][0],HI[0][1],HI[0][2],HI[0][3]},O,0,0,0); \
    O=__builtin_amdgcn_mfma_f32_32x32x16_bf16(pa1,(bf16x8){LO[1][0],LO[1][1],LO[1][2],LO[1][3],HI[1][0],HI[1][1],HI[1][2],HI[1][3]},O,0,0,0); \
    O=__builtin_amdgcn_mfma_f32_32x32x16_bf16(pa2,(bf16x8){LO[2][0],LO[2][1],LO[2][2],LO[2][3],HI[2][0],HI[2][1],HI[2][2],HI[2][3]},O,0,0,0); \
    O=__builtin_amdgcn_mfma_f32_32x32x16_bf16(pa3,(bf16x8){LO[3][0],LO[3][1],LO[3][2],LO[3][3],HI[3][0],HI[3][1],HI[3][2],HI[3][3]},O,0,0,0); }while(0)
__device__ __forceinline__ void pv128(f32x16*o,lds_cptr vp,s16x4 (&loA)[4],s16x4 (&hiA)[4],bf16x8 pa0,bf16x8 pa1,bf16x8 pa2,bf16x8 pa3){
  s16x4 loB[4],hiB[4];
  PV128_RD(loB,hiB,vp,4096);      SBAR(); PV128_MM(o[0],loA,hiA); SBAR();
  PV128_RD(loA,hiA,vp,8192);      SBAR(); PV128_MM(o[1],loB,hiB); SBAR();
  PV128_RD(loB,hiB,vp,8192+4096); SBAR(); PV128_MM(o[2],loA,hiA); SBAR();
  PV128_MM(o[3],loB,hiB);
}
namespace dfa { constexpr int DK=0, DV=3*8192, DWS=DV+3*16384, DOST=0, BYTES=DWS+2048; }
template<int THR> __device__ __forceinline__ void diff_unit(int b,int qb,const bf16*Q,const bf16*__restrict__ K,const bf16*__restrict__ V,bf16*O,char*shm){
  int tid_=threadIdx.x; asm volatile("":"+v"(tid_)); const int tid=tid_,lane=tid&63,r32=lane&31,hi=lane>>5; const int wid=__builtin_amdgcn_readfirstlane(tid>>6);
  const long rowbase=(long)b*SEQ; const int q0=qb*QB;
  const bf16*Qw=Q+(rowbase+q0+wid*QBLK)*PQ;
  const bf16*Kh=K+rowbase*PQ,*Vh=V+rowbase*PQ;
  const unsigned lds0=(unsigned)(uintptr_t)shm;
  float*wsf=(float*)(shm+dfa::DWS)+wid*64;
  const bf16*ksrc=Kh+(long)lane*PQ+wid*8;
  const bf16*vsrc=Vh+(long)(16*(wid&3)+(lane>>2))*PQ+(wid>>2)*32+(lane&3)*8;
  const unsigned kdst=lds0+dfa::DK+wid*1024, vdst=lds0+dfa::DV+wid*1024;
  #define DFA_DMA(t,sK,sV) do{ glds16(ksrc+(long)(t)*KVBLK*PQ,(unsigned)__builtin_amdgcn_readfirstlane(kdst+(sK))); \
      glds16(vsrc+(long)(t)*KVBLK*PQ,(unsigned)__builtin_amdgcn_readfirstlane(vdst+(sV))); glds16(vsrc+(long)(t)*KVBLK*PQ+64,(unsigned)__builtin_amdgcn_readfirstlane(vdst+(sV)+8192)); }while(0)
  const lds_cptr vp0=(lds_cptr)shm+dfa::DV+((lane>>4)&1)*32+(lane&3)*8+(4*hi+((lane&15)>>2))*64;
  const int NT=(q0+QB)/KVBLK, tlast=NT-4+(wid>>1);
  DFA_DMA(0,0,0); DFA_DMA(1,8192,16384);
  bf16x8 qr[4];
  #pragma unroll
  for(int d0=0;d0<4;++d0)qr[d0]=*reinterpret_cast<const bf16x8*>(&Qw[(long)r32*PQ+d0*16+hi*8]);
  asm volatile("":"+v"(qr[0]),"+v"(qr[1]),"+v"(qr[2]),"+v"(qr[3]));
  float l_reg=0.f; f32x16 o[4]; o[0]=f32x16{}; o[1]=f32x16{}; o[2]=f32x16{}; o[3]=f32x16{}; f32x16 negm=f32x16{};
  int sK=0,sV=0,sK2=2*8192,sV2=2*16384;
  for(int t=0;t<NT;++t){
    if(t+1<NT){WAIT_BAR(3);}else{WAIT_BAR(0);}
    if(t+2<NT){DFA_DMA(t+2,sK2,sV2);}
    if(t<=tlast){
      f32x16 p0,p1; qkt(p0,p1,shm+dfa::DK+sK,qr,negm,r32,hi);
      const lds_cptr vpt=vp0+sV; s16x4 vlo0[4],vhi0[4]; PV128_RD(vlo0,vhi0,vpt,0); SBAR();
      float rm=p0[0];
      #pragma unroll
      for(int r=0;r<16;++r){rm=__builtin_fmaxf(rm,p0[r]);rm=__builtin_fmaxf(rm,p1[r]);}
      { auto rr=__builtin_amdgcn_permlane32_swap(__float_as_uint(rm),__float_as_uint(rm),false,false); rm=__builtin_fmaxf(__uint_as_float(rr[0]),__uint_as_float(rr[1])); }
      if(t==0||__any(rm>(float)THR)){
        const float dl=(t==0)?rm:__builtin_fmaxf(rm,0.f);
        #pragma unroll
        for(int r=0;r<16;++r){p0[r]-=dl;p1[r]-=dl;negm[r]-=dl;}
        if(t!=0){ const float f=__builtin_amdgcn_exp2f(-dl); l_reg*=f; if(hi==0)wsf[r32]=f; asm volatile("s_waitcnt lgkmcnt(0)":::"memory");
          #pragma unroll
          for(int r=0;r<16;++r){const float fr_=wsf[crow(r,hi)]; o[0][r]*=fr_; o[1][r]*=fr_; o[2][r]*=fr_; o[3][r]*=fr_;} }
      }
      float sacc=0.f;
      #pragma unroll
      for(int r=0;r<16;++r){p0[r]=__builtin_amdgcn_exp2f(p0[r]);p1[r]=__builtin_amdgcn_exp2f(p1[r]);sacc+=p0[r]+p1[r];}
      l_reg+=sacc;
      u32x4 pw0,pw1,pw2,pw3;
      pw0=(u32x4){cvtpk_s(p0[0],p0[1]),cvtpk_s(p0[2],p0[3]),cvtpk_s(p0[4],p0[5]),cvtpk_s(p0[6],p0[7])};
      pw1=(u32x4){cvtpk_s(p0[8],p0[9]),cvtpk_s(p0[10],p0[11]),cvtpk_s(p0[12],p0[13]),cvtpk_s(p0[14],p0[15])};
      pw2=(u32x4){cvtpk_s(p1[0],p1[1]),cvtpk_s(p1[2],p1[3]),cvtpk_s(p1[4],p1[5]),cvtpk_s(p1[6],p1[7])};
      pw3=(u32x4){cvtpk_s(p1[8],p1[9]),cvtpk_s(p1[10],p1[11]),cvtpk_s(p1[12],p1[13]),cvtpk_s(p1[14],p1[15])};
      SBAR(); pv128(o,vpt,vlo0,vhi0,__builtin_bit_cast(bf16x8,pw0),__builtin_bit_cast(bf16x8,pw1),__builtin_bit_cast(bf16x8,pw2),__builtin_bit_cast(bf16x8,pw3));
    }
    sK2=sK; sV2=sV; sK=(sK==2*8192)?0:sK+8192; sV=(sV==2*16384)?0:sV+16384;
  }
  asm volatile("s_waitcnt lgkmcnt(0)\n\ts_barrier":::"memory");
  {auto rr=__builtin_amdgcn_permlane32_swap(__float_as_uint(l_reg),__float_as_uint(l_reg),false,false);l_reg=__uint_as_float(rr[0])+__uint_as_float(rr[1]);}
  if(hi==0)wsf[32+r32]=l_reg;asm volatile("s_waitcnt lgkmcnt(0)":::"memory");
  float rli[16];
  #pragma unroll
  for(int r=0;r<16;++r)rli[r]=__builtin_amdgcn_rcpf(wsf[32+crow(r,hi)]);
  bf16*Ow=O+(rowbase+q0+wid*QBLK)*PO;
  { bf16*stg=(bf16*)(shm+dfa::DOST)+wid*4096;
    #pragma unroll
    for(int r=0;r<16;++r){const int orow=crow(r,hi);
      #pragma unroll
      for(int d0=0;d0<4;++d0)stg[orow*128+d0*32+r32]=__float2bfloat16(o[d0][r]*rli[r]);}
    asm volatile("s_waitcnt lgkmcnt(0)":::"memory");
    #pragma unroll
    for(int i=0;i<8;++i){const int idx=i*64+lane,row=idx>>4,ch=idx&15; const u32x4 v=*(const u32x4*)(stg+row*128+ch*8); ATTN_STORE16(Ow+(long)row*PO+ch*8,v);} }
  asm volatile("s_waitcnt lgkmcnt(0)\n\ts_barrier":::"memory");
  #undef DFA_DMA
}

namespace dfb { constexpr int NS=5, DK=0, DV=NS*8192, DWS=DV+NS*16384, DOST=0, BYTES=DWS+2048; }
#ifndef IGLP_MODE
#define IGLP_MODE 1
#endif
template<int THR> __device__ __forceinline__ void diff_unit2(int b,int qb,const bf16*Q,const bf16*__restrict__ K,const bf16*__restrict__ V,bf16*O,char*shm){
  int tid_=threadIdx.x; asm volatile("":"+v"(tid_)); const int tid=tid_,lane=tid&63,r32=lane&31,hi=lane>>5; const int wid=__builtin_amdgcn_readfirstlane(tid>>6);
  const long rowbase=(long)b*SEQ; const int q0=qb*QB;
  const bf16*Qw=Q+(rowbase+q0+wid*QBLK)*PQ;
  const bf16*Kh=K+rowbase*PQ,*Vh=V+rowbase*PQ;
  const unsigned lds0=(unsigned)(uintptr_t)shm;
  float*wsf=(float*)(shm+dfb::DWS)+wid*64;
  const bf16*ksrc=Kh+(long)lane*PQ+wid*8;
  const bf16*vsrc=Vh+(long)(16*(wid&3)+(lane>>2))*PQ+(wid>>2)*32+(lane&3)*8;
  const unsigned kdst=lds0+dfb::DK+wid*1024, vdst=lds0+dfb::DV+wid*1024;
  #define DFB_DMA(t,s_) do{ glds16(ksrc+(long)(t)*KVBLK*PQ,(unsigned)__builtin_amdgcn_readfirstlane(kdst+s_*8192)); \
      glds16(vsrc+(long)(t)*KVBLK*PQ,(unsigned)__builtin_amdgcn_readfirstlane(vdst+s_*16384)); glds16(vsrc+(long)(t)*KVBLK*PQ+64,(unsigned)__builtin_amdgcn_readfirstlane(vdst+s_*16384+8192)); }while(0)
  const lds_cptr vp0=(lds_cptr)shm+dfb::DV+((lane>>4)&1)*32+(lane&3)*8+(4*hi+((lane&15)>>2))*64;
  const int NT=(q0+QB)/KVBLK, tlast=NT-4+(wid>>1);
  const lds_cptr kp0=(lds_cptr)shm+dfb::DK+hi*1024+r32*16;
  DFB_DMA(0,0); DFB_DMA(1,1); DFB_DMA(2,2);
  bf16x8 qr[4];
  #pragma unroll
  for(int d0=0;d0<4;++d0)qr[d0]=*reinterpret_cast<const bf16x8*>(&Qw[(long)r32*PQ+d0*16+hi*8]);
  asm volatile("":"+v"(qr[0]),"+v"(qr[1]),"+v"(qr[2]),"+v"(qr[3]));
  float l_reg=0.f; f32x16 o[4]; o[0]=f32x16{}; o[1]=f32x16{}; o[2]=f32x16{}; o[3]=f32x16{}; f32x16 negm=f32x16{};
  f32x16 s0,s1;
  u32x4 pw0,pw1,pw2,pw3;
  #define DFB_SOFTMAX() do{ float sacc=0.f; _Pragma("unroll") for(int r=0;r<16;++r){s0[r]=__builtin_amdgcn_exp2f(s0[r]);s1[r]=__builtin_amdgcn_exp2f(s1[r]);sacc+=s0[r]+s1[r];} l_reg+=sacc; \
      pw0=(u32x4){cvtpk_s(s0[0],s0[1]),cvtpk_s(s0[2],s0[3]),cvtpk_s(s0[4],s0[5]),cvtpk_s(s0[6],s0[7])}; \
      pw1=(u32x4){cvtpk_s(s0[8],s0[9]),cvtpk_s(s0[10],s0[11]),cvtpk_s(s0[12],s0[13]),cvtpk_s(s0[14],s0[15])}; \
      pw2=(u32x4){cvtpk_s(s1[0],s1[1]),cvtpk_s(s1[2],s1[3]),cvtpk_s(s1[4],s1[5]),cvtpk_s(s1[6],s1[7])}; \
      pw3=(u32x4){cvtpk_s(s1[8],s1[9]),cvtpk_s(s1[10],s1[11]),cvtpk_s(s1[12],s1[13]),cvtpk_s(s1[14],s1[15])}; }while(0)
  #define DFB_PV(sv) do{ const int vbt=vb0+(sv)*16384; \
      pv(o,vbt,__builtin_bit_cast(bf16x8,pw0),__builtin_bit_cast(bf16x8,pw1),__builtin_bit_cast(bf16x8,pw2),__builtin_bit_cast(bf16x8,pw3)); \
      pv(o+2,vbt+8192,__builtin_bit_cast(bf16x8,pw0),__builtin_bit_cast(bf16x8,pw1),__builtin_bit_cast(bf16x8,pw2),__builtin_bit_cast(bf16x8,pw3)); }while(0)
  #define DFB_REF(FIRST) do{ float rm=s0[0]; _Pragma("unroll") for(int r=0;r<16;++r){rm=__builtin_fmaxf(rm,s0[r]);rm=__builtin_fmaxf(rm,s1[r]);} \
      { auto rr=__builtin_amdgcn_permlane32_swap(__float_as_uint(rm),__float_as_uint(rm),false,false); rm=__builtin_fmaxf(__uint_as_float(rr[0]),__uint_as_float(rr[1])); } \
      if((FIRST)||__any(rm>(float)THR)){ const float dl=(FIRST)?rm:__builtin_fmaxf(rm,0.f); \
        _Pragma("unroll") for(int r=0;r<16;++r){s0[r]-=dl;s1[r]-=dl;negm[r]-=dl;} \
        if(!(FIRST)){ const float f=__builtin_amdgcn_exp2f(-dl); l_reg*=f; if(hi==0)wsf[r32]=f; asm volatile("s_waitcnt lgkmcnt(0)":::"memory"); \
          _Pragma("unroll") for(int r=0;r<16;++r){const float fr_=wsf[crow(r,hi)]; o[0][r]*=fr_; o[1][r]*=fr_; o[2][r]*=fr_; o[3][r]*=fr_;} } } }while(0)
  #define SC(c,j) (((c)<2)?s0[((c)&1)*8+(j)]:s1[((c)&1)*8+(j)])
  #define SLICE(c,d,PW) do{ const float e0_=__builtin_amdgcn_exp2f(SC(c,2*(d))), e1_=__builtin_amdgcn_exp2f(SC(c,2*(d)+1)); sacc+=e0_; sacc+=e1_; PW[d]=cvtpk_s(e0_,e1_); }while(0)
  #define VRD1(LO,HI,c,d) do{ LO[d]=vtr(vpt+((((d)>>1)*8192)+(((d)&1)*4096)+((c)*1024))); HI[d]=vtr(vpt+((((d)>>1)*8192)+(((d)&1)*4096)+((c)*1024)+512)); }while(0)
  #define VFRAG(LO,HI,d) (bf16x8){LO[d][0],LO[d][1],LO[d][2],LO[d][3],HI[d][0],HI[d][1],HI[d][2],HI[d][3]}
  #define GAP(d,P,LO,HI,TAIL) do{ o[d]=__builtin_amdgcn_mfma_f32_32x32x16_bf16(__builtin_bit_cast(bf16x8,P),VFRAG(LO,HI,d),o[d],0,0,0); TAIL; }while(0)
  #define KRD2(j) do{ kf[2*(j)]=*(const __attribute__((address_space(3))) bf16x8*)(kpt+(j)*2048); kf[2*(j)+1]=*(const __attribute__((address_space(3))) bf16x8*)(kpt+(j)*2048+512); }while(0)
  #define DFB_SMPV(sv,KTAIL0,KTAIL1,KTAIL2,KTAIL3) do{ const lds_cptr vpt=vp0+(sv)*16384; float sacc=0.f; u32x4 pa,pb; s16x4 alo[4],ahi[4],blo[4],bhi[4]; \
      __builtin_amdgcn_iglp_opt(IGLP_MODE); VRD1(alo,ahi,0,0); VRD1(alo,ahi,0,1); VRD1(alo,ahi,0,2); VRD1(alo,ahi,0,3); \
      SLICE(0,0,pa); SLICE(0,1,pa); SLICE(0,2,pa); SLICE(0,3,pa); \
      GAP(0,pa,alo,ahi,SLICE(1,0,pb);VRD1(blo,bhi,1,0)); GAP(1,pa,alo,ahi,SLICE(1,1,pb);VRD1(blo,bhi,1,1)); GAP(2,pa,alo,ahi,SLICE(1,2,pb);VRD1(blo,bhi,1,2)); GAP(3,pa,alo,ahi,SLICE(1,3,pb);VRD1(blo,bhi,1,3)); \
      GAP(0,pb,blo,bhi,SLICE(2,0,pa);VRD1(alo,ahi,2,0)); GAP(1,pb,blo,bhi,SLICE(2,1,pa);VRD1(alo,ahi,2,1)); GAP(2,pb,blo,bhi,SLICE(2,2,pa);VRD1(alo,ahi,2,2)); GAP(3,pb,blo,bhi,SLICE(2,3,pa);VRD1(alo,ahi,2,3)); \
      GAP(0,pa,alo,ahi,SLICE(3,0,pb);VRD1(blo,bhi,3,0)); GAP(1,pa,alo,ahi,SLICE(3,1,pb);VRD1(blo,bhi,3,1)); GAP(2,pa,alo,ahi,SLICE(3,2,pb);VRD1(blo,bhi,3,2)); GAP(3,pa,alo,ahi,SLICE(3,3,pb);VRD1(blo,bhi,3,3)); \
      GAP(0,pb,blo,bhi,KTAIL0); GAP(1,pb,blo,bhi,KTAIL1); GAP(2,pb,blo,bhi,KTAIL2); GAP(3,pb,blo,bhi,KTAIL3); \
      l_reg+=sacc; }while(0)
  #define DFB_QK() do{ \
      s0=__builtin_amdgcn_mfma_f32_32x32x16_bf16(kf[0],qr[0],negm,0,0,0); s1=__builtin_amdgcn_mfma_f32_32x32x16_bf16(kf[1],qr[0],negm,0,0,0); \
      s0=__builtin_amdgcn_mfma_f32_32x32x16_bf16(kf[2],qr[1],s0,0,0,0);   s1=__builtin_amdgcn_mfma_f32_32x32x16_bf16(kf[3],qr[1],s1,0,0,0); \
      s0=__builtin_amdgcn_mfma_f32_32x32x16_bf16(kf[4],qr[2],s0,0,0,0);   s1=__builtin_amdgcn_mfma_f32_32x32x16_bf16(kf[5],qr[2],s1,0,0,0); \
      s0=__builtin_amdgcn_mfma_f32_32x32x16_bf16(kf[6],qr[3],s0,0,0,0);   s1=__builtin_amdgcn_mfma_f32_32x32x16_bf16(kf[7],qr[3],s1,0,0,0); SBAR(); }while(0)
  WAIT_BAR(6); DFB_DMA(3,3);
  qkt(s0,s1,shm+dfb::DK,qr,negm,r32,hi);
  DFB_REF(true);
  int sc=1,sp=0,sn=4;
  for(int t=1;t<=NT;++t){
    if(t<NT){
      if(t+2<NT){WAIT_BAR(6);}else if(t+1<NT){WAIT_BAR(3);}else{WAIT_BAR(0);}
      if(t+3<NT){DFB_DMA(t+3,sn);}
    }
    const bool do_qk=(t<=tlast)&&(t<NT);
    if(t<=tlast+1){
      bf16x8 kf[8]; const lds_cptr kpt=kp0+sc*8192;
      DFB_SMPV(sp,if(do_qk)KRD2(0),if(do_qk)KRD2(1),if(do_qk)KRD2(2),if(do_qk)KRD2(3));
      if(do_qk){ DFB_QK(); DFB_REF(false); }
    }
    sp=sc; sc=(sc==4)?0:sc+1; sn=(sn==4)?0:sn+1;
  }
  asm volatile("s_waitcnt lgkmcnt(0)\n\ts_barrier":::"memory");
  {auto rr=__builtin_amdgcn_permlane32_swap(__float_as_uint(l_reg),__float_as_uint(l_reg),false,false);l_reg=__uint_as_float(rr[0])+__uint_as_float(rr[1]);}
  if(hi==0)wsf[32+r32]=l_reg;asm volatile("s_waitcnt lgkmcnt(0)":::"memory");
  float rli[16];
  #pragma unroll
  for(int r=0;r<16;++r)rli[r]=__builtin_amdgcn_rcpf(wsf[32+crow(r,hi)]);
  bf16*Ow=O+(rowbase+q0+wid*QBLK)*PO;
  { bf16*stg=(bf16*)(shm+dfb::DOST)+wid*4096;
    #pragma unroll
    for(int r=0;r<16;++r){const int orow=crow(r,hi);
      #pragma unroll
      for(int d0=0;d0<4;++d0)stg[orow*128+d0*32+r32]=__float2bfloat16(o[d0][r]*rli[r]);}
    asm volatile("s_waitcnt lgkmcnt(0)":::"memory");
    #pragma unroll
    for(int i=0;i<8;++i){const int idx=i*64+lane,row=idx>>4,ch=idx&15; const u32x4 v=*(const u32x4*)(stg+row*128+ch*8); ATTN_STORE16(Ow+(long)row*PO+ch*8,v);} }
  asm volatile("s_waitcnt lgkmcnt(0)\n\ts_barrier":::"memory");
  #undef DFB_DMA
  #undef DFB_SOFTMAX
  #undef DFB_PV
  #undef DFB_REF
  #undef SC
  #undef SLICE
  #undef VRD1
  #undef VFRAG
  #undef GAP
  #undef KRD2
  #undef DFB_SMPV
  #undef DFB_QK
}
constexpr int LDS_BIAS=LDS_BYTES;
__device__ __forceinline__ void band_unit(int b,int h,int qb,const bf16*Q,const bf16*__restrict__ K,const bf16*__restrict__ V,bf16*O,const float*__restrict__ relb,char*shm){
  int tid_=threadIdx.x; asm volatile("":"+v"(tid_)); const int tid=tid_,lane=tid&63,r32=lane&31,hi=lane>>5; const int wid=__builtin_amdgcn_readfirstlane(tid>>6);
  const long rowbase=(long)b*SEQ; const int q0=qb*QB;
  const bf16*Qw=Q+(rowbase+q0+wid*QBLK)*PQ;
  const bf16*Kh=K+rowbase*PQ,*Vh=V+rowbase*PQ;
  const unsigned lds0=(unsigned)(uintptr_t)shm;
  float*wsf=(float*)(shm+LDS_WS)+wid*64;
  float*biasL=(float*)(shm+LDS_BIAS);
  for(int i=tid;i<640;i+=512)biasL[i]=relb[h*513+(i<512?i:512)]*1.4426950408889634f;
  const bf16*ksrc=Kh+(long)lane*PQ+wid*8;
  const bf16*vsrc=Vh+(long)(16*(wid&3)+(lane>>2))*PQ+(wid>>2)*32+(lane&3)*8;
  const unsigned kdst=lds0+LDS_K+wid*1024, vdst=lds0+LDS_V+wid*1024;
  #define DMA_K(t,slot) glds16(ksrc+(long)(t)*KVBLK*PQ,(unsigned)__builtin_amdgcn_readfirstlane(kdst+(slot)))
  #define DMA_V(t,slot) glds16(vsrc+(long)(t)*KVBLK*PQ,(unsigned)__builtin_amdgcn_readfirstlane(vdst+(slot)))
  const int vb0=(int)(lds0+LDS_V)+((lane>>4)&1)*32+(lane&3)*8+(4*hi+((lane&15)>>2))*64;
  const char*Kbase=shm+LDS_K;
  const int c0=q0/KVBLK, cw=c0+(wid>>1);
  const int tlo=(c0<8)?0:c0-8, thi=c0+3;
  bf16x8 qr[4];
  #pragma unroll
  for(int d0=0;d0<4;++d0)qr[d0]=*reinterpret_cast<const bf16x8*>(&Qw[(long)r32*PQ+d0*16+hi*8]);
  asm volatile("":"+v"(qr[0]),"+v"(qr[1]),"+v"(qr[2]),"+v"(qr[3]));
  float m_run=-INFINITY,l_reg=0.f; f32x16 o[2]; o[0]=f32x16{}; o[1]=f32x16{}; const f32x16 zero=f32x16{};
  const int qabs=q0+wid*QBLK+r32;
  DMA_K(tlo,0);DMA_V(tlo,0);
  int sl=0;
  for(int t=tlo;t<=thi;++t){
    if(t<thi){DMA_K(t+1,sl^SLOTB);DMA_V(t+1,sl^SLOTB);WAIT_BAR(2);}else{WAIT_BAR(0);}
    if(t>=cw-8&&t<=cw){
      f32x16 p0,p1; qkt(p0,p1,Kbase+sl,qr,zero,r32,hi);
      if(cw-t>=5){ const float bc=biasL[512];
        #pragma unroll
        for(int r=0;r<16;++r){p0[r]+=bc;p1[r]+=bc;} }
      else{ const float*bp=biasL+(qabs-(t*KVBLK+4*hi)+256);
        #pragma unroll
        for(int r=0;r<16;++r){ p0[r]+=bp[-((r&3)+8*(r>>2))]; p1[r]+=bp[-((r&3)+8*(r>>2))-32]; } }
      float rm=p0[0];
      #pragma unroll
      for(int r=0;r<16;++r){rm=__builtin_fmaxf(rm,p0[r]);rm=__builtin_fmaxf(rm,p1[r]);}
      { auto rr=__builtin_amdgcn_permlane32_swap(__float_as_uint(rm),__float_as_uint(rm),false,false); rm=__builtin_fmaxf(__uint_as_float(rr[0]),__uint_as_float(rr[1])); }
      const float mn=__builtin_fmaxf(m_run,rm); const float f=__builtin_amdgcn_exp2f(m_run-mn); m_run=mn;
      float sacc=0.f;
      #pragma unroll
      for(int r=0;r<16;++r){p0[r]=__builtin_amdgcn_exp2f(p0[r]-mn);p1[r]=__builtin_amdgcn_exp2f(p1[r]-mn);sacc+=p0[r]+p1[r];}
      l_reg=l_reg*f+sacc;
      if(__any(f!=1.0f)){
      if(hi==0)wsf[r32]=f;
      asm volatile("s_waitcnt lgkmcnt(0)":::"memory");
      #pragma unroll
      for(int r=0;r<16;++r){const float fr_=wsf[crow(r,hi)]; o[0][r]*=fr_; o[1][r]*=fr_;} }
      u32x4 pw0,pw1,pw2,pw3;
      pw0=(u32x4){cvtpk_s(p0[0],p0[1]),cvtpk_s(p0[2],p0[3]),cvtpk_s(p0[4],p0[5]),cvtpk_s(p0[6],p0[7])};
      pw1=(u32x4){cvtpk_s(p0[8],p0[9]),cvtpk_s(p0[10],p0[11]),cvtpk_s(p0[12],p0[13]),cvtpk_s(p0[14],p0[15])};
      pw2=(u32x4){cvtpk_s(p1[0],p1[1]),cvtpk_s(p1[2],p1[3]),cvtpk_s(p1[4],p1[5]),cvtpk_s(p1[6],p1[7])};
      pw3=(u32x4){cvtpk_s(p1[8],p1[9]),cvtpk_s(p1[10],p1[11]),cvtpk_s(p1[12],p1[13]),cvtpk_s(p1[14],p1[15])};
      SBAR(); pv(o,vb0+sl,__builtin_bit_cast(bf16x8,pw0),__builtin_bit_cast(bf16x8,pw1),__builtin_bit_cast(bf16x8,pw2),__builtin_bit_cast(bf16x8,pw3));
    }
    asm volatile("s_waitcnt lgkmcnt(0)\n\ts_barrier":::"memory");
    sl^=SLOTB;
  }
  {auto rr=__builtin_amdgcn_permlane32_swap(__float_as_uint(l_reg),__float_as_uint(l_reg),false,false);l_reg=__uint_as_float(rr[0])+__uint_as_float(rr[1]);}
  if(hi==0)wsf[32+r32]=l_reg;asm volatile("s_waitcnt lgkmcnt(0)":::"memory");
  float rli[16];
  #pragma unroll
  for(int r=0;r<16;++r)rli[r]=__builtin_amdgcn_rcpf(wsf[32+crow(r,hi)]);
  bf16*Ow=O+(rowbase+q0+wid*QBLK)*PO;
  { bf16*stg=(bf16*)(shm+LDS_OST)+wid*2048;
    #pragma unroll
    for(int r=0;r<16;++r){const int orow=crow(r,hi);
      #pragma unroll
      for(int d0=0;d0<2;++d0)stg[orow*64+d0*32+r32]=__float2bfloat16(o[d0][r]*rli[r]);}
    asm volatile("s_waitcnt lgkmcnt(0)":::"memory");
    #pragma unroll
    for(int i=0;i<4;++i){const int row=i*8+(lane>>3),ch=lane&7; const u32x4 v=*(const u32x4*)(stg+row*64+ch*8); ATTN_STORE16(Ow+(long)row*PO+ch*8,v);} }
  asm volatile("s_waitcnt lgkmcnt(0)\n\ts_barrier":::"memory");
  #undef DMA_K
  #undef DMA_V
}
constexpr int ATTN_LDS_BYTES=LDS_BYTES+2560;
#undef SBAR
#undef WAIT_BAR
}


#define CFG_ONE_LAUNCH 1
#define CFG_ATTN 2
#define CFG_BAND 1
#define PROBE_REP_MASK 0x0

#define LAS __attribute__((address_space(3)))
__device__ __forceinline__ void p0_transpose_item(const float* W, int K, int N, bf16_t* WT, LAS float* scr, int item, int lane, bool up_il, const float* gain) {
    const int nblk = N / 32, kb = item / nblk, nb = item % nblk, k0 = 64 * kb, n0 = 32 * nb;
    const int rb = !up_il ? n0 : (n0 < DFF ? (n0 >> 7) * 256 + (n0 & 127) : ((n0 - DFF) >> 7) * 256 + 128 + ((n0 - DFF) & 127));
#pragma unroll 8
    for (int i = 0; i < 32; ++i) { const int kk = 2 * i + (lane >> 5); const float gk = gain ? gain[k0 + kk] : 1.0f; scr[kk * 33 + (lane & 31)] = W[(size_t)(k0 + kk) * N + n0 + (lane & 31)] * gk; }
    asm volatile("s_waitcnt lgkmcnt(0)" ::: "memory");
    const int c = lane & 7;
#pragma unroll
    for (int j = 0; j < 4; ++j) { const int n = (lane >> 3) + 8 * j; const LAS float* s = scr + (8 * c) * 33 + n;
        u32x4 o; o.x = cvtpk(s[0 * 33], s[1 * 33]); o.y = cvtpk(s[2 * 33], s[3 * 33]); o.z = cvtpk(s[4 * 33], s[5 * 33]); o.w = cvtpk(s[6 * 33], s[7 * 33]);
        *(u32x4*)(WT + (size_t)(rb + n) * K + k0 + 8 * c) = o; }
    asm volatile("s_waitcnt lgkmcnt(0)" ::: "memory");
}
__device__ __forceinline__ void transpose_phase(const Args& a, unsigned char* ws, LAS unsigned char* lds, int gw, int NGW, int wave, int lane) {
    LAS float* scr = (LAS float*)(lds + wave * 16384);
    constexpr int I_IN = (DM / 64) * (INW / 32), I_OUT = (DM / 64) * (DM / 32), I_UP = (DM / 64) * (UPW / 32), I_DN = (DFF / 64) * (DM / 32), I_L = I_IN + I_OUT + I_UP + I_DN;
    for (int it = gw; it < DEPTH * I_L; it += NGW) {
        const int l = it / I_L; int r = it % I_L; unsigned char* wl = ws + WS_W + (size_t)l * W_LAYER;
        if (r < I_IN) { p0_transpose_item(a.in[2] + (size_t)l * DM * INW, DM, INW, (bf16_t*)(wl + W_IN), scr, r, lane, false, a.in[1] + (size_t)l * DM); continue; } r -= I_IN;
        if (r < I_OUT) { p0_transpose_item(a.in[11] + (size_t)l * DM * DM, DM, DM, (bf16_t*)(wl + W_OUT), scr, r, lane, false, nullptr); continue; } r -= I_OUT;
        if (r < I_UP) { p0_transpose_item(a.in[13] + (size_t)l * DM * UPW, DM, UPW, (bf16_t*)(wl + W_UP), scr, r, lane, true, a.in[12] + (size_t)l * DM); continue; } r -= I_UP;
        p0_transpose_item(a.in[16] + (size_t)l * DFF * DM, DFF, DM, (bf16_t*)(wl + W_DOWN), scr, r, lane, false, nullptr);
    }
}

__device__ __forceinline__ void n_diff_item(const bf16_t* PROJ, bf16_t* AO, int chunk, int vh, int lane) {
    const int h = vh >> 2, m = (vh >> 1) & 1, e = vh & 1;
    const int t = chunk * 64 + lane, b = t / SEQ, kbeg = b * SEQ, kend = (chunk + 1) * 64;
    float q[64], o[64];
    { const u32x4* qp = (const u32x4*)(PROJ + (size_t)t * INW + h * 128 + m * 64);
#pragma unroll
      for (int i = 0; i < 8; ++i) { const u32x4 w = qp[i];
#pragma unroll
          for (int c = 0; c < 4; ++c) { q[i * 8 + 2 * c] = bflo(w[c]); q[i * 8 + 2 * c + 1] = bfhi(w[c]); } } }
#pragma unroll
    for (int d = 0; d < 64; ++d) o[d] = 0.f;
    float mx = -INFINITY, lsum = 0.f;
    for (int k = kbeg; k < kend; ++k) {
        const u32x4* kp = (const u32x4*)(PROJ + (size_t)k * INW + COL_KA + h * 128 + m * 64);
        const u32x4* vp = (const u32x4*)(PROJ + (size_t)k * INW + COL_VA + h * 128 + e * 64);
        float s = 0.f;
#pragma unroll
        for (int i = 0; i < 8; ++i) { const u32x4 w = kp[i];
#pragma unroll
            for (int c = 0; c < 4; ++c) { s += q[i * 8 + 2 * c] * bflo(w[c]); s += q[i * 8 + 2 * c + 1] * bfhi(w[c]); } }
        const float mn = fmaxf(mx, s), f = exp2f(mx - mn), p = exp2f(s - mn);
        lsum = lsum * f + p; mx = mn;
#pragma unroll
        for (int i = 0; i < 8; ++i) { const u32x4 w = vp[i];
#pragma unroll
            for (int c = 0; c < 4; ++c) { o[i * 8 + 2 * c] = o[i * 8 + 2 * c] * f + p * bflo(w[c]); o[i * 8 + 2 * c + 1] = o[i * 8 + 2 * c + 1] * f + p * bfhi(w[c]); } }
    }
    const float inv = 1.0f / lsum;
    u32x4* op = (u32x4*)(AO + (size_t)t * 1024 + vh * 64);
#pragma unroll
    for (int i = 0; i < 8; ++i) { u32x4 w;
#pragma unroll
        for (int c = 0; c < 4; ++c) w[c] = cvtpk(o[i * 8 + 2 * c] * inv, o[i * 8 + 2 * c + 1] * inv);
        op[i] = w; }
}
__device__ __forceinline__ void n_band_item(const bf16_t* PROJ, const float* relb, bf16_t* MIX, int chunk, int h, int lane) {
    const int t = chunk * 64 + lane, b = t / SEQ, cin = chunk % (SEQ / 64);
    const float* rb = relb + h * 513;
    float q[64], o[64];
    { const u32x4* qp = (const u32x4*)(PROJ + (size_t)t * INW + COL_QC + h * 64);
#pragma unroll
      for (int i = 0; i < 8; ++i) { const u32x4 w = qp[i];
#pragma unroll
          for (int c = 0; c < 4; ++c) { q[i * 8 + 2 * c] = bflo(w[c]); q[i * 8 + 2 * c + 1] = bfhi(w[c]); } } }
#pragma unroll
    for (int d = 0; d < 64; ++d) o[d] = 0.f;
    float mx = -INFINITY, lsum = 0.f;
    for (int j = 0; j < 9; ++j) {
        const int kc = cin - 8 + j; if (kc < 0) continue;
        for (int kk = 0; kk < 64; ++kk) {
            const int k = b * SEQ + kc * 64 + kk;
            int rel = t - k; rel = rel < -256 ? -256 : (rel > 256 ? 256 : rel);
            const u32x4* kp = (const u32x4*)(PROJ + (size_t)k * INW + COL_KC + h * 64);
            const u32x4* vp = (const u32x4*)(PROJ + (size_t)k * INW + COL_VC + h * 64);
            float s = rb[rel + 256] * LOG2E;
#pragma unroll
            for (int i = 0; i < 8; ++i) { const u32x4 w = kp[i];
#pragma unroll
                for (int c = 0; c < 4; ++c) { s += q[i * 8 + 2 * c] * bflo(w[c]); s += q[i * 8 + 2 * c + 1] * bfhi(w[c]); } }
            const float mn = fmaxf(mx, s), f = exp2f(mx - mn), p = exp2f(s - mn);
            lsum = lsum * f + p; mx = mn;
#pragma unroll
            for (int i = 0; i < 8; ++i) { const u32x4 w = vp[i];
#pragma unroll
                for (int c = 0; c < 4; ++c) { o[i * 8 + 2 * c] = o[i * 8 + 2 * c] * f + p * bflo(w[c]); o[i * 8 + 2 * c + 1] = o[i * 8 + 2 * c + 1] * f + p * bfhi(w[c]); } }
        }
    }
    const float inv = 1.0f / lsum;
    u32x4* op = (u32x4*)(MIX + (size_t)t * 1024 + 768 + h * 64);
#pragma unroll
    for (int i = 0; i < 8; ++i) { u32x4 w;
#pragma unroll
        for (int c = 0; c < 4; ++c) w[c] = cvtpk(o[i * 8 + 2 * c] * inv, o[i * 8 + 2 * c + 1] * inv);
        op[i] = w; }
}


__device__ __forceinline__ void convfix_rows(const Args& a, int l, unsigned char* ws, int pm, int tid) {
    const float* cw = a.in[14] + (size_t)l * 3 * DFF; const float* cb = a.in[15] + (size_t)l * DFF;
    const float* HA = (const float*)(ws + WS_HEADA); const float* HG = (const float*)(ws + WS_HEADG); const float* HL = (const float*)(ws + WS_HALO); bf16_t* ACT = (bf16_t*)(ws + WS_ACT);
    for (int i = tid; i < 4 * DFF; i += 512) { const int b4 = i / DFF, c = i % DFF, blk = pm * 4 + b4;
        const float a0 = HA[((size_t)blk * 2) * DFF + c], a1 = HA[((size_t)blk * 2 + 1) * DFF + c], g0 = HG[((size_t)blk * 2) * DFF + c], g1 = HG[((size_t)blk * 2 + 1) * DFF + c];
        float h0 = 0.f, h1 = 0.f; if ((blk % (SEQ / 64)) != 0) { h0 = HL[((size_t)(blk - 1) * 2) * DFF + c]; h1 = HL[((size_t)(blk - 1) * 2 + 1) * DFF + c]; }
        const float w0 = cw[c], w1 = cw[DFF + c], w2 = cw[2 * DFF + c], bb = cb[c];
        const float x0 = bb + w0 * h0 + w1 * h1 + w2 * a0, x1 = bb + w0 * h1 + w1 * a0 + w2 * a1;
        const float y0 = x0 * __builtin_amdgcn_rcpf(1.0f + __expf(-x0)) * g0, y1 = x1 * __builtin_amdgcn_rcpf(1.0f + __expf(-x1)) * g1;
        ACT[(size_t)(blk * 64) * DFF + c] = (bf16_t)(cvtpk(y0, 0.f) & 0xffffu); ACT[(size_t)(blk * 64 + 1) * DFF + c] = (bf16_t)(cvtpk(y1, 0.f) & 0xffffu); }
}
#define XB_TMO      128
#define XB_XCNT(j)  (256  + 64 * (j))
#define XB_XSUB(j)  (1280 + 64 * (j))
#define XB_XGEN(j)  (2304 + 64 * (j))
#define XB_TOP      3328
#define XB_TOPGEN   3392
#define XCD_BAR_WORDS 3456
#define XB_SPIN_CAP (1u << 18)

__device__ __forceinline__ unsigned xb_ld(unsigned* p)              { return __hip_atomic_load(p, __ATOMIC_RELAXED, __HIP_MEMORY_SCOPE_AGENT); }
__device__ __forceinline__ unsigned xb_add(unsigned* p, unsigned v) { return __hip_atomic_fetch_add(p, v, __ATOMIC_RELAXED, __HIP_MEMORY_SCOPE_AGENT); }
__device__ __forceinline__ unsigned xb_xcc_id() { return (unsigned)__builtin_amdgcn_s_getreg((3 << 11) | 20) & 0xFu; }
#define XB_SPIN(cond, bar) do { unsigned _sp = 0; while (cond) { __builtin_amdgcn_s_sleep(1); \
    if ((++_sp & 255u) == 0u) { if (xb_ld(&(bar)[XB_TMO])) break; if (_sp > XB_SPIN_CAP) { atomicAdd(&(bar)[XB_TMO], 1u); break; } } } } while (0)

struct XcdBarrier {
    unsigned* bar; unsigned x;
    volatile LAS unsigned* st;
};

__device__ __forceinline__ XcdBarrier xcd_barrier_post(unsigned* bar, volatile LAS unsigned* st) {
    XcdBarrier b; b.bar = bar; b.x = xb_xcc_id(); b.st = st;
    if (threadIdx.x == 0) (void)xb_add(&bar[XB_XCNT(b.x)], 1u);
    return b;
}
__device__ __forceinline__ void xcd_barrier_complete(unsigned* bar, unsigned x, unsigned& nloc, unsigned& nx) {
    const unsigned G = gridDim.x * gridDim.y * gridDim.z;
    unsigned sum, cnt, mine, sp = 0u;
    for (;;) {
        sum = 0u; cnt = 0u; mine = 0u;
#pragma unroll
        for (unsigned j = 0; j < 16; ++j) { const unsigned c = xb_ld(&bar[XB_XCNT(j)]); sum += c; cnt += (c > 0u) ? 1u : 0u; mine = (j == x) ? c : mine; }
        if (sum == G) break;
        __builtin_amdgcn_s_sleep(1);
        if ((++sp & 255u) == 0u) { if (xb_ld(&bar[XB_TMO])) break; if (sp > XB_SPIN_CAP) { atomicAdd(&bar[XB_TMO], 1u); break; } }
    }
    nloc = mine > 0u ? mine : 1u; nx = cnt > 0u ? cnt : 1u;
}

__device__ __forceinline__ void xcd_barrier(const XcdBarrier& b) {
    asm volatile("s_waitcnt vmcnt(0)" ::: "memory");
    __syncthreads();
    if (threadIdx.x == 0) {
        unsigned* bar = b.bar;
        __builtin_amdgcn_s_waitcnt(0);
        unsigned nloc = b.st[0], nx = b.st[1];
        if (nloc == 0u) { xcd_barrier_complete(bar, b.x, nloc, nx); b.st[0] = nloc; b.st[1] = nx; }
        const unsigned old = xb_add(&bar[XB_XSUB(b.x)], 1u);
        const unsigned gen = old / nloc;
        if (old + 1u == (gen + 1u) * nloc) {
            __builtin_amdgcn_fence(__ATOMIC_RELEASE, "agent");
            asm volatile("s_waitcnt vmcnt(0)" ::: "memory");
            const unsigned og = xb_add(&bar[XB_TOP], 1u);
            const unsigned tg = og / nx;
            if (og + 1u == (tg + 1u) * nx) xb_add(&bar[XB_TOPGEN], 1u);
            else XB_SPIN(xb_ld(&bar[XB_TOPGEN]) == tg, bar);
            __builtin_amdgcn_fence(__ATOMIC_ACQUIRE, "agent");
            xb_add(&bar[XB_XGEN(b.x)], 1u);
            asm volatile("s_waitcnt vmcnt(0)" ::: "memory");
        } else {
            XB_SPIN(xb_ld(&bar[XB_XGEN(b.x)]) == gen, bar);
            __builtin_amdgcn_fence(__ATOMIC_ACQUIRE, "agent");
            asm volatile("s_waitcnt vmcnt(0)" ::: "memory");
        }
    }
    __syncthreads();
}

constexpr int LDS_BYTES = 147456;
__device__ __forceinline__ bool phase_exists(int p) { if (p == 0 || p == PH_FINAL) return true; const int s = (p - 1) % 10; return s != 9 && s != 7; }
__device__ __forceinline__ bool sync_after(int p) { if (p == 0) return true; const int s = (p - 1) % 10; return !(s == 1 || s == 2); }
__global__ void __launch_bounds__(512, 2) mega(Args a) {
    extern __shared__ __attribute__((aligned(16))) unsigned char lds[];
    cg::grid_group grid = cg::this_grid();
    const int G = gridDim.x, blk = blockIdx.x;
    const int vcu = (G % 8 == 0) ? (blk % 8) * (G / 8) + blk / 8 : blk;
    const int NGW = G * 8, NT = G * 512;
    unsigned char* ws = a.ws;
    float* rowss = (float*)(ws + WS_ROWSS);
    bf16_t* XG = (bf16_t*)(ws + WS_XG); bf16_t* PROJ = (bf16_t*)(ws + WS_PROJ); bf16_t* AO = (bf16_t*)(ws + WS_AO); bf16_t* MIX = (bf16_t*)(ws + WS_MIX);
    LAS unsigned char* lds3 = (LAS unsigned char*)lds;
    volatile LAS unsigned* bst = (volatile LAS unsigned*)(lds3 + 131072 + 64);
    if (threadIdx.x < 2) bst[threadIdx.x] = 0u;
    unsigned* barw = (unsigned*)ws;
    if (a.ph_hi - a.ph_lo > 1 && blk == 0) for (int i = threadIdx.x; i < XCD_BAR_WORDS; i += 512) __hip_atomic_store(barw + i, 0u, __ATOMIC_RELAXED, __HIP_MEMORY_SCOPE_AGENT);
    __syncthreads();
    XcdBarrier bar; bar.bar = barw; bar.x = 0; bar.st = bst; bool posted = false;
    for (int p = a.ph_lo; p < a.ph_hi; ++p) {
        if (!phase_exists(p)) continue;
        const int nrep = (p != 0 && p != PH_FINAL && ((PROBE_REP_MASK >> ((p - 1) % 10)) & 1)) ? 2 : ((p == 0 && (PROBE_REP_MASK & 0x400)) ? 2 : 1);
        for (int rep = 0; rep < nrep; ++rep) {
        if (rep) __syncthreads();
        int tid = threadIdx.x; asm volatile("" : "+v"(tid));
        const int lane = tid & 63, wave = __builtin_amdgcn_readfirstlane(tid >> 6), gw = blk * 8 + wave, gtid = blk * 512 + tid;
        if (p == 0) { transpose_phase(a, ws, lds3, gw, NGW, wave, lane); norm0_phase(a.in[0], XG, rowss, gw, NGW, lane); }
        else if (p == PH_FINAL) { final_phase(a.out, XG, rowss + (size_t)8 * RSS, a.in[17], gw, NGW, lane); }
        else {
            const int l = (p - 1) / 10, s = (p - 1) % 10;
            unsigned char* wl = ws + WS_W + (size_t)l * W_LAYER;
            if (s == 0) {
                pg8::Gemm g{XG, (const bf16_t*)(wl + W_IN), M, INW, DM, DM}; pg8::StaticOrder S; S.init(M, INW, G, blk);
                pg8::EpiScale E{PROJ, INW, rowss + (size_t)(2 * l) * RSS, 1};
                pg8::gemm_phase<pg8::EpiScale, pg8::StaticOrder, true, true>(lds3, g, S, E);
            } else if (s == 1) {
#if CFG_ATTN == 2
                for (int i = vcu; i < 512; i += G) { const int r = i >> 8, v = i & 255, combo = v >> 4, sI = v & 15;
                    const int qb = (r == 0) ? sI : 31 - sI, b = combo >> 3, hm = combo & 7, h = hm >> 1, m = hm & 1;
                    attn_body::diff_unit2<8>(b, qb, (const attn_body::bf16*)(PROJ + h * 128 + m * 64), (const attn_body::bf16*)(PROJ + COL_KA + h * 128 + m * 64),
                                            (const attn_body::bf16*)(PROJ + COL_VA + h * 128), (attn_body::bf16*)(AO + h * 256 + m * 128), (char*)lds); }
#elif CFG_ATTN
                for (int i = vcu; i < 1024; i += G) { const int r = i >> 8, v = i & 255, bh = v >> 3, sI = v & 7;
                    const int qb = (r == 0) ? sI : (r == 1) ? 15 - sI : (r == 2) ? 16 + sI : 31 - sI;
                    const int b = bh >> 4, vh = bh & 15, h = vh >> 2, m = (vh >> 1) & 1, e = vh & 1;
                    attn_body::attn_unit<8>(b, qb, (const attn_body::bf16*)(PROJ + h * 128 + m * 64), (const attn_body::bf16*)(PROJ + COL_KA + h * 128 + m * 64),
                                            (const attn_body::bf16*)(PROJ + COL_VA + h * 128 + e * 64), (attn_body::bf16*)(AO + vh * 64), (char*)lds); }
#else
                for (int it = gw; it < 4096; it += NGW) n_diff_item(PROJ, AO, 255 - (it >> 4), it & 15, lane);
#endif
                __syncthreads();
            } else if (s == 2) {
#if CFG_BAND
                for (int i = vcu; i < 256; i += G) { const int b = i >> 7, h = (i >> 5) & 3, qb = i & 31;
                    attn_body::band_unit(b, h, qb, (const attn_body::bf16*)(PROJ + COL_QC + h * 64), (const attn_body::bf16*)(PROJ + COL_KC + h * 64),
                                         (const attn_body::bf16*)(PROJ + COL_VC + h * 64), (attn_body::bf16*)(MIX + 768 + h * 64), a.in[10] + (size_t)l * 4 * 513, (char*)lds); }
#else
                for (int it = gw; it < 1024; it += NGW) n_band_item(PROJ, a.in[10] + (size_t)l * 4 * 513, MIX, it >> 2, it & 3, lane);
#endif
                __syncthreads();
            } else if (s == 3) pool_phase(a, l, PROJ, MIX, (float*)lds, blk, G, tid);
            else if (s == 4) combine_phase(a, l, AO, MIX, gw, NGW, lane);
            else if (s == 5) {
                pg8::Gemm g{MIX, (const bf16_t*)(wl + W_OUT), M, DM, DM, DM}; pg8::StaticOrder S; S.init(M, DM, G, blk);
                pg8::EpiResid E{XG, rowss + (size_t)(2 * l + 1) * RSS};
                pg8::gemm_phase<pg8::EpiResid, pg8::StaticOrder, true, true>(lds3, g, S, E);
            } else if (s == 6) {
                pg8::Gemm g{XG, (const bf16_t*)(wl + W_UP), M, UPW, DM, DM}; pg8::StaticOrder S; S.init(M, UPW, G, blk);
                pg8::EpiConvAct E{(bf16_t*)(ws + WS_ACT), rowss + (size_t)(2 * l + 1) * RSS, a.in[14] + (size_t)l * 3 * DFF, a.in[15] + (size_t)l * DFF, (float*)(ws + WS_HEADA), (float*)(ws + WS_HEADG), (float*)(ws + WS_HALO)};
                pg8::gemm_phase<pg8::EpiConvAct, pg8::StaticOrder, true, true>(lds3, g, S, E);
            }
            else if (s == 8) {
                pg8::Gemm g{(const bf16_t*)(ws + WS_ACT), (const bf16_t*)(wl + W_DOWN), M, DM, DFF, DFF}; pg8::StaticOrder S; S.init(M, DM, G, blk);
                { pg8::Unit u; for (int i = 0; S.next(i, u); ++i) convfix_rows(a, l, ws, u.pm, tid); }
                asm volatile("s_waitcnt vmcnt(0)" ::: "memory"); __syncthreads();
                pg8::EpiResid E{XG, rowss + (size_t)(2 * l + 2) * RSS};
                pg8::gemm_phase<pg8::EpiResid, pg8::StaticOrder, true, true>(lds3, g, S, E);
            }
        }
        }
        if (p + 1 < a.ph_hi) { if (sync_after(p)) { if (!posted) { grid.sync(); bar = xcd_barrier_post(barw, bst); posted = true; } else xcd_barrier(bar); } else __syncthreads(); }
    }
}

extern "C" void kernel_launch(void* const* d_in, const int* in_sizes, int n_in, void* d_out, int out_size, void* d_ws, size_t ws_size, hipStream_t stream) {
    static int grid = 0;
    if (grid == 0) {
        if (n_in != 18 || out_size != M * DM || ws_size < WS_END) { fprintf(stderr, "kernel_launch: unexpected shapes / workspace (n_in %d out %d ws %zu)\n", n_in, out_size, ws_size); grid = -1; return; }
        int dev = 0, cus = 0, per_cu = 0;
        (void)hipGetDevice(&dev); (void)hipDeviceGetAttribute(&cus, hipDeviceAttributeMultiprocessorCount, dev);
        if (hipFuncSetAttribute((const void*)mega, hipFuncAttributeMaxDynamicSharedMemorySize, LDS_BYTES) != hipSuccess) { fprintf(stderr, "hipFuncSetAttribute failed\n"); grid = -1; return; }
        if (hipOccupancyMaxActiveBlocksPerMultiprocessor(&per_cu, (const void*)mega, 512, LDS_BYTES) != hipSuccess || per_cu < 1) { fprintf(stderr, "occupancy query: %d\n", per_cu); per_cu = 1; }
        (void)hipGetLastError();
        grid = (cus > 0 ? cus : 256) * per_cu;
    }
    if (grid < 0) return;
    Args a{};
    for (int i = 0; i < 18; ++i) a.in[i] = (const float*)d_in[i];
    a.out = (float*)d_out; a.ws = (unsigned char*)d_ws;
    for (int l = 0; l < DEPTH; ++l) a.lam_init[l] = (float)(0.8 - 0.6 * exp(-0.3 * (double)l));
#if CFG_ONE_LAUNCH
    a.ph_lo = 0; a.ph_hi = PH_FINAL + 1;
    void* args[] = {&a};
    hipError_t e = hipLaunchCooperativeKernel((const void*)mega, dim3(grid), dim3(512), args, LDS_BYTES, stream);
    if (e != hipSuccess) fprintf(stderr, "cooperative launch failed: %s (grid %d)\n", hipGetErrorString(e), grid);
#else
    for (int p = 0; p <= PH_FINAL; ++p) { if (p != 0 && p != PH_FINAL && (((p - 1) % 10) == 9 || ((p - 1) % 10) == 7)) continue; a.ph_lo = p; a.ph_hi = p + 1; hipLaunchKernelGGL(mega, dim3(grid), dim3(512), LDS_BYTES, stream, a); }
#endif
}
```

```cpp
#include <hip/hip_runtime.h>
#include <hip/hip_cooperative_groups.h>
#include <cstdint>
#include <cstdio>
#include <cmath>
namespace cg = cooperative_groups;

constexpr int BATCH = 2, SEQ = 8192, DM = 1024, DEPTH = 4, M = BATCH * SEQ;
constexpr int INW = 2560, DFF = 2816, UPW = 2 * DFF;
constexpr float EPS = 1e-5f;
constexpr float LOG2E = 1.4426950408889634f;
constexpr float C2 = 0.125f * LOG2E;
constexpr int COL_KA = 512, COL_VA = 1024, COL_UB = 1536, COL_QC = 1792, COL_KC = 2048, COL_VC = 2304;

typedef unsigned short bf16_t;
typedef unsigned u32x4 __attribute__((ext_vector_type(4)));
typedef unsigned u32x2 __attribute__((ext_vector_type(2)));
typedef float f32x4 __attribute__((ext_vector_type(4)));
typedef float f32x2_t __attribute__((ext_vector_type(2)));
typedef __bf16 bf16x2_t __attribute__((ext_vector_type(2)));

constexpr size_t MiB = 1u << 20;
constexpr size_t WS_ROWSS = 304 * MiB;
constexpr size_t WS_W = 2 * MiB;
constexpr size_t W_LAYER = 23 * MiB + 512 * 1024, W_IN = 0, W_OUT = 5 * MiB, W_UP = 7 * MiB, W_DOWN = 18 * MiB;
constexpr size_t WS_XG = 96 * MiB;
constexpr size_t WS_PROJ = 128 * MiB;
constexpr size_t WS_AO = WS_PROJ + 80 * MiB;
constexpr size_t WS_MIX = WS_AO + 32 * MiB;
constexpr size_t WS_ACT = 128 * MiB;
constexpr size_t WS_HEADA = 272 * MiB, WS_HEADG = 278 * MiB, WS_HALO = 284 * MiB;
constexpr size_t WS_END = WS_ROWSS + 9 * MiB;
constexpr int RSS = M * 16;

__device__ __forceinline__ unsigned cvtpk(float lo, float hi) { f32x2_t v = {lo, hi}; bf16x2_t b = __builtin_convertvector(v, bf16x2_t); return __builtin_bit_cast(unsigned, b); }
__device__ __forceinline__ float bflo(unsigned w) { return __uint_as_float(w << 16); }
__device__ __forceinline__ float bfhi(unsigned w) { return __uint_as_float(w & 0xffff0000u); }
__device__ __forceinline__ float bf1(bf16_t v) { return __uint_as_float(((unsigned)v) << 16); }
__device__ __forceinline__ float wave_sum(float v) {
#pragma unroll
    for (int o = 1; o < 64; o <<= 1) v += __shfl_xor(v, o);
    return v;
}

__device__ __forceinline__ float row_rs(const float* rowss, int row) {
    const f32x4* p = (const f32x4*)(rowss + (size_t)row * 16); const f32x4 a = p[0], b = p[1], c = p[2], d = p[3];
    const float s = ((a.x + a.y) + (a.z + a.w)) + ((b.x + b.y) + (b.z + b.w)) + ((c.x + c.y) + (c.z + c.w)) + ((d.x + d.y) + (d.z + d.w));
    return rsqrtf(s * (1.0f / DM) + EPS);
}
struct Args {
    const float* in[18];
    float* out; unsigned char* ws;
    float lam_init[4];
    int ph_lo, ph_hi;
};
constexpr int PH_FINAL = 1 + 10 * DEPTH;

__device__ __forceinline__ void norm0_phase(const float* x, bf16_t* XH, float* rowss, int gw, int NGW, int lane) {
    for (int m = gw; m < M; m += NGW) {
        const f32x4* xr = (const f32x4*)(x + (size_t)m * DM) + lane;
        f32x4 v[4]; float s = 0.f;
#pragma unroll
        for (int j = 0; j < 4; ++j) { v[j] = xr[64 * j]; s += (v[j].x * v[j].x + v[j].y * v[j].y) + (v[j].z * v[j].z + v[j].w * v[j].w); }
        s = wave_sum(s);
        if (lane < 16) rowss[(size_t)m * 16 + lane] = (lane == 0) ? s : 0.f;
#pragma unroll
        for (int j = 0; j < 4; ++j) { u32x2 w; w.x = cvtpk(v[j].x, v[j].y); w.y = cvtpk(v[j].z, v[j].w); *(u32x2*)(XH + (size_t)m * DM + (64 * j + lane) * 4) = w; }
    }
}
__device__ __forceinline__ void combine_phase(const Args& a, int l, const bf16_t* __restrict__ AO, bf16_t* __restrict__ MIX, int gw, int NGW, int lane) {
    const float s1 = wave_sum(a.in[3][l * 64 + lane] * a.in[4][l * 64 + lane]);
    const float s2 = wave_sum(a.in[5][l * 64 + lane] * a.in[6][l * 64 + lane]);
    const float li = a.lam_init[l];
    const float lam = expf(s1) - expf(s2) + li;
    const float sc = 1.0f - li;
    const int h = lane >> 4, j0 = (lane & 15) * 8;
    float g[8];
#pragma unroll
    for (int j = 0; j < 8; ++j) g[j] = a.in[7][l * 128 + j0 + j] * sc;
    for (int t = gw; t < M; t += 2 * NGW) {
        const int t2 = t + NGW; const bool two = t2 < M;
        const bf16_t* p = AO + (size_t)t * 1024 + h * 256 + j0; const bf16_t* q = AO + (size_t)(two ? t2 : t) * 1024 + h * 256 + j0;
        const u32x4 a1 = *(const u32x4*)p, a2 = *(const u32x4*)(p + 128), b1 = *(const u32x4*)q, b2 = *(const u32x4*)(q + 128);
        float da[8], db[8]; float sa = 0.f, sb = 0.f;
#pragma unroll
        for (int c = 0; c < 4; ++c) { da[2 * c] = bflo(a1[c]) - lam * bflo(a2[c]); da[2 * c + 1] = bfhi(a1[c]) - lam * bfhi(a2[c]); db[2 * c] = bflo(b1[c]) - lam * bflo(b2[c]); db[2 * c + 1] = bfhi(b1[c]) - lam * bfhi(b2[c]);
            sa += da[2 * c] * da[2 * c] + da[2 * c + 1] * da[2 * c + 1]; sb += db[2 * c] * db[2 * c] + db[2 * c + 1] * db[2 * c + 1]; }
#pragma unroll
        for (int o = 1; o < 16; o <<= 1) { sa += __shfl_xor(sa, o); sb += __shfl_xor(sb, o); }
        const float ra = rsqrtf(sa * (1.0f / 128.0f) + EPS), rb = rsqrtf(sb * (1.0f / 128.0f) + EPS);
        u32x4 oa, ob;
#pragma unroll
        for (int c = 0; c < 4; ++c) { oa[c] = cvtpk(da[2 * c] * ra * g[2 * c], da[2 * c + 1] * ra * g[2 * c + 1]); ob[c] = cvtpk(db[2 * c] * rb * g[2 * c], db[2 * c + 1] * rb * g[2 * c + 1]); }
        *(u32x4*)(MIX + (size_t)t * 1024 + h * 128 + j0) = oa;
        if (two) *(u32x4*)(MIX + (size_t)t2 * 1024 + h * 128 + j0) = ob;
    }
}
__device__ __forceinline__ void pool_phase(const Args& a, int l, const bf16_t* PROJ, bf16_t* MIX, float* lds, int blk, int G, int tid) {
    typedef short bf16x8_t __attribute__((ext_vector_type(8)));
    constexpr int DS = 260;
    float* U = lds; float* Dd = lds + 31 * 256;
    const float* pw = a.in[8] + (size_t)l * 4 * 64 * 64; const float* ps = a.in[9] + l * 256;
    const int lane = tid & 63, wv = tid >> 6, g = wv & 3, nb0 = (wv >> 2) * 2, col = lane & 15, quad = lane >> 4;
    bf16x8_t bfr[2][2];
#pragma unroll
    for (int nb = 0; nb < 2; ++nb) { const int dd = (nb0 + nb) * 16 + col; const float sc = ps[g * 64 + dd];
#pragma unroll
        for (int ks = 0; ks < 2; ++ks) { u32x4 w;
#pragma unroll
            for (int q = 0; q < 4; ++q) { const int c = ks * 32 + quad * 8 + 2 * q; w[q] = cvtpk(pw[(g * 64 + c) * 64 + dd] * sc, pw[(g * 64 + c + 1) * 64 + dd] * sc); }
            bfr[nb][ks] = __builtin_bit_cast(bf16x8_t, w); } }
    u32x4 st0, st1;
#define POOL_FETCH(unit_) do { const int t0_ = (unit_) * 16, b_ = t0_ / SEQ, s0_ = t0_ % SEQ; \
        { const int r = tid >> 5, c8 = tid & 31, srow = s0_ - 15 + r; st0 = (u32x4){0u, 0u, 0u, 0u}; if (srow >= 0) st0 = *(const u32x4*)(PROJ + (size_t)(b_ * SEQ + srow) * INW + COL_UB + c8 * 8); } \
        { const int i2 = tid + 512, r = i2 >> 5, c8 = i2 & 31, srow = s0_ - 15 + r; st1 = (u32x4){0u, 0u, 0u, 0u}; if (i2 < 31 * 32 && srow >= 0) st1 = *(const u32x4*)(PROJ + (size_t)(b_ * SEQ + srow) * INW + COL_UB + c8 * 8); } } while (0)
    if (blk < M / 16) POOL_FETCH(blk);
    for (int unit = blk; unit < M / 16; unit += G) {
        const int t0 = unit * 16, s0 = t0 % SEQ;
        { f32x4* d = (f32x4*)(U + (tid >> 5) * 256 + (tid & 31) * 8);
          d[0] = (f32x4){bflo(st0.x), bfhi(st0.x), bflo(st0.y), bfhi(st0.y)}; d[1] = (f32x4){bflo(st0.z), bfhi(st0.z), bflo(st0.w), bfhi(st0.w)};
          const int i2 = tid + 512; if (i2 < 31 * 32) { f32x4* d2 = (f32x4*)(U + (i2 >> 5) * 256 + (i2 & 31) * 8);
              d2[0] = (f32x4){bflo(st1.x), bfhi(st1.x), bflo(st1.y), bfhi(st1.y)}; d2[1] = (f32x4){bflo(st1.z), bfhi(st1.z), bflo(st1.w), bfhi(st1.w)}; } }
        __syncthreads();
        if (unit + G < M / 16) POOL_FETCH(unit + G);
        { const int ch = tid & 255, tt0 = (tid >> 8) * 8, gg = ch >> 6, w = 2 << gg;
          float sum = 0.f;
          for (int j = 0; j < w; ++j) sum += U[(15 + tt0 - j) * 256 + ch];
#pragma unroll
          for (int i = 0; i < 8; ++i) { const int tt = tt0 + i, s = s0 + tt; const int cnt = (s + 1 < w) ? s + 1 : w;
              const float cur = U[(15 + tt) * 256 + ch];
              Dd[tt * DS + ch] = sum / (float)cnt - cur;
              if (i < 7) sum += U[(16 + tt) * 256 + ch] - U[(16 + tt - w) * 256 + ch]; } }
        __syncthreads();
        { f32x4 acc[2]; acc[0] = (f32x4){0.f, 0.f, 0.f, 0.f}; acc[1] = acc[0];
#pragma unroll
          for (int ks = 0; ks < 2; ++ks) {
              const f32x4* dp = (const f32x4*)(Dd + col * DS + g * 64 + ks * 32 + quad * 8); const f32x4 d0 = dp[0], d1 = dp[1];
              u32x4 w; w.x = cvtpk(d0.x, d0.y); w.y = cvtpk(d0.z, d0.w); w.z = cvtpk(d1.x, d1.y); w.w = cvtpk(d1.z, d1.w);
              const bf16x8_t af = __builtin_bit_cast(bf16x8_t, w);
              acc[0] = __builtin_amdgcn_mfma_f32_16x16x32_bf16(af, bfr[0][ks], acc[0], 0, 0, 0);
              acc[1] = __builtin_amdgcn_mfma_f32_16x16x32_bf16(af, bfr[1][ks], acc[1], 0, 0, 0); }
#pragma unroll
          for (int nb = 0; nb < 2; ++nb)
#pragma unroll
              for (int jj = 0; jj < 4; ++jj) MIX[(size_t)(t0 + quad * 4 + jj) * 1024 + 512 + g * 64 + (nb0 + nb) * 16 + col] = (bf16_t)(cvtpk(acc[nb][jj], 0.f) & 0xffffu); }
        __syncthreads();
    }
#undef POOL_FETCH
}
__device__ __forceinline__ void final_phase(float* out, const bf16_t* XH, const float* rowss, const float* g, int gw, int NGW, int lane) {
    for (int m = gw; m < M; m += NGW) {
        const float r = row_rs(rowss, m);
        f32x4* orow = (f32x4*)(out + (size_t)m * DM) + lane;
#pragma unroll
        for (int j = 0; j < 4; ++j) { const f32x4 gg = ((const f32x4*)g)[64 * j + lane]; const u32x2 h = *(const u32x2*)(XH + (size_t)m * DM + (64 * j + lane) * 4);
            const f32x4 v = {bflo(h.x), bfhi(h.x), bflo(h.y), bfhi(h.y)}; orow[64 * j] = v * r * gg; }
    }
}

namespace pg8 {
#define PG8_LAS __attribute__((address_space(3)))
typedef unsigned short bf16_t;
typedef short bf16x8 __attribute__((ext_vector_type(8)));
typedef float f32x4 __attribute__((ext_vector_type(4)));
typedef unsigned u32x4 __attribute__((ext_vector_type(4)));
constexpr int BM = 256, BK = 64, HALF = 128, HTB = HALF * BK * 2  , STAGE_BYTES = 8 * HTB, NXCD = 8, WGM = 8;

__host__ __device__ __forceinline__ int lds_byte(int r, int c) { const int st = (r >> 4) * 2 + (c >> 5), rr = r & 15, cc = c & 31, ob = rr * 64 + cc * 2; return st * 1024 + (ob ^ (((ob >> 9) & 1) << 5)); }
__host__ __device__ __forceinline__ void stage_rc(int b, int& R, int& C) { const int st = b / 1024, sb = b % 1024, swz = sb ^ (((sb >> 9) & 1) << 5); R = (st >> 1) * 16 + swz / 64; C = (st & 1) * 32 + (swz % 64) / 2; }
__host__ __device__ __forceinline__ int lds_byte2(int r, int ch) { return (r >> 3) * 1024 + (r & 7) * 128 + ((ch ^ ((r >> 1) & 7)) * 16); }
__host__ __device__ __forceinline__ void stage_rc2(int b, int& R, int& C) { const int p = b / 1024, l = (b % 1024) / 16; R = p * 8 + (l >> 3); C = ((l & 7) ^ ((R >> 1) & 7)) * 8; }
__host__ __device__ __forceinline__ int perm32(int rho) { const int n = rho >> 4, i = rho & 15; return 8 * (i >> 2) + 4 * n + (i & 3); }

struct Unit { int pm, pn; };
struct Gemm { const bf16_t* A; const bf16_t* Bt; int M, N, K, lda; };

struct StaticOrder {
    int nM, nN, nwg, G, c;
    __host__ __device__ void init(int M, int N, int G_, int c_) { nM = M / BM; nN = N / BM; nwg = nM * nN; G = G_; c = c_; }
    __host__ __device__ bool next(int i, Unit& u) const {
        const long L = (long)i * G + c; if (L >= nwg) return false;
        int wgid = (int)L; { const int q = nwg / NXCD, r = nwg % NXCD, xcd = wgid % NXCD, off = wgid / NXCD; wgid = (xcd < r ? xcd * (q + 1) : r * (q + 1) + (xcd - r) * q) + off; }
        const int nig = WGM * nN, gid = wgid / nig, fm = gid * WGM, gsz = (nM - fm) < WGM ? (nM - fm) : WGM;
        u.pm = fm + ((wgid % nig) % gsz); u.pn = (wgid % nig) / gsz; return true;
    }
    __device__ __forceinline__ void a_ready(const Unit&) const {}
    __device__ __forceinline__ void done(const Unit&) const {}
};


__device__ __forceinline__ unsigned cvt_pk_bf16(float lo, float hi) { typedef float f2 __attribute__((ext_vector_type(2))); typedef __bf16 b2 __attribute__((ext_vector_type(2))); f2 v = {lo, hi}; b2 b = __builtin_convertvector(v, b2); return __builtin_bit_cast(unsigned, b); }
struct EpiScale {
    static constexpr bool PERM = true, AFTER_DRAIN = false;
    bf16_t* O; int ldc; const float* rowss; int qscale;
    __device__ __forceinline__ void operator()(const f32x4 (&acc)[2][2][4][2], const Unit& u, int wr, int wc, int fr, int fq) const {
        const int row0 = u.pm * BM + wr * 64 + fr, col0 = u.pn * BM + wc * 32 + 8 * fq;
        const float cs = (qscale && (u.pn < 2 || u.pn == 7)) ? ::C2 : 1.0f;
#pragma unroll
        for (int ai = 0; ai < 2; ++ai)
#pragma unroll
            for (int m = 0; m < 4; ++m) { const int row = row0 + ai * HALF + m * 16; const float s = ::row_rs(rowss, row) * cs; bf16_t* rowp = O + (size_t)row * ldc + col0;
#pragma unroll
                for (int bj = 0; bj < 2; ++bj) { const f32x4 v0 = acc[ai][bj][m][0] * s, v1 = acc[ai][bj][m][1] * s;
                    u32x4 w; w.x = cvt_pk_bf16(v0[0], v0[1]); w.y = cvt_pk_bf16(v0[2], v0[3]); w.z = cvt_pk_bf16(v1[0], v1[1]); w.w = cvt_pk_bf16(v1[2], v1[3]);
                    *(u32x4*)(rowp + bj * HALF) = w; } }
    }
};
struct EpiResid {
    static constexpr bool PERM = true, AFTER_DRAIN = false;
    bf16_t* xh; float* rowss_next;
    __device__ __forceinline__ void operator()(const f32x4 (&acc)[2][2][4][2], const Unit& u, int wr, int wc, int fr, int fq) const {
        const int col0 = u.pn * BM + wc * 32 + 8 * fq;
#pragma unroll
        for (int ai = 0; ai < 2; ++ai)
#pragma unroll
            for (int m = 0; m < 4; ++m) { const int row = u.pm * BM + ai * HALF + wr * 64 + m * 16 + fr; const size_t off = (size_t)row * 1024 + col0; float ss = 0.f;
#pragma unroll
                for (int bj = 0; bj < 2; ++bj) { const size_t o = off + bj * HALF; const u32x4 h = *(const u32x4*)(xh + o); u32x4 nh;
#pragma unroll
                    for (int q = 0; q < 4; ++q) { const float x0 = ::bflo(h[q]) + acc[ai][bj][m][q >> 1][(q & 1) * 2], x1 = ::bfhi(h[q]) + acc[ai][bj][m][q >> 1][(q & 1) * 2 + 1];
                        ss += x0 * x0 + x1 * x1; nh[q] = cvt_pk_bf16(x0, x1); }
                    *(u32x4*)(xh + o) = nh; }
                ss += __shfl_xor(ss, 16); ss += __shfl_xor(ss, 32);
                if (fq == 0) rowss_next[(size_t)row * 16 + u.pn * 4 + wc] = ss; }
    }
};
__device__ __forceinline__ float dpp_shr1(float old, float v) { return __int_as_float(__builtin_amdgcn_update_dpp(__float_as_int(old), __float_as_int(v), 0x111, 0xf, 0xf, false)); }
__device__ __forceinline__ float dpp_shr2(float old, float v) { return __int_as_float(__builtin_amdgcn_update_dpp(__float_as_int(old), __float_as_int(v), 0x112, 0xf, 0xf, false)); }
__device__ __forceinline__ float dpp_ror1(float v) { return __int_as_float(__builtin_amdgcn_update_dpp(0, __float_as_int(v), 0x121, 0xf, 0xf, false)); }
__device__ __forceinline__ float dpp_ror2(float v) { return __int_as_float(__builtin_amdgcn_update_dpp(0, __float_as_int(v), 0x122, 0xf, 0xf, false)); }
struct EpiConvAct {
    static constexpr bool PERM = true, AFTER_DRAIN = false;
    bf16_t* ACT; const float* rowss; const float* cw; const float* cb; float* HEADA; float* HEADG; float* HALO;
    __device__ __forceinline__ void operator()(const f32x4 (&acc)[2][2][4][2], const Unit& u, int wr, int wc, int fr, int fq) const {
        constexpr int FF = 2816;
        const int ca = u.pn * 128 + wc * 32 + 8 * fq;
        float w0[8], w1[8], w2[8], bb[8];
#pragma unroll
        for (int h = 0; h < 2; ++h) { const f32x4 t0 = *(const f32x4*)(cw + ca + 4 * h), t1 = *(const f32x4*)(cw + FF + ca + 4 * h), t2 = *(const f32x4*)(cw + 2 * FF + ca + 4 * h), t3 = *(const f32x4*)(cb + ca + 4 * h);
#pragma unroll
            for (int j = 0; j < 4; ++j) { w0[4 * h + j] = t0[j]; w1[4 * h + j] = t1[j]; w2[4 * h + j] = t2[j]; bb[4 * h + j] = t3[j]; } }
#pragma unroll
        for (int ai = 0; ai < 2; ++ai) {
            const int blk = u.pm * 4 + ai * 2 + wr;
            float ap[8];
#pragma unroll
            for (int j = 0; j < 8; ++j) ap[j] = 0.f;
#pragma unroll
            for (int m = 0; m < 4; ++m) {
                const int row = u.pm * BM + ai * HALF + wr * 64 + m * 16 + fr; const float rs = ::row_rs(rowss, row);
                float a8[8], g8[8], y[8];
#pragma unroll
                for (int j = 0; j < 8; ++j) { a8[j] = acc[ai][0][m][j >> 2][j & 3] * rs; g8[j] = acc[ai][1][m][j >> 2][j & 3] * rs; }
#pragma unroll
                for (int j = 0; j < 8; ++j) { const float p1 = dpp_shr1(dpp_ror1(ap[j]), a8[j]), p2 = dpp_shr2(dpp_ror2(ap[j]), a8[j]);
                    const float x = bb[j] + w0[j] * p2 + w1[j] * p1 + w2[j] * a8[j];
                    y[j] = x * __builtin_amdgcn_rcpf(1.0f + __expf(-x)) * g8[j]; }
                if (m == 0 && fr < 2) { float* pa = HEADA + ((size_t)blk * 2 + fr) * FF + ca; float* pg = HEADG + ((size_t)blk * 2 + fr) * FF + ca;
                    *(f32x4*)pa = (f32x4){a8[0], a8[1], a8[2], a8[3]}; *(f32x4*)(pa + 4) = (f32x4){a8[4], a8[5], a8[6], a8[7]};
                    *(f32x4*)pg = (f32x4){g8[0], g8[1], g8[2], g8[3]}; *(f32x4*)(pg + 4) = (f32x4){g8[4], g8[5], g8[6], g8[7]}; }
                else { u32x4 w; w.x = cvt_pk_bf16(y[0], y[1]); w.y = cvt_pk_bf16(y[2], y[3]); w.z = cvt_pk_bf16(y[4], y[5]); w.w = cvt_pk_bf16(y[6], y[7]);
                    *(u32x4*)(ACT + (size_t)row * FF + ca) = w; }
                if (m == 3 && fr >= 14) { float* ph = HALO + ((size_t)blk * 2 + (fr - 14)) * FF + ca;
                    *(f32x4*)ph = (f32x4){a8[0], a8[1], a8[2], a8[3]}; *(f32x4*)(ph + 4) = (f32x4){a8[4], a8[5], a8[6], a8[7]}; }
#pragma unroll
                for (int j = 0; j < 8; ++j) ap[j] = a8[j];
            }
        }
    }
};
template <class Epi, class Sched, bool ALIGN_EPI = false, bool SP2 = false>
__device__ __forceinline__ void gemm_phase(PG8_LAS unsigned char* lds, const Gemm g, const Sched& S, const Epi& E) {
    int tid_ = threadIdx.x; asm volatile("" : "+v"(tid_));
    const int tid = tid_, wid = __builtin_amdgcn_readfirstlane(tid >> 6), lane = tid & 63, wr = wid >> 2, wc = wid & 3, fr = lane & 15, fq = lane >> 4;
    const int K = g.K, nt = K / BK;
    unsigned voffA[2], voffB[2];
#pragma unroll
    for (int i = 0; i < 2; ++i) { int R, C; stage_rc2(tid * 16 + i * 8192, R, C); const int Rb = Epi::PERM ? ((R & ~31) + perm32(R & 31)) : R;
        voffA[i] = (unsigned)(R * g.lda + C) * 2u; voffB[i] = (unsigned)(Rb * K + C) * 2u; }
    const size_t kstep = (size_t)(BK * 2);
    const size_t hstepA = (size_t)HALF * g.lda * 2, hstepB = (size_t)HALF * K * 2;
    const size_t tstepA = 2 * hstepA, tstepB = 2 * hstepB;
    const unsigned ldsw = (unsigned)wid * 1024u;
    const int aoffk[2] = {lds_byte2(wr * 64 + fr, fq), lds_byte2(wr * 64 + fr, 4 + fq)}, boffk[2] = {lds_byte2(wc * 32 + fr, fq), lds_byte2(wc * 32 + fr, 4 + fq)};
#define PG8_SA(b, h) (((b) * 2 + (h)) * HTB)
#define PG8_SB(b, h) ((4 + (b) * 2 + (h)) * HTB)
#define PG8_STAGE(bufoff, gbase, voff) do { _Pragma("unroll") for (int _i = 0; _i < 2; ++_i) \
        __builtin_amdgcn_global_load_lds((const unsigned*)((const char*)(gbase) + (voff)[_i]), (PG8_LAS unsigned*)(lds + (bufoff) + ldsw + _i * 8192), 16, 0, 0); } while (0)
#define PG8_LDA(dst, b, h) do { _Pragma("unroll") for (int m = 0; m < 4; ++m) _Pragma("unroll") for (int k = 0; k < 2; ++k) dst[m][k] = *(const PG8_LAS bf16x8*)(lds + PG8_SA(b, h) + aoffk[k] + m * 2048); } while (0)
#define PG8_LDB(dst, b, h) do { _Pragma("unroll") for (int n = 0; n < 2; ++n) _Pragma("unroll") for (int k = 0; k < 2; ++k) dst[n][k] = *(const PG8_LAS bf16x8*)(lds + PG8_SB(b, h) + boffk[k] + n * 2048); } while (0)
#define PG8_MMA(ai, bj, At, Bt) do { __builtin_amdgcn_s_setprio(1); _Pragma("unroll") for (int m = 0; m < 4; ++m) _Pragma("unroll") for (int n = 0; n < 2; ++n) _Pragma("unroll") for (int k = 0; k < 2; ++k) \
        acc[ai][bj][m][n] = __builtin_amdgcn_mfma_f32_16x16x32_bf16(Bt[n][k], At[m][k], acc[ai][bj][m][n], 0, 0, 0); __builtin_amdgcn_s_setprio(0); } while (0)
#define PG8_WAIT_V(n) asm volatile("s_waitcnt vmcnt(" #n ")" ::: "memory")
#define PG8_WAIT_L(n) asm volatile("s_waitcnt lgkmcnt(" #n ")" ::: "memory")
#define PG8_BAR __builtin_amdgcn_s_barrier()
#define PG8_SCHED __builtin_amdgcn_sched_barrier(0)
    Unit cur, nxt; int ui = 0;
    if (!S.next(0, cur)) return;
    f32x4 acc[2][2][4][2];
#pragma unroll
    for (int a = 0; a < 2; ++a)
#pragma unroll
        for (int b = 0; b < 2; ++b)
#pragma unroll
            for (int m = 0; m < 4; ++m)
#pragma unroll
                for (int n = 0; n < 2; ++n) acc[a][b][m][n] = (f32x4){0.f, 0.f, 0.f, 0.f};
    bf16x8 At[4][2], B0[2][2], B1[2][2];
    const char* cA = (const char*)g.A + (size_t)cur.pm * tstepA; const char* cB = (const char*)g.Bt + (size_t)cur.pn * tstepB;
    S.a_ready(cur);
    if constexpr (SP2) {
        PG8_STAGE(PG8_SB(0, 0), cB, voffB); PG8_STAGE(PG8_SB(0, 1), cB + hstepB, voffB); PG8_STAGE(PG8_SA(0, 0), cA, voffA); PG8_STAGE(PG8_SA(0, 1), cA + hstepA, voffA);
        if (wr == 1) PG8_BAR;
        PG8_WAIT_V(2); PG8_BAR;
        PG8_STAGE(PG8_SB(1, 0), cB + kstep, voffB); PG8_STAGE(PG8_SA(1, 0), cA + kstep, voffA); PG8_STAGE(PG8_SB(1, 1), cB + hstepB + kstep, voffB);
        PG8_WAIT_V(6); PG8_BAR;
    } else {
        PG8_STAGE(PG8_SB(0, 0), cB, voffB); PG8_STAGE(PG8_SA(0, 0), cA, voffA); PG8_STAGE(PG8_SB(0, 1), cB + hstepB, voffB); PG8_STAGE(PG8_SA(0, 1), cA + hstepA, voffA);
        if (wr == 1) PG8_BAR;
        PG8_WAIT_V(4); PG8_BAR;
        PG8_STAGE(PG8_SB(1, 0), cB + kstep, voffB); PG8_STAGE(PG8_SA(1, 0), cA + kstep, voffA); PG8_STAGE(PG8_SB(1, 1), cB + hstepB + kstep, voffB);
        PG8_WAIT_V(6); PG8_BAR;
    }
    for (;;) {
        const bool has_next = S.next(ui + 1, nxt);
        const char* nA = has_next ? (const char*)g.A + (size_t)nxt.pm * tstepA : cA; const char* nB = has_next ? (const char*)g.Bt + (size_t)nxt.pn * tstepB : cB;
        for (int t = 0; t < nt; t += 2) {
            const bool last = (t == nt - 2);
            const char* a1 = cA + (size_t)(t + 1) * kstep;
            const char* a2 = last ? nA : cA + (size_t)(t + 2) * kstep; const char* b2 = last ? nB : cB + (size_t)(t + 2) * kstep;
            const char* a3 = a2 + kstep; const char* b3 = b2 + kstep;
            if (last && has_next) S.a_ready(nxt);
            if constexpr (SP2) {
            PG8_LDB(B0, 0, 0); PG8_LDB(B1, 0, 1); PG8_SCHED; PG8_LDA(At, 0, 0); PG8_STAGE(PG8_SA(1, 1), a1 + hstepA, voffA);
            PG8_WAIT_V(8); PG8_WAIT_L(0); PG8_BAR; PG8_MMA(0, 0, At, B0); PG8_MMA(0, 1, At, B1); PG8_BAR; PG8_SCHED;
            PG8_LDA(At, 0, 1); PG8_STAGE(PG8_SB(0, 0), b2, voffB); PG8_STAGE(PG8_SB(0, 1), b2 + hstepB, voffB); PG8_STAGE(PG8_SA(0, 0), a2, voffA);
            PG8_WAIT_V(8); PG8_WAIT_L(0); PG8_BAR; PG8_MMA(1, 0, At, B0); PG8_MMA(1, 1, At, B1); PG8_BAR; PG8_SCHED;
            PG8_LDB(B0, 1, 0); PG8_LDB(B1, 1, 1); PG8_SCHED; PG8_LDA(At, 1, 0); PG8_STAGE(PG8_SA(0, 1), a2 + hstepA, voffA);
            PG8_WAIT_V(8); PG8_WAIT_L(0); PG8_BAR; PG8_MMA(0, 0, At, B0); PG8_MMA(0, 1, At, B1); PG8_BAR; PG8_SCHED;
            PG8_LDA(At, 1, 1); PG8_STAGE(PG8_SB(1, 0), b3, voffB); PG8_STAGE(PG8_SB(1, 1), b3 + hstepB, voffB); PG8_STAGE(PG8_SA(1, 0), a3, voffA);
            PG8_WAIT_V(8); PG8_WAIT_L(0); PG8_BAR; PG8_MMA(1, 0, At, B0); PG8_MMA(1, 1, At, B1); PG8_BAR; PG8_SCHED;
            } else {
            PG8_LDB(B0, 0, 0); PG8_SCHED; PG8_LDA(At, 0, 0); PG8_STAGE(PG8_SA(1, 1), a1 + hstepA, voffA);
            PG8_WAIT_L(8); PG8_BAR; PG8_WAIT_L(0); PG8_MMA(0, 0, At, B0); PG8_BAR; PG8_SCHED;
            PG8_LDB(B1, 0, 1); PG8_STAGE(PG8_SB(0, 0), b2, voffB);
            PG8_BAR; PG8_WAIT_L(0); PG8_MMA(0, 1, At, B1); PG8_BAR;
            PG8_LDA(At, 0, 1); PG8_STAGE(PG8_SA(0, 0), a2, voffA);
            PG8_BAR; PG8_WAIT_L(0); PG8_MMA(1, 0, At, B0); PG8_BAR; PG8_SCHED;
            PG8_STAGE(PG8_SB(0, 1), b2 + hstepB, voffB);
            PG8_WAIT_V(6); PG8_BAR; PG8_MMA(1, 1, At, B1); PG8_BAR;
            PG8_LDB(B0, 1, 0); PG8_SCHED; PG8_LDA(At, 1, 0); PG8_STAGE(PG8_SA(0, 1), a2 + hstepA, voffA);
            PG8_WAIT_L(8); PG8_BAR; PG8_WAIT_L(0); PG8_MMA(0, 0, At, B0); PG8_BAR; PG8_SCHED;
            PG8_LDB(B1, 1, 1); PG8_STAGE(PG8_SB(1, 0), b3, voffB);
            PG8_BAR; PG8_WAIT_L(0); PG8_MMA(0, 1, At, B1); PG8_BAR;
            PG8_LDA(At, 1, 1); PG8_STAGE(PG8_SA(1, 0), a3, voffA);
            PG8_BAR; PG8_WAIT_L(0); PG8_MMA(1, 0, At, B0); PG8_BAR; PG8_SCHED;
            PG8_STAGE(PG8_SB(1, 1), b3 + hstepB, voffB);
            PG8_WAIT_V(6); PG8_BAR; PG8_MMA(1, 1, At, B1); PG8_BAR;
            }
        }
        if constexpr (ALIGN_EPI) { if (wr == 0) PG8_BAR; }
        if constexpr (!Epi::AFTER_DRAIN) { E(acc, cur, wr, wc, fr, fq); S.done(cur); }
        if (!has_next) break;
#pragma unroll
        for (int a = 0; a < 2; ++a)
#pragma unroll
            for (int b = 0; b < 2; ++b)
#pragma unroll
                for (int m = 0; m < 4; ++m)
#pragma unroll
                    for (int n = 0; n < 2; ++n) acc[a][b][m][n] = (f32x4){0.f, 0.f, 0.f, 0.f};
        cur = nxt; cA = nA; cB = nB; ++ui;
        if constexpr (ALIGN_EPI) { if (wr == 1) PG8_BAR; }
    }
    PG8_WAIT_V(0);
    if constexpr (!ALIGN_EPI) { if (wr == 0) PG8_BAR; }
    PG8_BAR;
    if constexpr (Epi::AFTER_DRAIN) { E.fused(acc, cur, wr, wc, fr, fq, lds, wid, lane); S.done(cur); }
#undef PG8_SA
#undef PG8_SB
#undef PG8_STAGE
#undef PG8_LDA
#undef PG8_LDB
#undef PG8_MMA
#undef PG8_WAIT_V
#undef PG8_WAIT_L
#undef PG8_BAR
#undef PG8_SCHED
}
}

#include <hip/hip_bf16.h>
namespace attn_body {
using bf16=__hip_bfloat16;
using bf16x8=__attribute__((ext_vector_type(8)))short;
using s16x4=__attribute__((ext_vector_type(4)))short;
using f32x16=__attribute__((ext_vector_type(16)))float;
using u32x4=__attribute__((ext_vector_type(4)))unsigned;
constexpr int SEQ=8192,D=64,PQ=2560,PO=1024;
constexpr int NW=8,QBLK=32,QB=QBLK*NW,KVBLK=64,NQB=SEQ/QB;
constexpr int ATTN_UNIT_ROWS=QB;
__device__ __forceinline__ int crow(int r,int hi){return (r&3)+8*(r>>2)+4*hi;}
#define SBAR() __builtin_amdgcn_sched_barrier(0)
__device__ __forceinline__ void cmask(f32x16&p0,f32x16&p1,int jb,int qrel,int hi){
  const float NEG=-INFINITY; (void)hi;
  if(jb>(qrel>>6)){
  #pragma unroll
  for(int r=0;r<16;++r){p0[r]=NEG;p1[r]=NEG;}}
}

constexpr int NSLOT=3, SLOTB=8192;
constexpr int LDS_K=0, LDS_V=NSLOT*SLOTB, LDS_WS=2*NSLOT*SLOTB, LDS_OST=LDS_WS+NW*64*4, LDS_BYTES=LDS_OST+NW*4096;
constexpr float C2=0.125f*1.4426950408889634f;
__device__ __forceinline__ void glds16(const void*gsrc,unsigned lds_dst){unsigned keep;
  asm volatile("s_mov_b32 %0, m0\n\ts_mov_b32 m0, %2\n\ts_nop 0\n\tglobal_load_lds_dwordx4 %1, off\n\ts_mov_b32 m0, %0":"=&s"(keep):"v"(gsrc),"s"(lds_dst):"memory");}
__device__ __forceinline__ float max3f(float a,float b,float c){float r;asm("v_max3_f32 %0, %1, %2, %3":"=v"(r):"v"(a),"v"(b),"v"(c));return r;}
__device__ __forceinline__ float max2f(float a,float b){float r;asm("v_max_f32_e32 %0, %1, %2":"=v"(r):"v"(a),"v"(b));return r;}
__device__ __forceinline__ float fadd_s(float a,float b){float r;asm("v_add_f32_e32 %0, %1, %2":"=v"(r):"v"(a),"v"(b));return r;}
__device__ __forceinline__ float fsub_s(float a,float b){float r;asm("v_sub_f32_e32 %0, %1, %2":"=v"(r):"v"(a),"v"(b));return r;}
typedef float f32x2_t __attribute__((ext_vector_type(2))); typedef __bf16 bf16x2_t __attribute__((ext_vector_type(2)));
__device__ __forceinline__ unsigned cvtpk_s(float lo,float hi){f32x2_t v={lo,hi};bf16x2_t b=__builtin_convertvector(v,bf16x2_t);return __builtin_bit_cast(unsigned,b);}
#define WAIT_BAR(N) asm volatile("s_waitcnt vmcnt(" #N ") lgkmcnt(0)\n\ts_barrier":::"memory")

__device__ __forceinline__ void qkt(f32x16&p0,f32x16&p1,const char*Kslot,const bf16x8*qr,const f32x16&negm,int r32,int hi){
  const char*kb=Kslot+hi*1024+r32*16;
  #pragma unroll
  for(int d0=0;d0<4;++d0){
    const bf16x8 b0=*reinterpret_cast<const bf16x8*>(kb+d0*2048);
    const bf16x8 b1=*reinterpret_cast<const bf16x8*>(kb+d0*2048+512);
    if(d0==0){p0=__builtin_amdgcn_mfma_f32_32x32x16_bf16(b0,qr[0],negm,0,0,0);p1=__builtin_amdgcn_mfma_f32_32x32x16_bf16(b1,qr[0],negm,0,0,0);}
    else{p0=__builtin_amdgcn_mfma_f32_32x32x16_bf16(b0,qr[d0],p0,0,0,0);p1=__builtin_amdgcn_mfma_f32_32x32x16_bf16(b1,qr[d0],p1,0,0,0);}}
}
typedef __attribute__((address_space(3))) const char* lds_cptr;
typedef short v4i16_t __attribute__((ext_vector_type(4)));
__device__ __forceinline__ void kload8(bf16x8*kf,lds_cptr kp){
  kf[0]=*(const __attribute__((address_space(3))) bf16x8*)(kp);      kf[1]=*(const __attribute__((address_space(3))) bf16x8*)(kp+512);
  kf[2]=*(const __attribute__((address_space(3))) bf16x8*)(kp+2048); kf[3]=*(const __attribute__((address_space(3))) bf16x8*)(kp+2560);
  kf[4]=*(const __attribute__((address_space(3))) bf16x8*)(kp+4096); kf[5]=*(const __attribute__((address_space(3))) bf16x8*)(kp+4608);
  kf[6]=*(const __attribute__((address_space(3))) bf16x8*)(kp+6144); kf[7]=*(const __attribute__((address_space(3))) bf16x8*)(kp+6656);
}
__device__ __forceinline__ void kload2(bf16x8*kf,lds_cptr kp,int j){ kf[2*j]=*(const __attribute__((address_space(3))) bf16x8*)(kp+j*2048); kf[2*j+1]=*(const __attribute__((address_space(3))) bf16x8*)(kp+j*2048+512); }
__device__ __forceinline__ s16x4 vtr(lds_cptr p){ return __builtin_bit_cast(s16x4,__builtin_amdgcn_ds_read_tr16_b64_v4i16((__attribute__((address_space(3))) v4i16_t*)p)); }
__device__ __forceinline__ float rowmax(const f32x16&p0,const f32x16&p1){
  float a=max3f(p0[0],p0[1],p1[0]),b=max3f(p0[2],p0[3],p1[1]);a=max3f(a,p1[2],p1[3]);
  #pragma unroll
  for(int r=4;r<16;r+=4){a=max3f(a,p0[r],p0[r+1]);b=max3f(b,p0[r+2],p0[r+3]);a=max3f(a,p1[r],p1[r+1]);b=max3f(b,p1[r+2],p1[r+3]);}
  const float m=max2f(a,b);
  auto rr=__builtin_amdgcn_permlane32_swap(__float_as_uint(m),__float_as_uint(m),false,false);
  return max2f(__uint_as_float(rr[0]),__uint_as_float(rr[1]));
}
__device__ __forceinline__ void pv(f32x16*o,int vb,bf16x8 pa0,bf16x8 pa1,bf16x8 pa2,bf16x8 pa3){
  #pragma unroll
  for(int d0=0;d0<2;++d0){s16x4 lo[4],hi[4];
    #pragma unroll
    for(int ks=0;ks<4;++ks){
      asm volatile("ds_read_b64_tr_b16 %0,%1 offset:%c2":"=&v"(lo[ks]):"v"(vb),"i"(d0*4096+ks*1024):"memory");
      asm volatile("ds_read_b64_tr_b16 %0,%1 offset:%c2":"=&v"(hi[ks]):"v"(vb),"i"(d0*4096+ks*1024+512):"memory");}
    asm volatile("s_waitcnt lgkmcnt(0)":::"memory");SBAR();
    #define PK(k) (bf16x8){lo[k][0],lo[k][1],lo[k][2],lo[k][3],hi[k][0],hi[k][1],hi[k][2],hi[k][3]}
    o[d0]=__builtin_amdgcn_mfma_f32_32x32x16_bf16(pa0,PK(0),o[d0],0,0,0);
    o[d0]=__builtin_amdgcn_mfma_f32_32x32x16_bf16(pa1,PK(1),o[d0],0,0,0);
    o[d0]=__builtin_amdgcn_mfma_f32_32x32x16_bf16(pa2,PK(2),o[d0],0,0,0);
    o[d0]=__builtin_amdgcn_mfma_f32_32x32x16_bf16(pa3,PK(3),o[d0],0,0,0);
    #undef PK
  }
}

#ifndef ATTN_STORE16
#define ATTN_STORE16(p,v) (*(u32x4*)(p)=(v))
#endif
template<int THRL> __device__ __forceinline__ void attn_unit(int b,int qb,const bf16*Q,const bf16*__restrict__ K,const bf16*__restrict__ V,bf16*O,char*shm){
  int tid_=threadIdx.x; asm volatile("":"+v"(tid_)); const int tid=tid_,lane=tid&63,r32=lane&31,hi=lane>>5; const int wid=__builtin_amdgcn_readfirstlane(tid>>6);
  const long rowbase=(long)b*SEQ; const int q0=qb*QB;
  const bf16*Qw=Q+(rowbase+q0+wid*QBLK)*PQ;
  const bf16*Kh=K+rowbase*PQ,*Vh=V+rowbase*PQ;
  const unsigned lds0=(unsigned)(uintptr_t)shm;
  float*wsf=(float*)(shm+LDS_WS)+wid*64;
  const bf16*ksrc=Kh+(long)lane*PQ+wid*8;
  const bf16*vsrc=Vh+(long)(16*(wid&3)+(lane>>2))*PQ+(wid>>2)*32+(lane&3)*8;
  const unsigned kdst=lds0+LDS_K+wid*1024, vdst=lds0+LDS_V+wid*1024;
  #define DMA_K(t,slot) glds16(ksrc+(long)(t)*KVBLK*PQ,(unsigned)__builtin_amdgcn_readfirstlane(kdst+(slot)))
  #define DMA_V(t,slot) glds16(vsrc+(long)(t)*KVBLK*PQ,(unsigned)__builtin_amdgcn_readfirstlane(vdst+(slot)))
  const int vb0=(int)(lds0+LDS_V)+((lane>>4)&1)*32+(lane&3)*8+(4*hi+((lane&15)>>2))*64;
  const char*Kbase=shm+LDS_K; bf16x8 kf[8];
  const lds_cptr shm3=(lds_cptr)shm; const lds_cptr kp0=shm3+LDS_K+hi*1024+r32*16; const lds_cptr vp0=shm3+LDS_V+((lane>>4)&1)*32+(lane&3)*8+(4*hi+((lane&15)>>2))*64;
  const int NT=(q0+QB)/KVBLK;
  DMA_K(0,0);DMA_V(0,0);DMA_K(1,SLOTB);
  bf16x8 qr[4];
  #pragma unroll
  for(int d0=0;d0<4;++d0)qr[d0]=*reinterpret_cast<const bf16x8*>(&Qw[(long)r32*PQ+d0*16+hi*8]);
  float mhat=0.f,l_reg=0.f;f32x16 o[2];o[0]=f32x16{};o[1]=f32x16{};f32x16 negm=f32x16{};asm volatile("":"+v"(negm));
  const int qrel=wid*QBLK+r32;
  #define CMASK(P0,P1,t) do{int jb_=(t)-(NT-4); if(jb_>=0)cmask(P0,P1,jb_,qrel,hi);}while(0)
  bool resc=false;
  #define START(P0,P1) do{ const float rm=rowmax(P0,P1); resc=false; \
    { const float dl=rm; mhat=fadd_s(mhat,dl); \
      _Pragma("unroll") for(int r=0;r<16;++r){P0[r]=fsub_s(P0[r],dl);P1[r]=fsub_s(P1[r],dl);} \
      _Pragma("unroll") for(int r=0;r<16;++r)negm[r]=-mhat; asm volatile("":"+v"(negm)); } \
    _Pragma("unroll") for(int r=0;r<16;++r)P0[r]=__builtin_amdgcn_exp2f(P0[r]); }while(0)
  #define RESC() do{ if(resc){ asm volatile("s_waitcnt lgkmcnt(0)":::"memory"); \
      _Pragma("unroll") for(int d_=0;d_<2;++d_) _Pragma("unroll") for(int r=0;r<16;++r)o[d_][r]*=wsf[crow(r,hi)]; } }while(0)
  f32x16 pA0,pA1,pB0,pB1;
  int sl_prev=0,sl_cur=0,sl_next=SLOTB;
  #define ROT() do{sl_prev=sl_cur;sl_cur=sl_next;sl_next=(sl_next==(NSLOT-1)*SLOTB)?0:sl_next+SLOTB;}while(0)
  DMA_K(2,2*SLOTB);
  WAIT_BAR(3);
  qkt(pA0,pA1,Kbase,qr,negm,r32,hi);asm volatile("s_nop 15\n\ts_nop 7":"+v"(pA0),"+v"(pA1));CMASK(pA0,pA1,0);
  START(pA0,pA1);
  _Pragma("unroll") for(int r=0;r<16;++r)pA1[r]=__builtin_amdgcn_exp2f(pA1[r]);
  WAIT_BAR(0);
  DMA_K(3,0);DMA_V(1,SLOTB);
  ROT();
  kload8(kf,kp0+sl_cur);
  WAIT_BAR(2);
  s16x4 vlo[8],vhi[8]; u32x4 pw0,pw1,pw2,pw3;
  #define PKW(P,B) cvtpk_s(P[B],P[B+1])
  #define PAF(k) __builtin_bit_cast(bf16x8,pw##k)
  #define VFR(i) (bf16x8){vlo[i][0],vlo[i][1],vlo[i][2],vlo[i][3],vhi[i][0],vhi[i][1],vhi[i][2],vhi[i][3]}
  #define PIN(x) asm volatile("":"+v"(x))
  #define MX3(a,b,c) __builtin_fmaxf(__builtin_fmaxf((a),(b)),(c))
  #define GAPA(MF,A0,A1,A2,A3,W0,W1,PW) do{ MF; sacc+=A0; sacc+=A1; sacc+=A2; sacc+=A3; PIN(sacc); W0; W1; PIN(PW); SBAR(); }while(0)
  #define EX(v) __builtin_amdgcn_exp2f(v)
  #define GAPB(MF,X,B) do{ MF; X[B]=EX(X[B]); X[B+1]=EX(X[B+1]); X[B+2]=EX(X[B+2]); X[B+3]=EX(X[B+3]); PIN(X); SBAR(); }while(0)
  #define VRD(i) do{ vlo[i]=vtr(vp_+(((i)>>2)*4096+((i)&3)*1024)); vhi[i]=vtr(vp_+(((i)>>2)*4096+((i)&3)*1024+512)); }while(0)
  #define KRD(G,j) do{ if(G){ kload2(kf,kp0+sl_next,j); SBAR(); } }while(0)
  #define STEP(C0,C1,P0,P1,t,GK,GV,GL) do{ SBAR(); \
    const lds_cptr vp_=vp0+sl_prev; \
    VRD(0); SBAR(); float sacc=(P0[0]+P0[1]); \
    GAPA(C0=__builtin_amdgcn_mfma_f32_32x32x16_bf16(kf[0],qr[0],negm,0,0,0), P0[2],P0[3],P0[4],P0[5],     pw0[0]=PKW(P0,0), pw0[1]=PKW(P0,2), pw0); \
    VRD(4); SBAR(); GAPA(C1=__builtin_amdgcn_mfma_f32_32x32x16_bf16(kf[1],qr[0],negm,0,0,0), P0[6],P0[7],P0[8],P0[9],     pw0[2]=PKW(P0,4), pw0[3]=PKW(P0,6), pw0); \
    VRD(1); SBAR(); GAPA(C0=__builtin_amdgcn_mfma_f32_32x32x16_bf16(kf[2],qr[1],C0,0,0,0),   P0[10],P0[11],P0[12],P0[13], pw1[0]=PKW(P0,8), pw1[1]=PKW(P0,10), pw1); \
    VRD(5); SBAR(); GAPA(C1=__builtin_amdgcn_mfma_f32_32x32x16_bf16(kf[3],qr[1],C1,0,0,0),   P0[14],P0[15],P1[0],P1[1],   pw1[2]=PKW(P0,12),pw1[3]=PKW(P0,14), pw1); \
    VRD(2); SBAR(); GAPA(C0=__builtin_amdgcn_mfma_f32_32x32x16_bf16(kf[4],qr[2],C0,0,0,0),   P1[2],P1[3],P1[4],P1[5],     pw2[0]=PKW(P1,0), pw2[1]=PKW(P1,2), pw2); \
    VRD(6); SBAR(); GAPA(C1=__builtin_amdgcn_mfma_f32_32x32x16_bf16(kf[5],qr[2],C1,0,0,0),   P1[6],P1[7],P1[8],P1[9],     pw2[2]=PKW(P1,4), pw2[3]=PKW(P1,6), pw2); \
    VRD(3); SBAR(); GAPA(C0=__builtin_amdgcn_mfma_f32_32x32x16_bf16(kf[6],qr[3],C0,0,0,0),   P1[10],P1[11],P1[12],P1[13], pw3[0]=PKW(P1,8), pw3[1]=PKW(P1,10), pw3); \
    VRD(7); SBAR(); GAPA(C1=__builtin_amdgcn_mfma_f32_32x32x16_bf16(kf[7],qr[3],C1,0,0,0),   P1[14],P1[15],0.f,0.f,       pw3[2]=PKW(P1,12),pw3[3]=PKW(P1,14), pw3); \
    l_reg+=sacc; \
    if(GK){DMA_K((t)+3,sl_cur);} if(GV){DMA_V((t)+1,sl_next);} \
    CMASK(C0,C1,t); \
    { float a=MX3(C0[0],C0[1],C1[0]),b=MX3(C0[2],C0[3],C1[1]); a=MX3(a,C1[2],C1[3]); \
      _Pragma("unroll") for(int r=4;r<16;r+=4){a=MX3(a,C0[r],C0[r+1]);b=MX3(b,C0[r+2],C0[r+3]);a=MX3(a,C1[r],C1[r+1]);b=MX3(b,C1[r+2],C1[r+3]);} \
      float rm=__builtin_fmaxf(a,b); { auto rr=__builtin_amdgcn_permlane32_swap(__float_as_uint(rm),__float_as_uint(rm),false,false); rm=__builtin_fmaxf(__uint_as_float(rr[0]),__uint_as_float(rr[1])); } \
      resc=false; \
      if(__builtin_expect(__any(rm>(float)THRL),0)){ const float dl=__builtin_fmaxf(rm,0.f); mhat+=dl; \
        _Pragma("unroll") for(int r=0;r<16;++r){C0[r]-=dl;C1[r]-=dl;} \
        _Pragma("unroll") for(int r=0;r<16;++r)negm[r]=-mhat; asm volatile("":"+v"(negm)); \
        const float f=__builtin_amdgcn_exp2f(-dl); l_reg*=f; if(hi==0)wsf[r32]=f; resc=true; } } \
    SBAR(); \
    GAPB(o[0]=__builtin_amdgcn_mfma_f32_32x32x16_bf16(PAF(0),VFR(0),o[0],0,0,0), C0,0); \
    GAPB(o[1]=__builtin_amdgcn_mfma_f32_32x32x16_bf16(PAF(0),VFR(4),o[1],0,0,0), C0,4); \
    KRD(GL,0); GAPB(o[0]=__builtin_amdgcn_mfma_f32_32x32x16_bf16(PAF(1),VFR(1),o[0],0,0,0), C0,8); \
    KRD(GL,1); GAPB(o[1]=__builtin_amdgcn_mfma_f32_32x32x16_bf16(PAF(1),VFR(5),o[1],0,0,0), C0,12); \
    KRD(GL,2); GAPB(o[0]=__builtin_amdgcn_mfma_f32_32x32x16_bf16(PAF(2),VFR(2),o[0],0,0,0), C1,0); \
    KRD(GL,3); GAPB(o[1]=__builtin_amdgcn_mfma_f32_32x32x16_bf16(PAF(2),VFR(6),o[1],0,0,0), C1,4); \
    GAPB(o[0]=__builtin_amdgcn_mfma_f32_32x32x16_bf16(PAF(3),VFR(3),o[0],0,0,0), C1,8); \
    GAPB(o[1]=__builtin_amdgcn_mfma_f32_32x32x16_bf16(PAF(3),VFR(7),o[1],0,0,0), C1,12); \
    }while(0)
  int t=1;
  #undef CMASK
  #define CMASK(P0,P1,t) do{}while(0)
  for(;t+5<NT;t+=2){
    STEP(pB0,pB1,pA0,pA1,t,true,true,true);     WAIT_BAR(2); RESC(); ROT();
    STEP(pA0,pA1,pB0,pB1,t+1,true,true,true);   WAIT_BAR(2); RESC(); ROT();
  }
  #undef CMASK
  #define CMASK(P0,P1,t) do{int jb_=(t)-(NT-4); if(jb_>=0)cmask(P0,P1,jb_,qrel,hi);}while(0)
  #define ENDW(tt) do{ if((tt)+3<NT){WAIT_BAR(2);} else if((tt)+2<NT){WAIT_BAR(1);} else {WAIT_BAR(0);} }while(0)
  for(;t+1<NT;t+=2){
    STEP(pB0,pB1,pA0,pA1,t,(t+3<NT),(t+1<NT),(t+1<NT));       ENDW(t);   RESC(); ROT();
    STEP(pA0,pA1,pB0,pB1,t+1,(t+4<NT),(t+2<NT),(t+2<NT));     ENDW(t+1); RESC(); ROT();
  }
  STEP(pB0,pB1,pA0,pA1,NT-1,false,false,false); RESC();
  { float sacc=pB0[0]+pB0[1]; _Pragma("unroll") for(int r=2;r<16;++r)sacc+=pB0[r]; _Pragma("unroll") for(int r=0;r<16;++r)sacc+=pB1[r]; l_reg+=sacc;
    pw0=(u32x4){PKW(pB0,0),PKW(pB0,2),PKW(pB0,4),PKW(pB0,6)};pw1=(u32x4){PKW(pB0,8),PKW(pB0,10),PKW(pB0,12),PKW(pB0,14)};pw2=(u32x4){PKW(pB1,0),PKW(pB1,2),PKW(pB1,4),PKW(pB1,6)};pw3=(u32x4){PKW(pB1,8),PKW(pB1,10),PKW(pB1,12),PKW(pB1,14)};
    SBAR(); pv(o,vb0+sl_cur,PAF(0),PAF(1),PAF(2),PAF(3)); }
  #undef PKW
  #undef PAF
  #undef VFR
  #undef PIN
  #undef MX3
  #undef GAPA
  #undef GAPB
  #undef EX
  #undef VRD
  #undef KRD
  #undef STEP
  #undef ENDW
  {auto rr=__builtin_amdgcn_permlane32_swap(__float_as_uint(l_reg),__float_as_uint(l_reg),false,false);l_reg=__uint_as_float(rr[0])+__uint_as_float(rr[1]);}
  if(hi==0)wsf[32+r32]=l_reg;asm volatile("s_waitcnt lgkmcnt(0)":::"memory");
  float rli[16];
  #pragma unroll
  for(int r=0;r<16;++r)rli[r]=__builtin_amdgcn_rcpf(wsf[32+crow(r,hi)]);
  bf16*Ow=O+(rowbase+q0+wid*QBLK)*PO;
  { bf16*stg=(bf16*)(shm+LDS_OST)+wid*2048;
    #pragma unroll
    for(int r=0;r<16;++r){const int orow=crow(r,hi);
      #pragma unroll
      for(int d0=0;d0<2;++d0)stg[orow*64+d0*32+r32]=__float2bfloat16(o[d0][r]*rli[r]);}
    asm volatile("s_waitcnt lgkmcnt(0)":::"memory");
    #pragma unroll
    for(int i=0;i<4;++i){const int row=i*8+(lane>>3),ch=lane&7; const u32x4 v=*(const u32x4*)(stg+row*64+ch*8); ATTN_STORE16(Ow+(long)row*PO+ch*8,v);} }
  asm volatile("s_waitcnt lgkmcnt(0)\n\ts_barrier":::"memory");
  #undef DMA_K
  #undef DMA_V
  #undef CMASK
  #undef START
  #undef RESC
  #undef ROT
}


#define PV128_RD(LO,HI,vp,goff) do{ _Pragma("unroll") for(int ks=0;ks<4;++ks){ LO[ks]=vtr((vp)+((goff)+ks*1024)); HI[ks]=vtr((vp)+((goff)+ks*1024+512)); } }while(0)
#define PV128_MM(O,LO,HI) do{ \
    O=__builtin_amdgcn_mfma_f32_32x32x16_bf16(pa0,(bf16x8){LO[0][0],LO[0][1],LO[0][2],LO[0][3],HI[0][0],HI[0][1],HI[0][2],HI[0][3]},O,0,0,0); \
    O=__builtin_amdgcn_mfma_f32_32x32x16_bf16(pa1,(bf16x8){LO[1][0],LO[1][1],LO[1][2],LO[1][3],HI[1][0],HI[1][1],HI[1][2],HI[1][3]},O,0,0,0); \
    O=__builtin_amdgcn_mfma_f32_32x32x16_bf16(pa2,(bf16x8){LO[2][0],LO[2][1],LO[2][2],LO[2][3],HI[2][0],HI[2][1],HI[2][2],HI[2][3]},O,0,0,0); \
    O=__builtin_amdgcn_mfma_f32_32x32x16_bf16(pa3,(bf16x8){LO[3][0],LO[3][1],LO[3][2],LO[3][3],HI[3][0],HI[3][1],HI[3][2],HI[3][3]},O,0,0,0); }while(0)
__device__ __forceinline__ void pv128(f32x16*o,lds_cptr vp,s16x4 (&loA)[4],s16x4 (&hiA)[4],bf16x8 pa0,bf16x8 pa1,bf16x8 pa2,bf16x8 pa3){
  s16x4 loB[4],hiB[4];
  PV128_RD(loB,hiB,vp,4096);      SBAR(); PV128_MM(o[0],loA,hiA); SBAR();
  PV128_RD(loA,hiA,vp,8192);      SBAR(); PV128_MM(o[1],loB,hiB); SBAR();
  PV128_RD(loB,hiB,vp,8192+4096); SBAR(); PV128_MM(o[2],loA,hiA); SBAR();
  PV128_MM(o[3],loB,hiB);
}
namespace dfa { constexpr int DK=0, DV=3*8192, DWS=DV+3*16384, DOST=0, BYTES=DWS+2048; }
template<int THR> __device__ __forceinline__ void diff_unit(int b,int qb,const bf16*Q,const bf16*__restrict__ K,const bf16*__restrict__ V,bf16*O,char*shm){
  int tid_=threadIdx.x; asm volatile("":"+v"(tid_)); const int tid=tid_,lane=tid&63,r32=lane&31,hi=lane>>5; const int wid=__builtin_amdgcn_readfirstlane(tid>>6);
  const long rowbase=(long)b*SEQ; const int q0=qb*QB;
  const bf16*Qw=Q+(rowbase+q0+wid*QBLK)*PQ;
  const bf16*Kh=K+rowbase*PQ,*Vh=V+rowbase*PQ;
  const unsigned lds0=(unsigned)(uintptr_t)shm;
  float*wsf=(float*)(shm+dfa::DWS)+wid*64;
  const bf16*ksrc=Kh+(long)lane*PQ+wid*8;
  const bf16*vsrc=Vh+(long)(16*(wid&3)+(lane>>2))*PQ+(wid>>2)*32+(lane&3)*8;
  const unsigned kdst=lds0+dfa::DK+wid*1024, vdst=lds0+dfa::DV+wid*1024;
  #define DFA_DMA(t,sK,sV) do{ glds16(ksrc+(long)(t)*KVBLK*PQ,(unsigned)__builtin_amdgcn_readfirstlane(kdst+(sK))); \
      glds16(vsrc+(long)(t)*KVBLK*PQ,(unsigned)__builtin_amdgcn_readfirstlane(vdst+(sV))); glds16(vsrc+(long)(t)*KVBLK*PQ+64,(unsigned)__builtin_amdgcn_readfirstlane(vdst+(sV)+8192)); }while(0)
  const lds_cptr vp0=(lds_cptr)shm+dfa::DV+((lane>>4)&1)*32+(lane&3)*8+(4*hi+((lane&15)>>2))*64;
  const int NT=(q0+QB)/KVBLK, tlast=NT-4+(wid>>1);
  DFA_DMA(0,0,0); DFA_DMA(1,8192,16384);
  bf16x8 qr[4];
  #pragma unroll
  for(int d0=0;d0<4;++d0)qr[d0]=*reinterpret_cast<const bf16x8*>(&Qw[(long)r32*PQ+d0*16+hi*8]);
  asm volatile("":"+v"(qr[0]),"+v"(qr[1]),"+v"(qr[2]),"+v"(qr[3]));
  float l_reg=0.f; f32x16 o[4]; o[0]=f32x16{}; o[1]=f32x16{}; o[2]=f32x16{}; o[3]=f32x16{}; f32x16 negm=f32x16{};
  int sK=0,sV=0,sK2=2*8192,sV2=2*16384;
  for(int t=0;t<NT;++t){
    if(t+1<NT){WAIT_BAR(3);}else{WAIT_BAR(0);}
    if(t+2<NT){DFA_DMA(t+2,sK2,sV2);}
    if(t<=tlast){
      f32x16 p0,p1; qkt(p0,p1,shm+dfa::DK+sK,qr,negm,r32,hi);
      const lds_cptr vpt=vp0+sV; s16x4 vlo0[4],vhi0[4]; PV128_RD(vlo0,vhi0,vpt,0); SBAR();
      float rm=p0[0];
      #pragma unroll
      for(int r=0;r<16;++r){rm=__builtin_fmaxf(rm,p0[r]);rm=__builtin_fmaxf(rm,p1[r]);}
      { auto rr=__builtin_amdgcn_permlane32_swap(__float_as_uint(rm),__float_as_uint(rm),false,false); rm=__builtin_fmaxf(__uint_as_float(rr[0]),__uint_as_float(rr[1])); }
      if(t==0||__any(rm>(float)THR)){
        const float dl=(t==0)?rm:__builtin_fmaxf(rm,0.f);
        #pragma unroll
        for(int r=0;r<16;++r){p0[r]-=dl;p1[r]-=dl;negm[r]-=dl;}
        if(t!=0){ const float f=__builtin_amdgcn_exp2f(-dl); l_reg*=f; if(hi==0)wsf[r32]=f; asm volatile("s_waitcnt lgkmcnt(0)":::"memory");
          #pragma unroll
          for(int r=0;r<16;++r){const float fr_=wsf[crow(r,hi)]; o[0][r]*=fr_; o[1][r]*=fr_; o[2][r]*=fr_; o[3][r]*=fr_;} }
      }
      float sacc=0.f;
      #pragma unroll
      for(int r=0;r<16;++r){p0[r]=__builtin_amdgcn_exp2f(p0[r]);p1[r]=__builtin_amdgcn_exp2f(p1[r]);sacc+=p0[r]+p1[r];}
      l_reg+=sacc;
      u32x4 pw0,pw1,pw2,pw3;
      pw0=(u32x4){cvtpk_s(p0[0],p0[1]),cvtpk_s(p0[2],p0[3]),cvtpk_s(p0[4],p0[5]),cvtpk_s(p0[6],p0[7])};
      pw1=(u32x4){cvtpk_s(p0[8],p0[9]),cvtpk_s(p0[10],p0[11]),cvtpk_s(p0[12],p0[13]),cvtpk_s(p0[14],p0[15])};
      pw2=(u32x4){cvtpk_s(p1[0],p1[1]),cvtpk_s(p1[2],p1[3]),cvtpk_s(p1[4],p1[5]),cvtpk_s(p1[6],p1[7])};
      pw3=(u32x4){cvtpk_s(p1[8],p1[9]),cvtpk_s(p1[10],p1[11]),cvtpk_s(p1[12],p1[13]),cvtpk_s(p1[14],p1[15])};
      SBAR(); pv128(o,vpt,vlo0,vhi0,__builtin_bit_cast(bf16x8,pw0),__builtin_bit_cast(bf16x8,pw1),__builtin_bit_cast(bf16x8,pw2),__builtin_bit_cast(bf16x8,pw3));
    }
    sK2=sK; sV2=sV; sK=(sK==2*8192)?0:sK+8192; sV=(sV==2*16384)?0:sV+16384;
  }
  asm volatile("s_waitcnt lgkmcnt(0)\n\ts_barrier":::"memory");
  {auto rr=__builtin_amdgcn_permlane32_swap(__float_as_uint(l_reg),__float_as_uint(l_reg),false,false);l_reg=__uint_as_float(rr[0])+__uint_as_float(rr[1]);}
  if(hi==0)wsf[32+r32]=l_reg;asm volatile("s_waitcnt lgkmcnt(0)":::"memory");
  float rli[16];
  #pragma unroll
  for(int r=0;r<16;++r)rli[r]=__builtin_amdgcn_rcpf(wsf[32+crow(r,hi)]);
  bf16*Ow=O+(rowbase+q0+wid*QBLK)*PO;
  { bf16*stg=(bf16*)(shm+dfa::DOST)+wid*4096;
    #pragma unroll
    for(int r=0;r<16;++r){const int orow=crow(r,hi);
      #pragma unroll
      for(int d0=0;d0<4;++d0)stg[orow*128+d0*32+r32]=__float2bfloat16(o[d0][r]*rli[r]);}
    asm volatile("s_waitcnt lgkmcnt(0)":::"memory");
    #pragma unroll
    for(int i=0;i<8;++i){const int idx=i*64+lane,row=idx>>4,ch=idx&15; const u32x4 v=*(const u32x4*)(stg+row*128+ch*8); ATTN_STORE16(Ow+(long)row*PO+ch*8,v);} }
  asm volatile("s_waitcnt lgkmcnt(0)\n\ts_barrier":::"memory");
  #undef DFA_DMA
}

namespace dfb { constexpr int NS=5, DK=0, DV=NS*8192, DWS=DV+NS*16384, DOST=0, BYTES=DWS+2048; }
template<int THR> __device__ __forceinline__ void diff_unit2(int b,int qb,const bf16*Q,const bf16*__restrict__ K,const bf16*__restrict__ V,bf16*O,char*shm){
  int tid_=threadIdx.x; asm volatile("":"+v"(tid_)); const int tid=tid_,lane=tid&63,r32=lane&31,hi=lane>>5; const int wid=__builtin_amdgcn_readfirstlane(tid>>6);
  const long rowbase=(long)b*SEQ; const int q0=qb*QB;
  const bf16*Qw=Q+(rowbase+q0+wid*QBLK)*PQ;
  const bf16*Kh=K+rowbase*PQ,*Vh=V+rowbase*PQ;
  const unsigned lds0=(unsigned)(uintptr_t)shm;
  float*wsf=(float*)(shm+dfb::DWS)+wid*64;
  const bf16*ksrc=Kh+(long)lane*PQ+wid*8;
  const bf16*vsrc=Vh+(long)(16*(wid&3)+(lane>>2))*PQ+(wid>>2)*32+(lane&3)*8;
  const unsigned kdst=lds0+dfb::DK+wid*1024, vdst=lds0+dfb::DV+wid*1024;
  #define DFB_DMA(t,s_) do{ glds16(ksrc+(long)(t)*KVBLK*PQ,(unsigned)__builtin_amdgcn_readfirstlane(kdst+s_*8192)); \
      glds16(vsrc+(long)(t)*KVBLK*PQ,(unsigned)__builtin_amdgcn_readfirstlane(vdst+s_*16384)); glds16(vsrc+(long)(t)*KVBLK*PQ+64,(unsigned)__builtin_amdgcn_readfirstlane(vdst+s_*16384+8192)); }while(0)
  const int vb0=(int)(lds0+dfb::DV)+((lane>>4)&1)*32+(lane&3)*8+(4*hi+((lane&15)>>2))*64;
  const int NT=(q0+QB)/KVBLK, tlast=NT-4+(wid>>1);
  const lds_cptr kp0=(lds_cptr)shm+dfb::DK+hi*1024+r32*16;
  DFB_DMA(0,0); DFB_DMA(1,1); DFB_DMA(2,2);
  bf16x8 qr[4];
  #pragma unroll
  for(int d0=0;d0<4;++d0)qr[d0]=*reinterpret_cast<const bf16x8*>(&Qw[(long)r32*PQ+d0*16+hi*8]);
  asm volatile("":"+v"(qr[0]),"+v"(qr[1]),"+v"(qr[2]),"+v"(qr[3]));
  float l_reg=0.f; f32x16 o[4]; o[0]=f32x16{}; o[1]=f32x16{}; o[2]=f32x16{}; o[3]=f32x16{}; f32x16 negm=f32x16{};
  f32x16 s0,s1;
  u32x4 pw0,pw1,pw2,pw3;
  #define DFB_SOFTMAX() do{ float sacc=0.f; _Pragma("unroll") for(int r=0;r<16;++r){s0[r]=__builtin_amdgcn_exp2f(s0[r]);s1[r]=__builtin_amdgcn_exp2f(s1[r]);sacc+=s0[r]+s1[r];} l_reg+=sacc; \
      pw0=(u32x4){cvtpk_s(s0[0],s0[1]),cvtpk_s(s0[2],s0[3]),cvtpk_s(s0[4],s0[5]),cvtpk_s(s0[6],s0[7])}; \
      pw1=(u32x4){cvtpk_s(s0[8],s0[9]),cvtpk_s(s0[10],s0[11]),cvtpk_s(s0[12],s0[13]),cvtpk_s(s0[14],s0[15])}; \
      pw2=(u32x4){cvtpk_s(s1[0],s1[1]),cvtpk_s(s1[2],s1[3]),cvtpk_s(s1[4],s1[5]),cvtpk_s(s1[6],s1[7])}; \
      pw3=(u32x4){cvtpk_s(s1[8],s1[9]),cvtpk_s(s1[10],s1[11]),cvtpk_s(s1[12],s1[13]),cvtpk_s(s1[14],s1[15])}; }while(0)
  #define DFB_PV(sv) do{ const int vbt=vb0+(sv)*16384; \
      pv(o,vbt,__builtin_bit_cast(bf16x8,pw0),__builtin_bit_cast(bf16x8,pw1),__builtin_bit_cast(bf16x8,pw2),__builtin_bit_cast(bf16x8,pw3)); \
      pv(o+2,vbt+8192,__builtin_bit_cast(bf16x8,pw0),__builtin_bit_cast(bf16x8,pw1),__builtin_bit_cast(bf16x8,pw2),__builtin_bit_cast(bf16x8,pw3)); }while(0)
  #define DFB_REF(FIRST) do{ float rm=s0[0]; _Pragma("unroll") for(int r=0;r<16;++r){rm=__builtin_fmaxf(rm,s0[r]);rm=__builtin_fmaxf(rm,s1[r]);} \
      { auto rr=__builtin_amdgcn_permlane32_swap(__float_as_uint(rm),__float_as_uint(rm),false,false); rm=__builtin_fmaxf(__uint_as_float(rr[0]),__uint_as_float(rr[1])); } \
      if((FIRST)||__any(rm>(float)THR)){ const float dl=(FIRST)?rm:__builtin_fmaxf(rm,0.f); \
        _Pragma("unroll") for(int r=0;r<16;++r){s0[r]-=dl;s1[r]-=dl;negm[r]-=dl;} \
        if(!(FIRST)){ const float f=__builtin_amdgcn_exp2f(-dl); l_reg*=f; if(hi==0)wsf[r32]=f; asm volatile("s_waitcnt lgkmcnt(0)":::"memory"); \
          _Pragma("unroll") for(int r=0;r<16;++r){const float fr_=wsf[crow(r,hi)]; o[0][r]*=fr_; o[1][r]*=fr_; o[2][r]*=fr_; o[3][r]*=fr_;} } } }while(0)
  WAIT_BAR(6); DFB_DMA(3,3);
  qkt(s0,s1,shm+dfb::DK,qr,negm,r32,hi);
  DFB_REF(true);
  int sc=1,sp=0,sn=4;
  for(int t=1;t<NT;++t){
    if(t+2<NT){WAIT_BAR(6);}else if(t+1<NT){WAIT_BAR(3);}else{WAIT_BAR(0);}
    if(t+3<NT){DFB_DMA(t+3,sn);}
    if(t<=tlast+1){
      DFB_SOFTMAX(); SBAR();
      if(t<=tlast){ qkt(s0,s1,shm+dfb::DK+sc*8192,qr,negm,r32,hi); SBAR(); }
      DFB_PV(sp); SBAR();
      if(t<=tlast){ DFB_REF(false); }
    }
    sp=sc; sc=(sc==4)?0:sc+1; sn=(sn==4)?0:sn+1;
  }
  if(tlast==NT-1){ DFB_SOFTMAX(); SBAR(); DFB_PV(sp); }
  asm volatile("s_waitcnt lgkmcnt(0)\n\ts_barrier":::"memory");
  {auto rr=__builtin_amdgcn_permlane32_swap(__float_as_uint(l_reg),__float_as_uint(l_reg),false,false);l_reg=__uint_as_float(rr[0])+__uint_as_float(rr[1]);}
  if(hi==0)wsf[32+r32]=l_reg;asm volatile("s_waitcnt lgkmcnt(0)":::"memory");
  float rli[16];
  #pragma unroll
  for(int r=0;r<16;++r)rli[r]=__builtin_amdgcn_rcpf(wsf[32+crow(r,hi)]);
  bf16*Ow=O+(rowbase+q0+wid*QBLK)*PO;
  { bf16*stg=(bf16*)(shm+dfb::DOST)+wid*4096;
    #pragma unroll
    for(int r=0;r<16;++r){const int orow=crow(r,hi);
      #pragma unroll
      for(int d0=0;d0<4;++d0)stg[orow*128+d0*32+r32]=__float2bfloat16(o[d0][r]*rli[r]);}
    asm volatile("s_waitcnt lgkmcnt(0)":::"memory");
    #pragma unroll
    for(int i=0;i<8;++i){const int idx=i*64+lane,row=idx>>4,ch=idx&15; const u32x4 v=*(const u32x4*)(stg+row*128+ch*8); ATTN_STORE16(Ow+(long)row*PO+ch*8,v);} }
  asm volatile("s_waitcnt lgkmcnt(0)\n\ts_barrier":::"memory");
  #undef DFB_DMA
  #undef DFB_SOFTMAX
  #undef DFB_PV
  #undef DFB_REF
}
constexpr int LDS_BIAS=LDS_BYTES;
__device__ __forceinline__ void band_unit(int b,int h,int qb,const bf16*Q,const bf16*__restrict__ K,const bf16*__restrict__ V,bf16*O,const float*__restrict__ relb,char*shm){
  int tid_=threadIdx.x; asm volatile("":"+v"(tid_)); const int tid=tid_,lane=tid&63,r32=lane&31,hi=lane>>5; const int wid=__builtin_amdgcn_readfirstlane(tid>>6);
  const long rowbase=(long)b*SEQ; const int q0=qb*QB;
  const bf16*Qw=Q+(rowbase+q0+wid*QBLK)*PQ;
  const bf16*Kh=K+rowbase*PQ,*Vh=V+rowbase*PQ;
  const unsigned lds0=(unsigned)(uintptr_t)shm;
  float*wsf=(float*)(shm+LDS_WS)+wid*64;
  float*biasL=(float*)(shm+LDS_BIAS);
  for(int i=tid;i<640;i+=512)biasL[i]=relb[h*513+(i<512?i:512)]*1.4426950408889634f;
  const bf16*ksrc=Kh+(long)lane*PQ+wid*8;
  const bf16*vsrc=Vh+(long)(16*(wid&3)+(lane>>2))*PQ+(wid>>2)*32+(lane&3)*8;
  const unsigned kdst=lds0+LDS_K+wid*1024, vdst=lds0+LDS_V+wid*1024;
  #define DMA_K(t,slot) glds16(ksrc+(long)(t)*KVBLK*PQ,(unsigned)__builtin_amdgcn_readfirstlane(kdst+(slot)))
  #define DMA_V(t,slot) glds16(vsrc+(long)(t)*KVBLK*PQ,(unsigned)__builtin_amdgcn_readfirstlane(vdst+(slot)))
  const int vb0=(int)(lds0+LDS_V)+((lane>>4)&1)*32+(lane&3)*8+(4*hi+((lane&15)>>2))*64;
  const char*Kbase=shm+LDS_K;
  const int c0=q0/KVBLK, cw=c0+(wid>>1);
  const int tlo=(c0<8)?0:c0-8, thi=c0+3;
  bf16x8 qr[4];
  #pragma unroll
  for(int d0=0;d0<4;++d0)qr[d0]=*reinterpret_cast<const bf16x8*>(&Qw[(long)r32*PQ+d0*16+hi*8]);
  asm volatile("":"+v"(qr[0]),"+v"(qr[1]),"+v"(qr[2]),"+v"(qr[3]));
  float m_run=-INFINITY,l_reg=0.f; f32x16 o[2]; o[0]=f32x16{}; o[1]=f32x16{}; const f32x16 zero=f32x16{};
  const int qabs=q0+wid*QBLK+r32;
  DMA_K(tlo,0);DMA_V(tlo,0);
  int sl=0;
  for(int t=tlo;t<=thi;++t){
    if(t<thi){DMA_K(t+1,sl^SLOTB);DMA_V(t+1,sl^SLOTB);WAIT_BAR(2);}else{WAIT_BAR(0);}
    if(t>=cw-8&&t<=cw){
      f32x16 p0,p1; qkt(p0,p1,Kbase+sl,qr,zero,r32,hi);
      if(cw-t>=5){ const float bc=biasL[512];
        #pragma unroll
        for(int r=0;r<16;++r){p0[r]+=bc;p1[r]+=bc;} }
      else{ const float*bp=biasL+(qabs-(t*KVBLK+4*hi)+256);
        #pragma unroll
        for(int r=0;r<16;++r){ p0[r]+=bp[-((r&3)+8*(r>>2))]; p1[r]+=bp[-((r&3)+8*(r>>2))-32]; } }
      float rm=p0[0];
      #pragma unroll
      for(int r=0;r<16;++r){rm=__builtin_fmaxf(rm,p0[r]);rm=__builtin_fmaxf(rm,p1[r]);}
      { auto rr=__builtin_amdgcn_permlane32_swap(__float_as_uint(rm),__float_as_uint(rm),false,false); rm=__builtin_fmaxf(__uint_as_float(rr[0]),__uint_as_float(rr[1])); }
      const float mn=__builtin_fmaxf(m_run,rm); const float f=__builtin_amdgcn_exp2f(m_run-mn); m_run=mn;
      float sacc=0.f;
      #pragma unroll
      for(int r=0;r<16;++r){p0[r]=__builtin_amdgcn_exp2f(p0[r]-mn);p1[r]=__builtin_amdgcn_exp2f(p1[r]-mn);sacc+=p0[r]+p1[r];}
      l_reg=l_reg*f+sacc;
      if(__any(f!=1.0f)){
      if(hi==0)wsf[r32]=f;
      asm volatile("s_waitcnt lgkmcnt(0)":::"memory");
      #pragma unroll
      for(int r=0;r<16;++r){const float fr_=wsf[crow(r,hi)]; o[0][r]*=fr_; o[1][r]*=fr_;} }
      u32x4 pw0,pw1,pw2,pw3;
      pw0=(u32x4){cvtpk_s(p0[0],p0[1]),cvtpk_s(p0[2],p0[3]),cvtpk_s(p0[4],p0[5]),cvtpk_s(p0[6],p0[7])};
      pw1=(u32x4){cvtpk_s(p0[8],p0[9]),cvtpk_s(p0[10],p0[11]),cvtpk_s(p0[12],p0[13]),cvtpk_s(p0[14],p0[15])};
      pw2=(u32x4){cvtpk_s(p1[0],p1[1]),cvtpk_s(p1[2],p1[3]),cvtpk_s(p1[4],p1[5]),cvtpk_s(p1[6],p1[7])};
      pw3=(u32x4){cvtpk_s(p1[8],p1[9]),cvtpk_s(p1[10],p1[11]),cvtpk_s(p1[12],p1[13]),cvtpk_s(p1[14],p1[15])};
      SBAR(); pv(o,vb0+sl,__builtin_bit_cast(bf16x8,pw0),__builtin_bit_cast(bf16x8,pw1),__builtin_bit_cast(bf16x8,pw2),__builtin_bit_cast(bf16x8,pw3));
    }
    asm volatile("s_waitcnt lgkmcnt(0)\n\ts_barrier":::"memory");
    sl^=SLOTB;
  }
  {auto rr=__builtin_amdgcn_permlane32_swap(__float_as_uint(l_reg),__float_as_uint(l_reg),false,false);l_reg=__uint_as_float(rr[0])+__uint_as_float(rr[1]);}
  if(hi==0)wsf[32+r32]=l_reg;asm volatile("s_waitcnt lgkmcnt(0)":::"memory");
  float rli[16];
  #pragma unroll
  for(int r=0;r<16;++r)rli[r]=__builtin_amdgcn_rcpf(wsf[32+crow(r,hi)]);
  bf16*Ow=O+(rowbase+q0+wid*QBLK)*PO;
  { bf16*stg=(bf16*)(shm+LDS_OST)+wid*2048;
    #pragma unroll
    for(int r=0;r<16;++r){const int orow=crow(r,hi);
      #pragma unroll
      for(int d0=0;d0<2;++d0)stg[orow*64+d0*32+r32]=__float2bfloat16(o[d0][r]*rli[r]);}
    asm volatile("s_waitcnt lgkmcnt(0)":::"memory");
    #pragma unroll
    for(int i=0;i<4;++i){const int row=i*8+(lane>>3),ch=lane&7; const u32x4 v=*(const u32x4*)(stg+row*64+ch*8); ATTN_STORE16(Ow+(long)row*PO+ch*8,v);} }
  asm volatile("s_waitcnt lgkmcnt(0)\n\ts_barrier":::"memory");
  #undef DMA_K
  #undef DMA_V
}
constexpr int ATTN_LDS_BYTES=LDS_BYTES+2560;
#undef SBAR
#undef WAIT_BAR
}


#define CFG_ONE_LAUNCH 1
#define CFG_ATTN 2
#define CFG_BAND 1
#define PROBE_REP_MASK 0x0

#define LAS __attribute__((address_space(3)))
__device__ __forceinline__ void p0_transpose_item(const float* W, int K, int N, bf16_t* WT, LAS float* scr, int item, int lane, bool up_il, const float* gain) {
    const int nblk = N / 32, kb = item / nblk, nb = item % nblk, k0 = 64 * kb, n0 = 32 * nb;
    const int rb = !up_il ? n0 : (n0 < DFF ? (n0 >> 7) * 256 + (n0 & 127) : ((n0 - DFF) >> 7) * 256 + 128 + ((n0 - DFF) & 127));
#pragma unroll 8
    for (int i = 0; i < 32; ++i) { const int kk = 2 * i + (lane >> 5); const float gk = gain ? gain[k0 + kk] : 1.0f; scr[kk * 33 + (lane & 31)] = W[(size_t)(k0 + kk) * N + n0 + (lane & 31)] * gk; }
    asm volatile("s_waitcnt lgkmcnt(0)" ::: "memory");
    const int c = lane & 7;
#pragma unroll
    for (int j = 0; j < 4; ++j) { const int n = (lane >> 3) + 8 * j; const LAS float* s = scr + (8 * c) * 33 + n;
        u32x4 o; o.x = cvtpk(s[0 * 33], s[1 * 33]); o.y = cvtpk(s[2 * 33], s[3 * 33]); o.z = cvtpk(s[4 * 33], s[5 * 33]); o.w = cvtpk(s[6 * 33], s[7 * 33]);
        *(u32x4*)(WT + (size_t)(rb + n) * K + k0 + 8 * c) = o; }
    asm volatile("s_waitcnt lgkmcnt(0)" ::: "memory");
}
__device__ __forceinline__ void transpose_phase(const Args& a, unsigned char* ws, LAS unsigned char* lds, int gw, int NGW, int wave, int lane) {
    LAS float* scr = (LAS float*)(lds + wave * 16384);
    constexpr int I_IN = (DM / 64) * (INW / 32), I_OUT = (DM / 64) * (DM / 32), I_UP = (DM / 64) * (UPW / 32), I_DN = (DFF / 64) * (DM / 32), I_L = I_IN + I_OUT + I_UP + I_DN;
    for (int it = gw; it < DEPTH * I_L; it += NGW) {
        const int l = it / I_L; int r = it % I_L; unsigned char* wl = ws + WS_W + (size_t)l * W_LAYER;
        if (r < I_IN) { p0_transpose_item(a.in[2] + (size_t)l * DM * INW, DM, INW, (bf16_t*)(wl + W_IN), scr, r, lane, false, a.in[1] + (size_t)l * DM); continue; } r -= I_IN;
        if (r < I_OUT) { p0_transpose_item(a.in[11] + (size_t)l * DM * DM, DM, DM, (bf16_t*)(wl + W_OUT), scr, r, lane, false, nullptr); continue; } r -= I_OUT;
        if (r < I_UP) { p0_transpose_item(a.in[13] + (size_t)l * DM * UPW, DM, UPW, (bf16_t*)(wl + W_UP), scr, r, lane, true, a.in[12] + (size_t)l * DM); continue; } r -= I_UP;
        p0_transpose_item(a.in[16] + (size_t)l * DFF * DM, DFF, DM, (bf16_t*)(wl + W_DOWN), scr, r, lane, false, nullptr);
    }
}

__device__ __forceinline__ void n_diff_item(const bf16_t* PROJ, bf16_t* AO, int chunk, int vh, int lane) {
    const int h = vh >> 2, m = (vh >> 1) & 1, e = vh & 1;
    const int t = chunk * 64 + lane, b = t / SEQ, kbeg = b * SEQ, kend = (chunk + 1) * 64;
    float q[64], o[64];
    { const u32x4* qp = (const u32x4*)(PROJ + (size_t)t * INW + h * 128 + m * 64);
#pragma unroll
      for (int i = 0; i < 8; ++i) { const u32x4 w = qp[i];
#pragma unroll
          for (int c = 0; c < 4; ++c) { q[i * 8 + 2 * c] = bflo(w[c]); q[i * 8 + 2 * c + 1] = bfhi(w[c]); } } }
#pragma unroll
    for (int d = 0; d < 64; ++d) o[d] = 0.f;
    float mx = -INFINITY, lsum = 0.f;
    for (int k = kbeg; k < kend; ++k) {
        const u32x4* kp = (const u32x4*)(PROJ + (size_t)k * INW + COL_KA + h * 128 + m * 64);
        const u32x4* vp = (const u32x4*)(PROJ + (size_t)k * INW + COL_VA + h * 128 + e * 64);
        float s = 0.f;
#pragma unroll
        for (int i = 0; i < 8; ++i) { const u32x4 w = kp[i];
#pragma unroll
            for (int c = 0; c < 4; ++c) { s += q[i * 8 + 2 * c] * bflo(w[c]); s += q[i * 8 + 2 * c + 1] * bfhi(w[c]); } }
        const float mn = fmaxf(mx, s), f = exp2f(mx - mn), p = exp2f(s - mn);
        lsum = lsum * f + p; mx = mn;
#pragma unroll
        for (int i = 0; i < 8; ++i) { const u32x4 w = vp[i];
#pragma unroll
            for (int c = 0; c < 4; ++c) { o[i * 8 + 2 * c] = o[i * 8 + 2 * c] * f + p * bflo(w[c]); o[i * 8 + 2 * c + 1] = o[i * 8 + 2 * c + 1] * f + p * bfhi(w[c]); } }
    }
    const float inv = 1.0f / lsum;
    u32x4* op = (u32x4*)(AO + (size_t)t * 1024 + vh * 64);
#pragma unroll
    for (int i = 0; i < 8; ++i) { u32x4 w;
#pragma unroll
        for (int c = 0; c < 4; ++c) w[c] = cvtpk(o[i * 8 + 2 * c] * inv, o[i * 8 + 2 * c + 1] * inv);
        op[i] = w; }
}
__device__ __forceinline__ void n_band_item(const bf16_t* PROJ, const float* relb, bf16_t* MIX, int chunk, int h, int lane) {
    const int t = chunk * 64 + lane, b = t / SEQ, cin = chunk % (SEQ / 64);
    const float* rb = relb + h * 513;
    float q[64], o[64];
    { const u32x4* qp = (const u32x4*)(PROJ + (size_t)t * INW + COL_QC + h * 64);
#pragma unroll
      for (int i = 0; i < 8; ++i) { const u32x4 w = qp[i];
#pragma unroll
          for (int c = 0; c < 4; ++c) { q[i * 8 + 2 * c] = bflo(w[c]); q[i * 8 + 2 * c + 1] = bfhi(w[c]); } } }
#pragma unroll
    for (int d = 0; d < 64; ++d) o[d] = 0.f;
    float mx = -INFINITY, lsum = 0.f;
    for (int j = 0; j < 9; ++j) {
        const int kc = cin - 8 + j; if (kc < 0) continue;
        for (int kk = 0; kk < 64; ++kk) {
            const int k = b * SEQ + kc * 64 + kk;
            int rel = t - k; rel = rel < -256 ? -256 : (rel > 256 ? 256 : rel);
            const u32x4* kp = (const u32x4*)(PROJ + (size_t)k * INW + COL_KC + h * 64);
            const u32x4* vp = (const u32x4*)(PROJ + (size_t)k * INW + COL_VC + h * 64);
            float s = rb[rel + 256] * LOG2E;
#pragma unroll
            for (int i = 0; i < 8; ++i) { const u32x4 w = kp[i];
#pragma unroll
                for (int c = 0; c < 4; ++c) { s += q[i * 8 + 2 * c] * bflo(w[c]); s += q[i * 8 + 2 * c + 1] * bfhi(w[c]); } }
            const float mn = fmaxf(mx, s), f = exp2f(mx - mn), p = exp2f(s - mn);
            lsum = lsum * f + p; mx = mn;
#pragma unroll
            for (int i = 0; i < 8; ++i) { const u32x4 w = vp[i];
#pragma unroll
                for (int c = 0; c < 4; ++c) { o[i * 8 + 2 * c] = o[i * 8 + 2 * c] * f + p * bflo(w[c]); o[i * 8 + 2 * c + 1] = o[i * 8 + 2 * c + 1] * f + p * bfhi(w[c]); } }
        }
    }
    const float inv = 1.0f / lsum;
    u32x4* op = (u32x4*)(MIX + (size_t)t * 1024 + 768 + h * 64);
#pragma unroll
    for (int i = 0; i < 8; ++i) { u32x4 w;
#pragma unroll
        for (int c = 0; c < 4; ++c) w[c] = cvtpk(o[i * 8 + 2 * c] * inv, o[i * 8 + 2 * c + 1] * inv);
        op[i] = w; }
}


__device__ __forceinline__ void convfix_rows(const Args& a, int l, unsigned char* ws, int pm, int tid) {
    const float* cw = a.in[14] + (size_t)l * 3 * DFF; const float* cb = a.in[15] + (size_t)l * DFF;
    const float* HA = (const float*)(ws + WS_HEADA); const float* HG = (const float*)(ws + WS_HEADG); const float* HL = (const float*)(ws + WS_HALO); bf16_t* ACT = (bf16_t*)(ws + WS_ACT);
    for (int i = tid; i < 4 * DFF; i += 512) { const int b4 = i / DFF, c = i % DFF, blk = pm * 4 + b4;
        const float a0 = HA[((size_t)blk * 2) * DFF + c], a1 = HA[((size_t)blk * 2 + 1) * DFF + c], g0 = HG[((size_t)blk * 2) * DFF + c], g1 = HG[((size_t)blk * 2 + 1) * DFF + c];
        float h0 = 0.f, h1 = 0.f; if ((blk % (SEQ / 64)) != 0) { h0 = HL[((size_t)(blk - 1) * 2) * DFF + c]; h1 = HL[((size_t)(blk - 1) * 2 + 1) * DFF + c]; }
        const float w0 = cw[c], w1 = cw[DFF + c], w2 = cw[2 * DFF + c], bb = cb[c];
        const float x0 = bb + w0 * h0 + w1 * h1 + w2 * a0, x1 = bb + w0 * h1 + w1 * a0 + w2 * a1;
        const float y0 = x0 * __builtin_amdgcn_rcpf(1.0f + __expf(-x0)) * g0, y1 = x1 * __builtin_amdgcn_rcpf(1.0f + __expf(-x1)) * g1;
        ACT[(size_t)(blk * 64) * DFF + c] = (bf16_t)(cvtpk(y0, 0.f) & 0xffffu); ACT[(size_t)(blk * 64 + 1) * DFF + c] = (bf16_t)(cvtpk(y1, 0.f) & 0xffffu); }
}
#define XB_TMO      128
#define XB_XCNT(j)  (256  + 64 * (j))
#define XB_XSUB(j)  (1280 + 64 * (j))
#define XB_XGEN(j)  (2304 + 64 * (j))
#define XB_TOP      3328
#define XB_TOPGEN   3392
#define XCD_BAR_WORDS 3456
#define XB_SPIN_CAP (1u << 18)

__device__ __forceinline__ unsigned xb_ld(unsigned* p)              { return __hip_atomic_load(p, __ATOMIC_RELAXED, __HIP_MEMORY_SCOPE_AGENT); }
__device__ __forceinline__ unsigned xb_add(unsigned* p, unsigned v) { return __hip_atomic_fetch_add(p, v, __ATOMIC_RELAXED, __HIP_MEMORY_SCOPE_AGENT); }
__device__ __forceinline__ unsigned xb_xcc_id() { return (unsigned)__builtin_amdgcn_s_getreg((3 << 11) | 20) & 0xFu; }
#define XB_SPIN(cond, bar) do { unsigned _sp = 0; while (cond) { \
    if ((++_sp & 255u) == 0u) { if (xb_ld(&(bar)[XB_TMO])) break; if (_sp > XB_SPIN_CAP) { atomicAdd(&(bar)[XB_TMO], 1u); break; } } } } while (0)

struct XcdBarrier {
    unsigned* bar; unsigned x;
    volatile LAS unsigned* st;
};

__device__ __forceinline__ XcdBarrier xcd_barrier_post(unsigned* bar, volatile LAS unsigned* st) {
    XcdBarrier b; b.bar = bar; b.x = xb_xcc_id(); b.st = st;
    if (threadIdx.x == 0) (void)xb_add(&bar[XB_XCNT(b.x)], 1u);
    return b;
}
__device__ __forceinline__ void xcd_barrier_complete(unsigned* bar, unsigned x, unsigned& nloc, unsigned& nx) {
    const unsigned G = gridDim.x * gridDim.y * gridDim.z;
    unsigned sum, cnt, mine, sp = 0u;
    for (;;) {
        sum = 0u; cnt = 0u; mine = 0u;
#pragma unroll
        for (unsigned j = 0; j < 16; ++j) { const unsigned c = xb_ld(&bar[XB_XCNT(j)]); sum += c; cnt += (c > 0u) ? 1u : 0u; mine = (j == x) ? c : mine; }
        if (sum == G) break;
        __builtin_amdgcn_s_sleep(1);
        if ((++sp & 255u) == 0u) { if (xb_ld(&bar[XB_TMO])) break; if (sp > XB_SPIN_CAP) { atomicAdd(&bar[XB_TMO], 1u); break; } }
    }
    nloc = mine > 0u ? mine : 1u; nx = cnt > 0u ? cnt : 1u;
}

__device__ __forceinline__ void xcd_barrier(const XcdBarrier& b) {
    asm volatile("s_waitcnt vmcnt(0)" ::: "memory");
    __syncthreads();
    if (threadIdx.x == 0) {
        unsigned* bar = b.bar;
        __builtin_amdgcn_s_waitcnt(0);
        unsigned nloc = b.st[0], nx = b.st[1];
        if (nloc == 0u) { xcd_barrier_complete(bar, b.x, nloc, nx); b.st[0] = nloc; b.st[1] = nx; }
        const unsigned old = xb_add(&bar[XB_XSUB(b.x)], 1u);
        const unsigned gen = old / nloc;
        if (old + 1u == (gen + 1u) * nloc) {
            __builtin_amdgcn_fence(__ATOMIC_RELEASE, "agent");
            asm volatile("s_waitcnt vmcnt(0)" ::: "memory");
            const unsigned og = xb_add(&bar[XB_TOP], 1u);
            const unsigned tg = og / nx;
            if (og + 1u == (tg + 1u) * nx) xb_add(&bar[XB_TOPGEN], 1u);
            else XB_SPIN(xb_ld(&bar[XB_TOPGEN]) == tg, bar);
            __builtin_amdgcn_fence(__ATOMIC_ACQUIRE, "agent");
            xb_add(&bar[XB_XGEN(b.x)], 1u);
            asm volatile("s_waitcnt vmcnt(0)" ::: "memory");
        } else {
            XB_SPIN(xb_ld(&bar[XB_XGEN(b.x)]) == gen, bar);
            __builtin_amdgcn_fence(__ATOMIC_ACQUIRE, "agent");
            asm volatile("s_waitcnt vmcnt(0)" ::: "memory");
        }
    }
    __syncthreads();
}

constexpr int LDS_BYTES = 147456;
__device__ __forceinline__ bool phase_exists(int p) { if (p == 0 || p == PH_FINAL) return true; const int s = (p - 1) % 10; return s != 9 && s != 7; }
__device__ __forceinline__ bool sync_after(int p) { if (p == 0) return true; const int s = (p - 1) % 10; return !(s == 1 || s == 2); }
__global__ void __launch_bounds__(512, 2) mega(Args a) {
    extern __shared__ __attribute__((aligned(16))) unsigned char lds[];
    cg::grid_group grid = cg::this_grid();
    const int G = gridDim.x, blk = blockIdx.x;
    const int vcu = (G % 8 == 0) ? (blk % 8) * (G / 8) + blk / 8 : blk;
    const int NGW = G * 8, NT = G * 512;
    unsigned char* ws = a.ws;
    float* rowss = (float*)(ws + WS_ROWSS);
    bf16_t* XG = (bf16_t*)(ws + WS_XG); bf16_t* PROJ = (bf16_t*)(ws + WS_PROJ); bf16_t* AO = (bf16_t*)(ws + WS_AO); bf16_t* MIX = (bf16_t*)(ws + WS_MIX);
    LAS unsigned char* lds3 = (LAS unsigned char*)lds;
    volatile LAS unsigned* bst = (volatile LAS unsigned*)(lds3 + 131072 + 64);
    if (threadIdx.x < 2) bst[threadIdx.x] = 0u;
    unsigned* barw = (unsigned*)ws;
    if (a.ph_hi - a.ph_lo > 1 && blk == 0) for (int i = threadIdx.x; i < XCD_BAR_WORDS; i += 512) __hip_atomic_store(barw + i, 0u, __ATOMIC_RELAXED, __HIP_MEMORY_SCOPE_AGENT);
    __syncthreads();
    XcdBarrier bar; bar.bar = barw; bar.x = 0; bar.st = bst; bool posted = false;
    for (int p = a.ph_lo; p < a.ph_hi; ++p) {
        if (!phase_exists(p)) continue;
        const int nrep = (p != 0 && p != PH_FINAL && ((PROBE_REP_MASK >> ((p - 1) % 10)) & 1)) ? 2 : ((p == 0 && (PROBE_REP_MASK & 0x400)) ? 2 : 1);
        for (int rep = 0; rep < nrep; ++rep) {
        if (rep) __syncthreads();
        int tid = threadIdx.x; asm volatile("" : "+v"(tid));
        const int lane = tid & 63, wave = __builtin_amdgcn_readfirstlane(tid >> 6), gw = blk * 8 + wave, gtid = blk * 512 + tid;
        if (p == 0) { transpose_phase(a, ws, lds3, gw, NGW, wave, lane); norm0_phase(a.in[0], XG, rowss, gw, NGW, lane); }
        else if (p == PH_FINAL) { final_phase(a.out, XG, rowss + (size_t)8 * RSS, a.in[17], gw, NGW, lane); }
        else {
            const int l = (p - 1) / 10, s = (p - 1) % 10;
            unsigned char* wl = ws + WS_W + (size_t)l * W_LAYER;
            if (s == 0) {
                pg8::Gemm g{XG, (const bf16_t*)(wl + W_IN), M, INW, DM, DM}; pg8::StaticOrder S; S.init(M, INW, G, blk);
                pg8::EpiScale E{PROJ, INW, rowss + (size_t)(2 * l) * RSS, 1};
                pg8::gemm_phase<pg8::EpiScale, pg8::StaticOrder, true, true>(lds3, g, S, E);
            } else if (s == 1) {
#if CFG_ATTN == 2
                for (int i = vcu; i < 512; i += G) { const int r = i >> 8, v = i & 255, combo = v >> 4, sI = v & 15;
                    const int qb = (r == 0) ? sI : 31 - sI, b = combo >> 3, hm = combo & 7, h = hm >> 1, m = hm & 1;
                    attn_body::diff_unit2<8>(b, qb, (const attn_body::bf16*)(PROJ + h * 128 + m * 64), (const attn_body::bf16*)(PROJ + COL_KA + h * 128 + m * 64),
                                            (const attn_body::bf16*)(PROJ + COL_VA + h * 128), (attn_body::bf16*)(AO + h * 256 + m * 128), (char*)lds); }
#elif CFG_ATTN
                for (int i = vcu; i < 1024; i += G) { const int r = i >> 8, v = i & 255, bh = v >> 3, sI = v & 7;
                    const int qb = (r == 0) ? sI : (r == 1) ? 15 - sI : (r == 2) ? 16 + sI : 31 - sI;
                    const int b = bh >> 4, vh = bh & 15, h = vh >> 2, m = (vh >> 1) & 1, e = vh & 1;
                    attn_body::attn_unit<8>(b, qb, (const attn_body::bf16*)(PROJ + h * 128 + m * 64), (const attn_body::bf16*)(PROJ + COL_KA + h * 128 + m * 64),
                                            (const attn_body::bf16*)(PROJ + COL_VA + h * 128 + e * 64), (attn_body::bf16*)(AO + vh * 64), (char*)lds); }
#else
                for (int it = gw; it < 4096; it += NGW) n_diff_item(PROJ, AO, 255 - (it >> 4), it & 15, lane);
#endif
                __syncthreads();
            } else if (s == 2) {
#if CFG_BAND
                for (int i = vcu; i < 256; i += G) { const int b = i >> 7, h = (i >> 5) & 3, qb = i & 31;
                    attn_body::band_unit(b, h, qb, (const attn_body::bf16*)(PROJ + COL_QC + h * 64), (const attn_body::bf16*)(PROJ + COL_KC + h * 64),
                                         (const attn_body::bf16*)(PROJ + COL_VC + h * 64), (attn_body::bf16*)(MIX + 768 + h * 64), a.in[10] + (size_t)l * 4 * 513, (char*)lds); }
#else
                for (int it = gw; it < 1024; it += NGW) n_band_item(PROJ, a.in[10] + (size_t)l * 4 * 513, MIX, it >> 2, it & 3, lane);
#endif
                __syncthreads();
            } else if (s == 3) pool_phase(a, l, PROJ, MIX, (float*)lds, blk, G, tid);
            else if (s == 4) combine_phase(a, l, AO, MIX, gw, NGW, lane);
            else if (s == 5) {
                pg8::Gemm g{MIX, (const bf16_t*)(wl + W_OUT), M, DM, DM, DM}; pg8::StaticOrder S; S.init(M, DM, G, blk);
                pg8::EpiResid E{XG, rowss + (size_t)(2 * l + 1) * RSS};
                pg8::gemm_phase<pg8::EpiResid, pg8::StaticOrder, true, true>(lds3, g, S, E);
            } else if (s == 6) {
                pg8::Gemm g{XG, (const bf16_t*)(wl + W_UP), M, UPW, DM, DM}; pg8::StaticOrder S; S.init(M, UPW, G, blk);
                pg8::EpiConvAct E{(bf16_t*)(ws + WS_ACT), rowss + (size_t)(2 * l + 1) * RSS, a.in[14] + (size_t)l * 3 * DFF, a.in[15] + (size_t)l * DFF, (float*)(ws + WS_HEADA), (float*)(ws + WS_HEADG), (float*)(ws + WS_HALO)};
                pg8::gemm_phase<pg8::EpiConvAct, pg8::StaticOrder, true, true>(lds3, g, S, E);
            }
            else if (s == 8) {
                pg8::Gemm g{(const bf16_t*)(ws + WS_ACT), (const bf16_t*)(wl + W_DOWN), M, DM, DFF, DFF}; pg8::StaticOrder S; S.init(M, DM, G, blk);
                { pg8::Unit u; for (int i = 0; S.next(i, u); ++i) convfix_rows(a, l, ws, u.pm, tid); }
                asm volatile("s_waitcnt vmcnt(0)" ::: "memory"); __syncthreads();
                pg8::EpiResid E{XG, rowss + (size_t)(2 * l + 2) * RSS};
                pg8::gemm_phase<pg8::EpiResid, pg8::StaticOrder, true, true>(lds3, g, S, E);
            }
        }
        }
        if (p + 1 < a.ph_hi) { if (sync_after(p)) { if (!posted) { grid.sync(); bar = xcd_barrier_post(barw, bst); posted = true; } else xcd_barrier(bar); } else __syncthreads(); }
    }
}

extern "C" void kernel_launch(void* const* d_in, const int* in_sizes, int n_in, void* d_out, int out_size, void* d_ws, size_t ws_size, hipStream_t stream) {
    static int grid = 0;
    if (grid == 0) {
        if (n_in != 18 || out_size != M * DM || ws_size < WS_END) { fprintf(stderr, "kernel_launch: unexpected shapes / workspace (n_in %d out %d ws %zu)\n", n_in, out_size, ws_size); grid = -1; return; }
        int dev = 0, cus = 0, per_cu = 0;
        (void)hipGetDevice(&dev); (void)hipDeviceGetAttribute(&cus, hipDeviceAttributeMultiprocessorCount, dev);
        if (hipFuncSetAttribute((const void*)mega, hipFuncAttributeMaxDynamicSharedMemorySize, LDS_BYTES) != hipSuccess) { fprintf(stderr, "hipFuncSetAttribute failed\n"); grid = -1; return; }
        if (hipOccupancyMaxActiveBlocksPerMultiprocessor(&per_cu, (const void*)mega, 512, LDS_BYTES) != hipSuccess || per_cu < 1) { fprintf(stderr, "occupancy query: %d\n", per_cu); per_cu = 1; }
        (void)hipGetLastError();
        grid = (cus > 0 ? cus : 256) * per_cu;
    }
    if (grid < 0) return;
    Args a{};
    for (int i = 0; i < 18; ++i) a.in[i] = (const float*)d_in[i];
    a.out = (float*)d_out; a.ws = (unsigned char*)d_ws;
    for (int l = 0; l < DEPTH; ++l) a.lam_init[l] = (float)(0.8 - 0.6 * exp(-0.3 * (double)l));
#if CFG_ONE_LAUNCH
    a.ph_lo = 0; a.ph_hi = PH_FINAL + 1;
    void* args[] = {&a};
    hipError_t e = hipLaunchCooperativeKernel((const void*)mega, dim3(grid), dim3(512), args, LDS_BYTES, stream);
    if (e != hipSuccess) fprintf(stderr, "cooperative launch failed: %s (grid %d)\n", hipGetErrorString(e), grid);
#else
    for (int p = 0; p <= PH_FINAL; ++p) { if (p != 0 && p != PH_FINAL && (((p - 1) % 10) == 9 || ((p - 1) % 10) == 7)) continue; a.ph_lo = p; a.ph_hi = p + 1; hipLaunchKernelGGL(mega, dim3(grid), dim3(512), LDS_BYTES, stream, a); }
#endif
}
```

```cpp
#include <hip/hip_runtime.h>
#include <hip/hip_cooperative_groups.h>
#include <cstdint>
#include <cstdio>
#include <cmath>
namespace cg = cooperative_groups;

constexpr int BATCH = 2, SEQ = 8192, DM = 1024, DEPTH = 4, M = BATCH * SEQ;
constexpr int INW = 2560, DFF = 2816, UPW = 2 * DFF;
constexpr float EPS = 1e-5f;
constexpr float LOG2E = 1.4426950408889634f;
constexpr float C2 = 0.125f * LOG2E;
constexpr int COL_KA = 512, COL_VA = 1024, COL_UB = 1536, COL_QC = 1792, COL_KC = 2048, COL_VC = 2304;

typedef unsigned short bf16_t;
typedef unsigned u32x4 __attribute__((ext_vector_type(4)));
typedef unsigned u32x2 __attribute__((ext_vector_type(2)));
typedef float f32x4 __attribute__((ext_vector_type(4)));
typedef float f32x2_t __attribute__((ext_vector_type(2)));
typedef __bf16 bf16x2_t __attribute__((ext_vector_type(2)));

constexpr size_t MiB = 1u << 20;
constexpr size_t WS_ROWSS = 304 * MiB;
constexpr size_t WS_W = 2 * MiB;
constexpr size_t W_LAYER = 23 * MiB + 512 * 1024, W_IN = 0, W_OUT = 5 * MiB, W_UP = 7 * MiB, W_DOWN = 18 * MiB;
constexpr size_t WS_XG = 96 * MiB;
constexpr size_t WS_PROJ = 128 * MiB;
constexpr size_t WS_AO = WS_PROJ + 80 * MiB;
constexpr size_t WS_MIX = WS_AO + 32 * MiB;
constexpr size_t WS_ACT = 128 * MiB;
constexpr size_t WS_HEADA = 272 * MiB, WS_HEADG = 278 * MiB, WS_HALO = 284 * MiB;
constexpr size_t WS_END = WS_ROWSS + 9 * MiB;
constexpr int RSS = M * 16;

__device__ __forceinline__ unsigned cvtpk(float lo, float hi) { f32x2_t v = {lo, hi}; bf16x2_t b = __builtin_convertvector(v, bf16x2_t); return __builtin_bit_cast(unsigned, b); }
__device__ __forceinline__ float bflo(unsigned w) { return __uint_as_float(w << 16); }
__device__ __forceinline__ float bfhi(unsigned w) { return __uint_as_float(w & 0xffff0000u); }
__device__ __forceinline__ float bf1(bf16_t v) { return __uint_as_float(((unsigned)v) << 16); }
__device__ __forceinline__ float wave_sum(float v) {
#pragma unroll
    for (int o = 1; o < 64; o <<= 1) v += __shfl_xor(v, o);
    return v;
}

__device__ __forceinline__ float row_rs(const float* rowss, int row) {
    const f32x4* p = (const f32x4*)(rowss + (size_t)row * 16); const f32x4 a = p[0], b = p[1], c = p[2], d = p[3];
    const float s = ((a.x + a.y) + (a.z + a.w)) + ((b.x + b.y) + (b.z + b.w)) + ((c.x + c.y) + (c.z + c.w)) + ((d.x + d.y) + (d.z + d.w));
    return rsqrtf(s * (1.0f / DM) + EPS);
}
struct Args {
    const float* in[18];
    float* out; unsigned char* ws;
    float lam_init[4];
    int ph_lo, ph_hi;
};
constexpr int PH_FINAL = 1 + 10 * DEPTH;

__device__ __forceinline__ void norm0_phase(const float* x, bf16_t* XH, float* rowss, int gw, int NGW, int lane) {
    for (int m = gw; m < M; m += NGW) {
        const f32x4* xr = (const f32x4*)(x + (size_t)m * DM) + lane;
        f32x4 v[4]; float s = 0.f;
#pragma unroll
        for (int j = 0; j < 4; ++j) { v[j] = xr[64 * j]; s += (v[j].x * v[j].x + v[j].y * v[j].y) + (v[j].z * v[j].z + v[j].w * v[j].w); }
        s = wave_sum(s);
        if (lane < 16) rowss[(size_t)m * 16 + lane] = (lane == 0) ? s : 0.f;
#pragma unroll
        for (int j = 0; j < 4; ++j) { u32x2 w; w.x = cvtpk(v[j].x, v[j].y); w.y = cvtpk(v[j].z, v[j].w); *(u32x2*)(XH + (size_t)m * DM + (64 * j + lane) * 4) = w; }
    }
}
__device__ __forceinline__ void combine_phase(const Args& a, int l, const bf16_t* __restrict__ AO, bf16_t* __restrict__ MIX, int gw, int NGW, int lane) {
    const float s1 = wave_sum(a.in[3][l * 64 + lane] * a.in[4][l * 64 + lane]);
    const float s2 = wave_sum(a.in[5][l * 64 + lane] * a.in[6][l * 64 + lane]);
    const float li = a.lam_init[l];
    const float lam = expf(s1) - expf(s2) + li;
    const float sc = 1.0f - li;
    const int h = lane >> 4, j0 = (lane & 15) * 8;
    float g[8];
#pragma unroll
    for (int j = 0; j < 8; ++j) g[j] = a.in[7][l * 128 + j0 + j] * sc;
    for (int t = gw; t < M; t += 4 * NGW) {
        u32x4 x1[4], x2[4];
#pragma unroll
        for (int r = 0; r < 4; ++r) { const int tr = (t + r * NGW < M) ? t + r * NGW : t; const bf16_t* p = AO + (size_t)tr * 1024 + h * 256 + j0; x1[r] = *(const u32x4*)p; x2[r] = *(const u32x4*)(p + 128); }
#pragma unroll
        for (int r = 0; r < 4; ++r) {
            float d[8]; float ss = 0.f;
#pragma unroll
            for (int c = 0; c < 4; ++c) { d[2 * c] = bflo(x1[r][c]) - lam * bflo(x2[r][c]); d[2 * c + 1] = bfhi(x1[r][c]) - lam * bfhi(x2[r][c]); ss += d[2 * c] * d[2 * c] + d[2 * c + 1] * d[2 * c + 1]; }
#pragma unroll
            for (int o = 1; o < 16; o <<= 1) ss += __shfl_xor(ss, o);
            const float rr = rsqrtf(ss * (1.0f / 128.0f) + EPS);
            u32x4 ov;
#pragma unroll
            for (int c = 0; c < 4; ++c) ov[c] = cvtpk(d[2 * c] * rr * g[2 * c], d[2 * c + 1] * rr * g[2 * c + 1]);
            if (t + r * NGW < M) *(u32x4*)(MIX + (size_t)(t + r * NGW) * 1024 + h * 128 + j0) = ov;
        }
    }
}
__device__ __forceinline__ void pool_phase(const Args& a, int l, const bf16_t* PROJ, bf16_t* MIX, float* lds, int blk, int G, int tid) {
    typedef short bf16x8_t __attribute__((ext_vector_type(8)));
    constexpr int DS = 260;
    float* U = lds; float* Dd = lds + 31 * 256;
    const float* pw = a.in[8] + (size_t)l * 4 * 64 * 64; const float* ps = a.in[9] + l * 256;
    const int lane = tid & 63, wv = tid >> 6, g = wv & 3, nb0 = (wv >> 2) * 2, col = lane & 15, quad = lane >> 4;
    bf16x8_t bfr[2][2];
#pragma unroll
    for (int nb = 0; nb < 2; ++nb) { const int dd = (nb0 + nb) * 16 + col; const float sc = ps[g * 64 + dd];
#pragma unroll
        for (int ks = 0; ks < 2; ++ks) { u32x4 w;
#pragma unroll
            for (int q = 0; q < 4; ++q) { const int c = ks * 32 + quad * 8 + 2 * q; w[q] = cvtpk(pw[(g * 64 + c) * 64 + dd] * sc, pw[(g * 64 + c + 1) * 64 + dd] * sc); }
            bfr[nb][ks] = __builtin_bit_cast(bf16x8_t, w); } }
    u32x4 st0, st1;
#define POOL_FETCH(unit_) do { const int t0_ = (unit_) * 16, b_ = t0_ / SEQ, s0_ = t0_ % SEQ; \
        { const int r = tid >> 5, c8 = tid & 31, srow = s0_ - 15 + r; st0 = (u32x4){0u, 0u, 0u, 0u}; if (srow >= 0) st0 = *(const u32x4*)(PROJ + (size_t)(b_ * SEQ + srow) * INW + COL_UB + c8 * 8); } \
        { const int i2 = tid + 512, r = i2 >> 5, c8 = i2 & 31, srow = s0_ - 15 + r; st1 = (u32x4){0u, 0u, 0u, 0u}; if (i2 < 31 * 32 && srow >= 0) st1 = *(const u32x4*)(PROJ + (size_t)(b_ * SEQ + srow) * INW + COL_UB + c8 * 8); } } while (0)
    if (blk < M / 16) POOL_FETCH(blk);
    for (int unit = blk; unit < M / 16; unit += G) {
        const int t0 = unit * 16, s0 = t0 % SEQ;
        { f32x4* d = (f32x4*)(U + (tid >> 5) * 256 + (tid & 31) * 8);
          d[0] = (f32x4){bflo(st0.x), bfhi(st0.x), bflo(st0.y), bfhi(st0.y)}; d[1] = (f32x4){bflo(st0.z), bfhi(st0.z), bflo(st0.w), bfhi(st0.w)};
          const int i2 = tid + 512; if (i2 < 31 * 32) { f32x4* d2 = (f32x4*)(U + (i2 >> 5) * 256 + (i2 & 31) * 8);
              d2[0] = (f32x4){bflo(st1.x), bfhi(st1.x), bflo(st1.y), bfhi(st1.y)}; d2[1] = (f32x4){bflo(st1.z), bfhi(st1.z), bflo(st1.w), bfhi(st1.w)}; } }
        __syncthreads();
        if (unit + G < M / 16) POOL_FETCH(unit + G);
        { const int ch = tid & 255, tt0 = (tid >> 8) * 8, gg = ch >> 6, w = 2 << gg;
          float sum = 0.f;
          for (int j = 0; j < w; ++j) sum += U[(15 + tt0 - j) * 256 + ch];
#pragma unroll
          for (int i = 0; i < 8; ++i) { const int tt = tt0 + i, s = s0 + tt; const int cnt = (s + 1 < w) ? s + 1 : w;
              const float cur = U[(15 + tt) * 256 + ch];
              Dd[tt * DS + ch] = sum / (float)cnt - cur;
              if (i < 7) sum += U[(16 + tt) * 256 + ch] - U[(16 + tt - w) * 256 + ch]; } }
        __syncthreads();
        { f32x4 acc[2]; acc[0] = (f32x4){0.f, 0.f, 0.f, 0.f}; acc[1] = acc[0];
#pragma unroll
          for (int ks = 0; ks < 2; ++ks) {
              const f32x4* dp = (const f32x4*)(Dd + col * DS + g * 64 + ks * 32 + quad * 8); const f32x4 d0 = dp[0], d1 = dp[1];
              u32x4 w; w.x = cvtpk(d0.x, d0.y); w.y = cvtpk(d0.z, d0.w); w.z = cvtpk(d1.x, d1.y); w.w = cvtpk(d1.z, d1.w);
              const bf16x8_t af = __builtin_bit_cast(bf16x8_t, w);
              acc[0] = __builtin_amdgcn_mfma_f32_16x16x32_bf16(af, bfr[0][ks], acc[0], 0, 0, 0);
              acc[1] = __builtin_amdgcn_mfma_f32_16x16x32_bf16(af, bfr[1][ks], acc[1], 0, 0, 0); }
#pragma unroll
          for (int nb = 0; nb < 2; ++nb)
#pragma unroll
              for (int jj = 0; jj < 4; ++jj) MIX[(size_t)(t0 + quad * 4 + jj) * 1024 + 512 + g * 64 + (nb0 + nb) * 16 + col] = (bf16_t)(cvtpk(acc[nb][jj], 0.f) & 0xffffu); }
        __syncthreads();
    }
#undef POOL_FETCH
}
__device__ __forceinline__ void final_phase(float* out, const bf16_t* XH, const float* rowss, const float* g, int gw, int NGW, int lane) {
    for (int m = gw; m < M; m += NGW) {
        const float r = row_rs(rowss, m);
        f32x4* orow = (f32x4*)(out + (size_t)m * DM) + lane;
#pragma unroll
        for (int j = 0; j < 4; ++j) { const f32x4 gg = ((const f32x4*)g)[64 * j + lane]; const u32x2 h = *(const u32x2*)(XH + (size_t)m * DM + (64 * j + lane) * 4);
            const f32x4 v = {bflo(h.x), bfhi(h.x), bflo(h.y), bfhi(h.y)}; orow[64 * j] = v * r * gg; }
    }
}

namespace pg8 {
#define PG8_LAS __attribute__((address_space(3)))
typedef unsigned short bf16_t;
typedef short bf16x8 __attribute__((ext_vector_type(8)));
typedef float f32x4 __attribute__((ext_vector_type(4)));
typedef unsigned u32x4 __attribute__((ext_vector_type(4)));
constexpr int BM = 256, BK = 64, HALF = 128, HTB = HALF * BK * 2  , STAGE_BYTES = 8 * HTB, NXCD = 8, WGM = 8;

__host__ __device__ __forceinline__ int lds_byte(int r, int c) { const int st = (r >> 4) * 2 + (c >> 5), rr = r & 15, cc = c & 31, ob = rr * 64 + cc * 2; return st * 1024 + (ob ^ (((ob >> 9) & 1) << 5)); }
__host__ __device__ __forceinline__ void stage_rc(int b, int& R, int& C) { const int st = b / 1024, sb = b % 1024, swz = sb ^ (((sb >> 9) & 1) << 5); R = (st >> 1) * 16 + swz / 64; C = (st & 1) * 32 + (swz % 64) / 2; }
__host__ __device__ __forceinline__ int lds_byte2(int r, int ch) { return (r >> 3) * 1024 + (r & 7) * 128 + ((ch ^ ((r >> 1) & 7)) * 16); }
__host__ __device__ __forceinline__ void stage_rc2(int b, int& R, int& C) { const int p = b / 1024, l = (b % 1024) / 16; R = p * 8 + (l >> 3); C = ((l & 7) ^ ((R >> 1) & 7)) * 8; }
__host__ __device__ __forceinline__ int perm32(int rho) { const int n = rho >> 4, i = rho & 15; return 8 * (i >> 2) + 4 * n + (i & 3); }

struct Unit { int pm, pn; };
struct Gemm { const bf16_t* A; const bf16_t* Bt; int M, N, K, lda; };

struct StaticOrder {
    int nM, nN, nwg, G, c;
    __host__ __device__ void init(int M, int N, int G_, int c_) { nM = M / BM; nN = N / BM; nwg = nM * nN; G = G_; c = c_; }
    __host__ __device__ bool next(int i, Unit& u) const {
        const long L = (long)i * G + c; if (L >= nwg) return false;
        int wgid = (int)L; { const int q = nwg / NXCD, r = nwg % NXCD, xcd = wgid % NXCD, off = wgid / NXCD; wgid = (xcd < r ? xcd * (q + 1) : r * (q + 1) + (xcd - r) * q) + off; }
        const int nig = WGM * nN, gid = wgid / nig, fm = gid * WGM, gsz = (nM - fm) < WGM ? (nM - fm) : WGM;
        u.pm = fm + ((wgid % nig) % gsz); u.pn = (wgid % nig) / gsz; return true;
    }
    __device__ __forceinline__ void a_ready(const Unit&) const {}
    __device__ __forceinline__ void done(const Unit&) const {}
};


__device__ __forceinline__ unsigned cvt_pk_bf16(float lo, float hi) { typedef float f2 __attribute__((ext_vector_type(2))); typedef __bf16 b2 __attribute__((ext_vector_type(2))); f2 v = {lo, hi}; b2 b = __builtin_convertvector(v, b2); return __builtin_bit_cast(unsigned, b); }
struct EpiScale {
    static constexpr bool PERM = true, AFTER_DRAIN = false;
    bf16_t* O; int ldc; const float* rowss; int qscale;
    __device__ __forceinline__ void operator()(const f32x4 (&acc)[2][2][4][2], const Unit& u, int wr, int wc, int fr, int fq) const {
        const int row0 = u.pm * BM + wr * 64 + fr, col0 = u.pn * BM + wc * 32 + 8 * fq;
        const float cs = (qscale && (u.pn < 2 || u.pn == 7)) ? ::C2 : 1.0f;
#pragma unroll
        for (int ai = 0; ai < 2; ++ai)
#pragma unroll
            for (int m = 0; m < 4; ++m) { const int row = row0 + ai * HALF + m * 16; const float s = ::row_rs(rowss, row) * cs; bf16_t* rowp = O + (size_t)row * ldc + col0;
#pragma unroll
                for (int bj = 0; bj < 2; ++bj) { const f32x4 v0 = acc[ai][bj][m][0] * s, v1 = acc[ai][bj][m][1] * s;
                    u32x4 w; w.x = cvt_pk_bf16(v0[0], v0[1]); w.y = cvt_pk_bf16(v0[2], v0[3]); w.z = cvt_pk_bf16(v1[0], v1[1]); w.w = cvt_pk_bf16(v1[2], v1[3]);
                    *(u32x4*)(rowp + bj * HALF) = w; } }
    }
};
struct EpiResid {
    static constexpr bool PERM = true, AFTER_DRAIN = false;
    bf16_t* xh; float* rowss_next;
    __device__ __forceinline__ void operator()(const f32x4 (&acc)[2][2][4][2], const Unit& u, int wr, int wc, int fr, int fq) const {
        const int col0 = u.pn * BM + wc * 32 + 8 * fq;
#pragma unroll
        for (int ai = 0; ai < 2; ++ai)
#pragma unroll
            for (int m = 0; m < 4; ++m) { const int row = u.pm * BM + ai * HALF + wr * 64 + m * 16 + fr; const size_t off = (size_t)row * 1024 + col0; float ss = 0.f;
#pragma unroll
                for (int bj = 0; bj < 2; ++bj) { const size_t o = off + bj * HALF; const u32x4 h = *(const u32x4*)(xh + o); u32x4 nh;
#pragma unroll
                    for (int q = 0; q < 4; ++q) { const float x0 = ::bflo(h[q]) + acc[ai][bj][m][q >> 1][(q & 1) * 2], x1 = ::bfhi(h[q]) + acc[ai][bj][m][q >> 1][(q & 1) * 2 + 1];
                        ss += x0 * x0 + x1 * x1; nh[q] = cvt_pk_bf16(x0, x1); }
                    *(u32x4*)(xh + o) = nh; }
                ss += __shfl_xor(ss, 16); ss += __shfl_xor(ss, 32);
                if (fq == 0) rowss_next[(size_t)row * 16 + u.pn * 4 + wc] = ss; }
    }
};
__device__ __forceinline__ float dpp_shr1(float old, float v) { return __int_as_float(__builtin_amdgcn_update_dpp(__float_as_int(old), __float_as_int(v), 0x111, 0xf, 0xf, false)); }
__device__ __forceinline__ float dpp_shr2(float old, float v) { return __int_as_float(__builtin_amdgcn_update_dpp(__float_as_int(old), __float_as_int(v), 0x112, 0xf, 0xf, false)); }
__device__ __forceinline__ float dpp_ror1(float v) { return __int_as_float(__builtin_amdgcn_update_dpp(0, __float_as_int(v), 0x121, 0xf, 0xf, false)); }
__device__ __forceinline__ float dpp_ror2(float v) { return __int_as_float(__builtin_amdgcn_update_dpp(0, __float_as_int(v), 0x122, 0xf, 0xf, false)); }
struct EpiConvAct {
    static constexpr bool PERM = true, AFTER_DRAIN = false;
    bf16_t* ACT; const float* rowss; const float* cw; const float* cb; float* HEADA; float* HEADG; float* HALO;
    __device__ __forceinline__ void operator()(const f32x4 (&acc)[2][2][4][2], const Unit& u, int wr, int wc, int fr, int fq) const {
        constexpr int FF = 2816;
        const int ca = u.pn * 128 + wc * 32 + 8 * fq;
        float w0[8], w1[8], w2[8], bb[8];
#pragma unroll
        for (int h = 0; h < 2; ++h) { const f32x4 t0 = *(const f32x4*)(cw + ca + 4 * h), t1 = *(const f32x4*)(cw + FF + ca + 4 * h), t2 = *(const f32x4*)(cw + 2 * FF + ca + 4 * h), t3 = *(const f32x4*)(cb + ca + 4 * h);
#pragma unroll
            for (int j = 0; j < 4; ++j) { w0[4 * h + j] = t0[j]; w1[4 * h + j] = t1[j]; w2[4 * h + j] = t2[j]; bb[4 * h + j] = t3[j]; } }
#pragma unroll
        for (int ai = 0; ai < 2; ++ai) {
            const int blk = u.pm * 4 + ai * 2 + wr;
            float ap[8];
#pragma unroll
            for (int j = 0; j < 8; ++j) ap[j] = 0.f;
#pragma unroll
            for (int m = 0; m < 4; ++m) {
                const int row = u.pm * BM + ai * HALF + wr * 64 + m * 16 + fr; const float rs = ::row_rs(rowss, row);
                float a8[8], g8[8], y[8];
#pragma unroll
                for (int j = 0; j < 8; ++j) { a8[j] = acc[ai][0][m][j >> 2][j & 3] * rs; g8[j] = acc[ai][1][m][j >> 2][j & 3] * rs; }
#pragma unroll
                for (int j = 0; j < 8; ++j) { const float p1 = dpp_shr1(dpp_ror1(ap[j]), a8[j]), p2 = dpp_shr2(dpp_ror2(ap[j]), a8[j]);
                    const float x = bb[j] + w0[j] * p2 + w1[j] * p1 + w2[j] * a8[j];
                    y[j] = x * __builtin_amdgcn_rcpf(1.0f + __expf(-x)) * g8[j]; }
                if (m == 0 && fr < 2) { float* pa = HEADA + ((size_t)blk * 2 + fr) * FF + ca; float* pg = HEADG + ((size_t)blk * 2 + fr) * FF + ca;
                    *(f32x4*)pa = (f32x4){a8[0], a8[1], a8[2], a8[3]}; *(f32x4*)(pa + 4) = (f32x4){a8[4], a8[5], a8[6], a8[7]};
                    *(f32x4*)pg = (f32x4){g8[0], g8[1], g8[2], g8[3]}; *(f32x4*)(pg + 4) = (f32x4){g8[4], g8[5], g8[6], g8[7]}; }
                else { u32x4 w; w.x = cvt_pk_bf16(y[0], y[1]); w.y = cvt_pk_bf16(y[2], y[3]); w.z = cvt_pk_bf16(y[4], y[5]); w.w = cvt_pk_bf16(y[6], y[7]);
                    *(u32x4*)(ACT + (size_t)row * FF + ca) = w; }
                if (m == 3 && fr >= 14) { float* ph = HALO + ((size_t)blk * 2 + (fr - 14)) * FF + ca;
                    *(f32x4*)ph = (f32x4){a8[0], a8[1], a8[2], a8[3]}; *(f32x4*)(ph + 4) = (f32x4){a8[4], a8[5], a8[6], a8[7]}; }
#pragma unroll
                for (int j = 0; j < 8; ++j) ap[j] = a8[j];
            }
        }
    }
};
template <class Epi, class Sched, bool ALIGN_EPI = false, bool SP2 = false>
__device__ __forceinline__ void gemm_phase(PG8_LAS unsigned char* lds, const Gemm g, const Sched& S, const Epi& E) {
    int tid_ = threadIdx.x; asm volatile("" : "+v"(tid_));
    const int tid = tid_, wid = __builtin_amdgcn_readfirstlane(tid >> 6), lane = tid & 63, wr = wid >> 2, wc = wid & 3, fr = lane & 15, fq = lane >> 4;
    const int K = g.K, nt = K / BK;
    unsigned voffA[2], voffB[2];
#pragma unroll
    for (int i = 0; i < 2; ++i) { int R, C; stage_rc2(tid * 16 + i * 8192, R, C); const int Rb = Epi::PERM ? ((R & ~31) + perm32(R & 31)) : R;
        voffA[i] = (unsigned)(R * g.lda + C) * 2u; voffB[i] = (unsigned)(Rb * K + C) * 2u; }
    const size_t kstep = (size_t)(BK * 2);
    const size_t hstepA = (size_t)HALF * g.lda * 2, hstepB = (size_t)HALF * K * 2;
    const size_t tstepA = 2 * hstepA, tstepB = 2 * hstepB;
    const unsigned ldsw = (unsigned)wid * 1024u;
    const int aoffk[2] = {lds_byte2(wr * 64 + fr, fq), lds_byte2(wr * 64 + fr, 4 + fq)}, boffk[2] = {lds_byte2(wc * 32 + fr, fq), lds_byte2(wc * 32 + fr, 4 + fq)};
#define PG8_SA(b, h) (((b) * 2 + (h)) * HTB)
#define PG8_SB(b, h) ((4 + (b) * 2 + (h)) * HTB)
#define PG8_STAGE(bufoff, gbase, voff) do { _Pragma("unroll") for (int _i = 0; _i < 2; ++_i) \
        __builtin_amdgcn_global_load_lds((const unsigned*)((const char*)(gbase) + (voff)[_i]), (PG8_LAS unsigned*)(lds + (bufoff) + ldsw + _i * 8192), 16, 0, 0); } while (0)
#define PG8_LDA(dst, b, h) do { _Pragma("unroll") for (int m = 0; m < 4; ++m) _Pragma("unroll") for (int k = 0; k < 2; ++k) dst[m][k] = *(const PG8_LAS bf16x8*)(lds + PG8_SA(b, h) + aoffk[k] + m * 2048); } while (0)
#define PG8_LDB(dst, b, h) do { _Pragma("unroll") for (int n = 0; n < 2; ++n) _Pragma("unroll") for (int k = 0; k < 2; ++k) dst[n][k] = *(const PG8_LAS bf16x8*)(lds + PG8_SB(b, h) + boffk[k] + n * 2048); } while (0)
#define PG8_MMA(ai, bj, At, Bt) do { __builtin_amdgcn_s_setprio(1); _Pragma("unroll") for (int m = 0; m < 4; ++m) _Pragma("unroll") for (int n = 0; n < 2; ++n) _Pragma("unroll") for (int k = 0; k < 2; ++k) \
        acc[ai][bj][m][n] = __builtin_amdgcn_mfma_f32_16x16x32_bf16(Bt[n][k], At[m][k], acc[ai][bj][m][n], 0, 0, 0); __builtin_amdgcn_s_setprio(0); } while (0)
#define PG8_WAIT_V(n) asm volatile("s_waitcnt vmcnt(" #n ")" ::: "memory")
#define PG8_WAIT_L(n) asm volatile("s_waitcnt lgkmcnt(" #n ")" ::: "memory")
#define PG8_BAR __builtin_amdgcn_s_barrier()
#define PG8_SCHED __builtin_amdgcn_sched_barrier(0)
    Unit cur, nxt; int ui = 0;
    if (!S.next(0, cur)) return;
    f32x4 acc[2][2][4][2];
#pragma unroll
    for (int a = 0; a < 2; ++a)
#pragma unroll
        for (int b = 0; b < 2; ++b)
#pragma unroll
            for (int m = 0; m < 4; ++m)
#pragma unroll
                for (int n = 0; n < 2; ++n) acc[a][b][m][n] = (f32x4){0.f, 0.f, 0.f, 0.f};
    bf16x8 At[4][2], B0[2][2], B1[2][2];
    const char* cA = (const char*)g.A + (size_t)cur.pm * tstepA; const char* cB = (const char*)g.Bt + (size_t)cur.pn * tstepB;
    S.a_ready(cur);
    if constexpr (SP2) {
        PG8_STAGE(PG8_SB(0, 0), cB, voffB); PG8_STAGE(PG8_SB(0, 1), cB + hstepB, voffB); PG8_STAGE(PG8_SA(0, 0), cA, voffA); PG8_STAGE(PG8_SA(0, 1), cA + hstepA, voffA);
        if (wr == 1) PG8_BAR;
        PG8_WAIT_V(2); PG8_BAR;
        PG8_STAGE(PG8_SB(1, 0), cB + kstep, voffB); PG8_STAGE(PG8_SA(1, 0), cA + kstep, voffA); PG8_STAGE(PG8_SB(1, 1), cB + hstepB + kstep, voffB);
        PG8_WAIT_V(6); PG8_BAR;
    } else {
        PG8_STAGE(PG8_SB(0, 0), cB, voffB); PG8_STAGE(PG8_SA(0, 0), cA, voffA); PG8_STAGE(PG8_SB(0, 1), cB + hstepB, voffB); PG8_STAGE(PG8_SA(0, 1), cA + hstepA, voffA);
        if (wr == 1) PG8_BAR;
        PG8_WAIT_V(4); PG8_BAR;
        PG8_STAGE(PG8_SB(1, 0), cB + kstep, voffB); PG8_STAGE(PG8_SA(1, 0), cA + kstep, voffA); PG8_STAGE(PG8_SB(1, 1), cB + hstepB + kstep, voffB);
        PG8_WAIT_V(6); PG8_BAR;
    }
    for (;;) {
        const bool has_next = S.next(ui + 1, nxt);
        const char* nA = has_next ? (const char*)g.A + (size_t)nxt.pm * tstepA : cA; const char* nB = has_next ? (const char*)g.Bt + (size_t)nxt.pn * tstepB : cB;
        for (int t = 0; t < nt; t += 2) {
            const bool last = (t == nt - 2);
            const char* a1 = cA + (size_t)(t + 1) * kstep;
            const char* a2 = last ? nA : cA + (size_t)(t + 2) * kstep; const char* b2 = last ? nB : cB + (size_t)(t + 2) * kstep;
            const char* a3 = a2 + kstep; const char* b3 = b2 + kstep;
            if (last && has_next) S.a_ready(nxt);
            if constexpr (SP2) {
            PG8_LDB(B0, 0, 0); PG8_LDB(B1, 0, 1); PG8_SCHED; PG8_LDA(At, 0, 0); PG8_STAGE(PG8_SA(1, 1), a1 + hstepA, voffA);
            PG8_WAIT_V(8); PG8_WAIT_L(0); PG8_BAR; PG8_MMA(0, 0, At, B0); PG8_MMA(0, 1, At, B1); PG8_BAR; PG8_SCHED;
            PG8_LDA(At, 0, 1); PG8_STAGE(PG8_SB(0, 0), b2, voffB); PG8_STAGE(PG8_SB(0, 1), b2 + hstepB, voffB); PG8_STAGE(PG8_SA(0, 0), a2, voffA);
            PG8_WAIT_V(8); PG8_WAIT_L(0); PG8_BAR; PG8_MMA(1, 0, At, B0); PG8_MMA(1, 1, At, B1); PG8_BAR; PG8_SCHED;
            PG8_LDB(B0, 1, 0); PG8_LDB(B1, 1, 1); PG8_SCHED; PG8_LDA(At, 1, 0); PG8_STAGE(PG8_SA(0, 1), a2 + hstepA, voffA);
            PG8_WAIT_V(8); PG8_WAIT_L(0); PG8_BAR; PG8_MMA(0, 0, At, B0); PG8_MMA(0, 1, At, B1); PG8_BAR; PG8_SCHED;
            PG8_LDA(At, 1, 1); PG8_STAGE(PG8_SB(1, 0), b3, voffB); PG8_STAGE(PG8_SB(1, 1), b3 + hstepB, voffB); PG8_STAGE(PG8_SA(1, 0), a3, voffA);
            PG8_WAIT_V(8); PG8_WAIT_L(0); PG8_BAR; PG8_MMA(1, 0, At, B0); PG8_MMA(1, 1, At, B1); PG8_BAR; PG8_SCHED;
            } else {
            PG8_LDB(B0, 0, 0); PG8_SCHED; PG8_LDA(At, 0, 0); PG8_STAGE(PG8_SA(1, 1), a1 + hstepA, voffA);
            PG8_WAIT_L(8); PG8_BAR; PG8_WAIT_L(0); PG8_MMA(0, 0, At, B0); PG8_BAR; PG8_SCHED;
            PG8_LDB(B1, 0, 1); PG8_STAGE(PG8_SB(0, 0), b2, voffB);
            PG8_BAR; PG8_WAIT_L(0); PG8_MMA(0, 1, At, B1); PG8_BAR;
            PG8_LDA(At, 0, 1); PG8_STAGE(PG8_SA(0, 0), a2, voffA);
            PG8_BAR; PG8_WAIT_L(0); PG8_MMA(1, 0, At, B0); PG8_BAR; PG8_SCHED;
            PG8_STAGE(PG8_SB(0, 1), b2 + hstepB, voffB);
            PG8_WAIT_V(6); PG8_BAR; PG8_MMA(1, 1, At, B1); PG8_BAR;
            PG8_LDB(B0, 1, 0); PG8_SCHED; PG8_LDA(At, 1, 0); PG8_STAGE(PG8_SA(0, 1), a2 + hstepA, voffA);
            PG8_WAIT_L(8); PG8_BAR; PG8_WAIT_L(0); PG8_MMA(0, 0, At, B0); PG8_BAR; PG8_SCHED;
            PG8_LDB(B1, 1, 1); PG8_STAGE(PG8_SB(1, 0), b3, voffB);
            PG8_BAR; PG8_WAIT_L(0); PG8_MMA(0, 1, At, B1); PG8_BAR;
            PG8_LDA(At, 1, 1); PG8_STAGE(PG8_SA(1, 0), a3, voffA);
            PG8_BAR; PG8_WAIT_L(0); PG8_MMA(1, 0, At, B0); PG8_BAR; PG8_SCHED;
            PG8_STAGE(PG8_SB(1, 1), b3 + hstepB, voffB);
            PG8_WAIT_V(6); PG8_BAR; PG8_MMA(1, 1, At, B1); PG8_BAR;
            }
        }
        if constexpr (ALIGN_EPI) { if (wr == 0) PG8_BAR; }
        if constexpr (!Epi::AFTER_DRAIN) { E(acc, cur, wr, wc, fr, fq); S.done(cur); }
        if (!has_next) break;
#pragma unroll
        for (int a = 0; a < 2; ++a)
#pragma unroll
            for (int b = 0; b < 2; ++b)
#pragma unroll
                for (int m = 0; m < 4; ++m)
#pragma unroll
                    for (int n = 0; n < 2; ++n) acc[a][b][m][n] = (f32x4){0.f, 0.f, 0.f, 0.f};
        cur = nxt; cA = nA; cB = nB; ++ui;
        if constexpr (ALIGN_EPI) { if (wr == 1) PG8_BAR; }
    }
    PG8_WAIT_V(0);
    if constexpr (!ALIGN_EPI) { if (wr == 0) PG8_BAR; }
    PG8_BAR;
    if constexpr (Epi::AFTER_DRAIN) { E.fused(acc, cur, wr, wc, fr, fq, lds, wid, lane); S.done(cur); }
#undef PG8_SA
#undef PG8_SB
#undef PG8_STAGE
#undef PG8_LDA
#undef PG8_LDB
#undef PG8_MMA
#undef PG8_WAIT_V
#undef PG8_WAIT_L
#undef PG8_BAR
#undef PG8_SCHED
}
}

#include <hip/hip_bf16.h>
namespace attn_body {
using bf16=__hip_bfloat16;
using bf16x8=__attribute__((ext_vector_type(8)))short;
using s16x4=__attribute__((ext_vector_type(4)))short;
using f32x16=__attribute__((ext_vector_type(16)))float;
using u32x4=__attribute__((ext_vector_type(4)))unsigned;
constexpr int SEQ=8192,D=64,PQ=2560,PO=1024;
constexpr int NW=8,QBLK=32,QB=QBLK*NW,KVBLK=64,NQB=SEQ/QB;
constexpr int ATTN_UNIT_ROWS=QB;
__device__ __forceinline__ int crow(int r,int hi){return (r&3)+8*(r>>2)+4*hi;}
#define SBAR() __builtin_amdgcn_sched_barrier(0)
__device__ __forceinline__ void cmask(f32x16&p0,f32x16&p1,int jb,int qrel,int hi){
  const float NEG=-INFINITY; (void)hi;
  if(jb>(qrel>>6)){
  #pragma unroll
  for(int r=0;r<16;++r){p0[r]=NEG;p1[r]=NEG;}}
}

constexpr int NSLOT=3, SLOTB=8192;
constexpr int LDS_K=0, LDS_V=NSLOT*SLOTB, LDS_WS=2*NSLOT*SLOTB, LDS_OST=LDS_WS+NW*64*4, LDS_BYTES=LDS_OST+NW*4096;
constexpr float C2=0.125f*1.4426950408889634f;
__device__ __forceinline__ void glds16(const void*gsrc,unsigned lds_dst){unsigned keep;
  asm volatile("s_mov_b32 %0, m0\n\ts_mov_b32 m0, %2\n\ts_nop 0\n\tglobal_load_lds_dwordx4 %1, off\n\ts_mov_b32 m0, %0":"=&s"(keep):"v"(gsrc),"s"(lds_dst):"memory");}
__device__ __forceinline__ float max3f(float a,float b,float c){float r;asm("v_max3_f32 %0, %1, %2, %3":"=v"(r):"v"(a),"v"(b),"v"(c));return r;}
__device__ __forceinline__ float max2f(float a,float b){float r;asm("v_max_f32_e32 %0, %1, %2":"=v"(r):"v"(a),"v"(b));return r;}
__device__ __forceinline__ float fadd_s(float a,float b){float r;asm("v_add_f32_e32 %0, %1, %2":"=v"(r):"v"(a),"v"(b));return r;}
__device__ __forceinline__ float fsub_s(float a,float b){float r;asm("v_sub_f32_e32 %0, %1, %2":"=v"(r):"v"(a),"v"(b));return r;}
typedef float f32x2_t __attribute__((ext_vector_type(2))); typedef __bf16 bf16x2_t __attribute__((ext_vector_type(2)));
__device__ __forceinline__ unsigned cvtpk_s(float lo,float hi){f32x2_t v={lo,hi};bf16x2_t b=__builtin_convertvector(v,bf16x2_t);return __builtin_bit_cast(unsigned,b);}
#define WAIT_BAR(N) asm volatile("s_waitcnt vmcnt(" #N ") lgkmcnt(0)\n\ts_barrier":::"memory")

__device__ __forceinline__ void qkt(f32x16&p0,f32x16&p1,const char*Kslot,const bf16x8*qr,const f32x16&negm,int r32,int hi){
  const char*kb=Kslot+hi*1024+r32*16;
  #pragma unroll
  for(int d0=0;d0<4;++d0){
    const bf16x8 b0=*reinterpret_cast<const bf16x8*>(kb+d0*2048);
    const bf16x8 b1=*reinterpret_cast<const bf16x8*>(kb+d0*2048+512);
    if(d0==0){p0=__builtin_amdgcn_mfma_f32_32x32x16_bf16(b0,qr[0],negm,0,0,0);p1=__builtin_amdgcn_mfma_f32_32x32x16_bf16(b1,qr[0],negm,0,0,0);}
    else{p0=__builtin_amdgcn_mfma_f32_32x32x16_bf16(b0,qr[d0],p0,0,0,0);p1=__builtin_amdgcn_mfma_f32_32x32x16_bf16(b1,qr[d0],p1,0,0,0);}}
}
typedef __attribute__((address_space(3))) const char* lds_cptr;
typedef short v4i16_t __attribute__((ext_vector_type(4)));
__device__ __forceinline__ void kload8(bf16x8*kf,lds_cptr kp){
  kf[0]=*(const __attribute__((address_space(3))) bf16x8*)(kp);      kf[1]=*(const __attribute__((address_space(3))) bf16x8*)(kp+512);
  kf[2]=*(const __attribute__((address_space(3))) bf16x8*)(kp+2048); kf[3]=*(const __attribute__((address_space(3))) bf16x8*)(kp+2560);
  kf[4]=*(const __attribute__((address_space(3))) bf16x8*)(kp+4096); kf[5]=*(const __attribute__((address_space(3))) bf16x8*)(kp+4608);
  kf[6]=*(const __attribute__((address_space(3))) bf16x8*)(kp+6144); kf[7]=*(const __attribute__((address_space(3))) bf16x8*)(kp+6656);
}
__device__ __forceinline__ void kload2(bf16x8*kf,lds_cptr kp,int j){ kf[2*j]=*(const __attribute__((address_space(3))) bf16x8*)(kp+j*2048); kf[2*j+1]=*(const __attribute__((address_space(3))) bf16x8*)(kp+j*2048+512); }
__device__ __forceinline__ s16x4 vtr(lds_cptr p){ return __builtin_bit_cast(s16x4,__builtin_amdgcn_ds_read_tr16_b64_v4i16((__attribute__((address_space(3))) v4i16_t*)p)); }
__device__ __forceinline__ float rowmax(const f32x16&p0,const f32x16&p1){
  float a=max3f(p0[0],p0[1],p1[0]),b=max3f(p0[2],p0[3],p1[1]);a=max3f(a,p1[2],p1[3]);
  #pragma unroll
  for(int r=4;r<16;r+=4){a=max3f(a,p0[r],p0[r+1]);b=max3f(b,p0[r+2],p0[r+3]);a=max3f(a,p1[r],p1[r+1]);b=max3f(b,p1[r+2],p1[r+3]);}
  const float m=max2f(a,b);
  auto rr=__builtin_amdgcn_permlane32_swap(__float_as_uint(m),__float_as_uint(m),false,false);
  return max2f(__uint_as_float(rr[0]),__uint_as_float(rr[1]));
}
__device__ __forceinline__ void pv(f32x16*o,int vb,bf16x8 pa0,bf16x8 pa1,bf16x8 pa2,bf16x8 pa3){
  #pragma unroll
  for(int d0=0;d0<2;++d0){s16x4 lo[4],hi[4];
    #pragma unroll
    for(int ks=0;ks<4;++ks){
      asm volatile("ds_read_b64_tr_b16 %0,%1 offset:%c2":"=&v"(lo[ks]):"v"(vb),"i"(d0*4096+ks*1024):"memory");
      asm volatile("ds_read_b64_tr_b16 %0,%1 offset:%c2":"=&v"(hi[ks]):"v"(vb),"i"(d0*4096+ks*1024+512):"memory");}
    asm volatile("s_waitcnt lgkmcnt(0)":::"memory");SBAR();
    #define PK(k) (bf16x8){lo[k][0],lo[k][1],lo[k][2],lo[k][3],hi[k][0],hi[k][1],hi[k][2],hi[k][3]}
    o[d0]=__builtin_amdgcn_mfma_f32_32x32x16_bf16(pa0,PK(0),o[d0],0,0,0);
    o[d0]=__builtin_amdgcn_mfma_f32_32x32x16_bf16(pa1,PK(1),o[d0],0,0,0);
    o[d0]=__builtin_amdgcn_mfma_f32_32x32x16_bf16(pa2,PK(2),o[d0],0,0,0);
    o[d0]=__builtin_amdgcn_mfma_f32_32x32x16_bf16(pa3,PK(3),o[d0],0,0,0);
    #undef PK
  }
}

#ifndef ATTN_STORE16
#define ATTN_STORE16(p,v) (*(u32x4*)(p)=(v))
#endif
template<int THRL> __device__ __forceinline__ void attn_unit(int b,int qb,const bf16*Q,const bf16*__restrict__ K,const bf16*__restrict__ V,bf16*O,char*shm){
  int tid_=threadIdx.x; asm volatile("":"+v"(tid_)); const int tid=tid_,lane=tid&63,r32=lane&31,hi=lane>>5; const int wid=__builtin_amdgcn_readfirstlane(tid>>6);
  const long rowbase=(long)b*SEQ; const int q0=qb*QB;
  const bf16*Qw=Q+(rowbase+q0+wid*QBLK)*PQ;
  const bf16*Kh=K+rowbase*PQ,*Vh=V+rowbase*PQ;
  const unsigned lds0=(unsigned)(uintptr_t)shm;
  float*wsf=(float*)(shm+LDS_WS)+wid*64;
  const bf16*ksrc=Kh+(long)lane*PQ+wid*8;
  const bf16*vsrc=Vh+(long)(16*(wid&3)+(lane>>2))*PQ+(wid>>2)*32+(lane&3)*8;
  const unsigned kdst=lds0+LDS_K+wid*1024, vdst=lds0+LDS_V+wid*1024;
  #define DMA_K(t,slot) glds16(ksrc+(long)(t)*KVBLK*PQ,(unsigned)__builtin_amdgcn_readfirstlane(kdst+(slot)))
  #define DMA_V(t,slot) glds16(vsrc+(long)(t)*KVBLK*PQ,(unsigned)__builtin_amdgcn_readfirstlane(vdst+(slot)))
  const int vb0=(int)(lds0+LDS_V)+((lane>>4)&1)*32+(lane&3)*8+(4*hi+((lane&15)>>2))*64;
  const char*Kbase=shm+LDS_K; bf16x8 kf[8];
  const lds_cptr shm3=(lds_cptr)shm; const lds_cptr kp0=shm3+LDS_K+hi*1024+r32*16; const lds_cptr vp0=shm3+LDS_V+((lane>>4)&1)*32+(lane&3)*8+(4*hi+((lane&15)>>2))*64;
  const int NT=(q0+QB)/KVBLK;
  DMA_K(0,0);DMA_V(0,0);DMA_K(1,SLOTB);
  bf16x8 qr[4];
  #pragma unroll
  for(int d0=0;d0<4;++d0)qr[d0]=*reinterpret_cast<const bf16x8*>(&Qw[(long)r32*PQ+d0*16+hi*8]);
  float mhat=0.f,l_reg=0.f;f32x16 o[2];o[0]=f32x16{};o[1]=f32x16{};f32x16 negm=f32x16{};asm volatile("":"+v"(negm));
  const int qrel=wid*QBLK+r32;
  #define CMASK(P0,P1,t) do{int jb_=(t)-(NT-4); if(jb_>=0)cmask(P0,P1,jb_,qrel,hi);}while(0)
  bool resc=false;
  #define START(P0,P1) do{ const float rm=rowmax(P0,P1); resc=false; \
    { const float dl=rm; mhat=fadd_s(mhat,dl); \
      _Pragma("unroll") for(int r=0;r<16;++r){P0[r]=fsub_s(P0[r],dl);P1[r]=fsub_s(P1[r],dl);} \
      _Pragma("unroll") for(int r=0;r<16;++r)negm[r]=-mhat; asm volatile("":"+v"(negm)); } \
    _Pragma("unroll") for(int r=0;r<16;++r)P0[r]=__builtin_amdgcn_exp2f(P0[r]); }while(0)
  #define RESC() do{ if(resc){ asm volatile("s_waitcnt lgkmcnt(0)":::"memory"); \
      _Pragma("unroll") for(int d_=0;d_<2;++d_) _Pragma("unroll") for(int r=0;r<16;++r)o[d_][r]*=wsf[crow(r,hi)]; } }while(0)
  f32x16 pA0,pA1,pB0,pB1;
  int sl_prev=0,sl_cur=0,sl_next=SLOTB;
  #define ROT() do{sl_prev=sl_cur;sl_cur=sl_next;sl_next=(sl_next==(NSLOT-1)*SLOTB)?0:sl_next+SLOTB;}while(0)
  DMA_K(2,2*SLOTB);
  WAIT_BAR(3);
  qkt(pA0,pA1,Kbase,qr,negm,r32,hi);asm volatile("s_nop 15\n\ts_nop 7":"+v"(pA0),"+v"(pA1));CMASK(pA0,pA1,0);
  START(pA0,pA1);
  _Pragma("unroll") for(int r=0;r<16;++r)pA1[r]=__builtin_amdgcn_exp2f(pA1[r]);
  WAIT_BAR(0);
  DMA_K(3,0);DMA_V(1,SLOTB);
  ROT();
  kload8(kf,kp0+sl_cur);
  WAIT_BAR(2);
  s16x4 vlo[8],vhi[8]; u32x4 pw0,pw1,pw2,pw3;
  #define PKW(P,B) cvtpk_s(P[B],P[B+1])
  #define PAF(k) __builtin_bit_cast(bf16x8,pw##k)
  #define VFR(i) (bf16x8){vlo[i][0],vlo[i][1],vlo[i][2],vlo[i][3],vhi[i][0],vhi[i][1],vhi[i][2],vhi[i][3]}
  #define PIN(x) asm volatile("":"+v"(x))
  #define MX3(a,b,c) __builtin_fmaxf(__builtin_fmaxf((a),(b)),(c))
  #define GAPA(MF,A0,A1,A2,A3,W0,W1,PW) do{ MF; sacc+=A0; sacc+=A1; sacc+=A2; sacc+=A3; PIN(sacc); W0; W1; PIN(PW); SBAR(); }while(0)
  #define EX(v) __builtin_amdgcn_exp2f(v)
  #define GAPB(MF,X,B) do{ MF; X[B]=EX(X[B]); X[B+1]=EX(X[B+1]); X[B+2]=EX(X[B+2]); X[B+3]=EX(X[B+3]); PIN(X); SBAR(); }while(0)
  #define VRD(i) do{ vlo[i]=vtr(vp_+(((i)>>2)*4096+((i)&3)*1024)); vhi[i]=vtr(vp_+(((i)>>2)*4096+((i)&3)*1024+512)); }while(0)
  #define KRD(G,j) do{ if(G){ kload2(kf,kp0+sl_next,j); SBAR(); } }while(0)
  #define STEP(C0,C1,P0,P1,t,GK,GV,GL) do{ SBAR(); \
    const lds_cptr vp_=vp0+sl_prev; \
    VRD(0); SBAR(); float sacc=(P0[0]+P0[1]); \
    GAPA(C0=__builtin_amdgcn_mfma_f32_32x32x16_bf16(kf[0],qr[0],negm,0,0,0), P0[2],P0[3],P0[4],P0[5],     pw0[0]=PKW(P0,0), pw0[1]=PKW(P0,2), pw0); \
    VRD(4); SBAR(); GAPA(C1=__builtin_amdgcn_mfma_f32_32x32x16_bf16(kf[1],qr[0],negm,0,0,0), P0[6],P0[7],P0[8],P0[9],     pw0[2]=PKW(P0,4), pw0[3]=PKW(P0,6), pw0); \
    VRD(1); SBAR(); GAPA(C0=__builtin_amdgcn_mfma_f32_32x32x16_bf16(kf[2],qr[1],C0,0,0,0),   P0[10],P0[11],P0[12],P0[13], pw1[0]=PKW(P0,8), pw1[1]=PKW(P0,10), pw1); \
    VRD(5); SBAR(); GAPA(C1=__builtin_amdgcn_mfma_f32_32x32x16_bf16(kf[3],qr[1],C1,0,0,0),   P0[14],P0[15],P1[0],P1[1],   pw1[2]=PKW(P0,12),pw1[3]=PKW(P0,14), pw1); \
    VRD(2); SBAR(); GAPA(C0=__builtin_amdgcn_mfma_f32_32x32x16_bf16(kf[4],qr[2],C0,0,0,0),   P1[2],P1[3],P1[4],P1[5],     pw2[0]=PKW(P1,0), pw2[1]=PKW(P1,2), pw2); \
    VRD(6); SBAR(); GAPA(C1=__builtin_amdgcn_mfma_f32_32x32x16_bf16(kf[5],qr[2],C1,0,0,0),   P1[6],P1[7],P1[8],P1[9],     pw2[2]=PKW(P1,4), pw2[3]=PKW(P1,6), pw2); \
    VRD(3); SBAR(); GAPA(C0=__builtin_amdgcn_mfma_f32_32x32x16_bf16(kf[6],qr[3],C0,0,0,0),   P1[10],P1[11],P1[12],P1[13], pw3[0]=PKW(P1,8), pw3[1]=PKW(P1,10), pw3); \
    VRD(7); SBAR(); GAPA(C1=__builtin_amdgcn_mfma_f32_32x32x16_bf16(kf[7],qr[3],C1,0,0,0),   P1[14],P1[15],0.f,0.f,       pw3[2]=PKW(P1,12),pw3[3]=PKW(P1,14), pw3); \
    l_reg+=sacc; \
    if(GK){DMA_K((t)+3,sl_cur);} if(GV){DMA_V((t)+1,sl_next);} \
    CMASK(C0,C1,t); \
    { float a=MX3(C0[0],C0[1],C1[0]),b=MX3(C0[2],C0[3],C1[1]); a=MX3(a,C1[2],C1[3]); \
      _Pragma("unroll") for(int r=4;r<16;r+=4){a=MX3(a,C0[r],C0[r+1]);b=MX3(b,C0[r+2],C0[r+3]);a=MX3(a,C1[r],C1[r+1]);b=MX3(b,C1[r+2],C1[r+3]);} \
      float rm=__builtin_fmaxf(a,b); { auto rr=__builtin_amdgcn_permlane32_swap(__float_as_uint(rm),__float_as_uint(rm),false,false); rm=__builtin_fmaxf(__uint_as_float(rr[0]),__uint_as_float(rr[1])); } \
      resc=false; \
      if(__builtin_expect(__any(rm>(float)THRL),0)){ const float dl=__builtin_fmaxf(rm,0.f); mhat+=dl; \
        _Pragma("unroll") for(int r=0;r<16;++r){C0[r]-=dl;C1[r]-=dl;} \
        _Pragma("unroll") for(int r=0;r<16;++r)negm[r]=-mhat; asm volatile("":"+v"(negm)); \
        const float f=__builtin_amdgcn_exp2f(-dl); l_reg*=f; if(hi==0)wsf[r32]=f; resc=true; } } \
    SBAR(); \
    GAPB(o[0]=__builtin_amdgcn_mfma_f32_32x32x16_bf16(PAF(0),VFR(0),o[0],0,0,0), C0,0); \
    GAPB(o[1]=__builtin_amdgcn_mfma_f32_32x32x16_bf16(PAF(0),VFR(4),o[1],0,0,0), C0,4); \
    KRD(GL,0); GAPB(o[0]=__builtin_amdgcn_mfma_f32_32x32x16_bf16(PAF(1),VFR(1),o[0],0,0,0), C0,8); \
    KRD(GL,1); GAPB(o[1]=__builtin_amdgcn_mfma_f32_32x32x16_bf16(PAF(1),VFR(5),o[1],0,0,0), C0,12); \
    KRD(GL,2); GAPB(o[0]=__builtin_amdgcn_mfma_f32_32x32x16_bf16(PAF(2),VFR(2),o[0],0,0,0), C1,0); \
    KRD(GL,3); GAPB(o[1]=__builtin_amdgcn_mfma_f32_32x32x16_bf16(PAF(2),VFR(6),o[1],0,0,0), C1,4); \
    GAPB(o[0]=__builtin_amdgcn_mfma_f32_32x32x16_bf16(PAF(3),VFR(3),o[0],0,0,0), C1,8); \
    GAPB(o[1]=__builtin_amdgcn_mfma_f32_32x32x16_bf16(PAF(3),VFR(7),o[1],0,0,0), C1,12); \
    }while(0)
  int t=1;
  #undef CMASK
  #define CMASK(P0,P1,t) do{}while(0)
  for(;t+5<NT;t+=2){
    STEP(pB0,pB1,pA0,pA1,t,true,true,true);     WAIT_BAR(2); RESC(); ROT();
    STEP(pA0,pA1,pB0,pB1,t+1,true,true,true);   WAIT_BAR(2); RESC(); ROT();
  }
  #undef CMASK
  #define CMASK(P0,P1,t) do{int jb_=(t)-(NT-4); if(jb_>=0)cmask(P0,P1,jb_,qrel,hi);}while(0)
  #define ENDW(tt) do{ if((tt)+3<NT){WAIT_BAR(2);} else if((tt)+2<NT){WAIT_BAR(1);} else {WAIT_BAR(0);} }while(0)
  for(;t+1<NT;t+=2){
    STEP(pB0,pB1,pA0,pA1,t,(t+3<NT),(t+1<NT),(t+1<NT));       ENDW(t);   RESC(); ROT();
    STEP(pA0,pA1,pB0,pB1,t+1,(t+4<NT),(t+2<NT),(t+2<NT));     ENDW(t+1); RESC(); ROT();
  }
  STEP(pB0,pB1,pA0,pA1,NT-1,false,false,false); RESC();
  { float sacc=pB0[0]+pB0[1]; _Pragma("unroll") for(int r=2;r<16;++r)sacc+=pB0[r]; _Pragma("unroll") for(int r=0;r<16;++r)sacc+=pB1[r]; l_reg+=sacc;
    pw0=(u32x4){PKW(pB0,0),PKW(pB0,2),PKW(pB0,4),PKW(pB0,6)};pw1=(u32x4){PKW(pB0,8),PKW(pB0,10),PKW(pB0,12),PKW(pB0,14)};pw2=(u32x4){PKW(pB1,0),PKW(pB1,2),PKW(pB1,4),PKW(pB1,6)};pw3=(u32x4){PKW(pB1,8),PKW(pB1,10),PKW(pB1,12),PKW(pB1,14)};
    SBAR(); pv(o,vb0+sl_cur,PAF(0),PAF(1),PAF(2),PAF(3)); }
  #undef PKW
  #undef PAF
  #undef VFR
  #undef PIN
  #undef MX3
  #undef GAPA
  #undef GAPB
  #undef EX
  #undef VRD
  #undef KRD
  #undef STEP
  #undef ENDW
  {auto rr=__builtin_amdgcn_permlane32_swap(__float_as_uint(l_reg),__float_as_uint(l_reg),false,false);l_reg=__uint_as_float(rr[0])+__uint_as_float(rr[1]);}
  if(hi==0)wsf[32+r32]=l_reg;asm volatile("s_waitcnt lgkmcnt(0)":::"memory");
  float rli[16];
  #pragma unroll
  for(int r=0;r<16;++r)rli[r]=__builtin_amdgcn_rcpf(wsf[32+crow(r,hi)]);
  bf16*Ow=O+(rowbase+q0+wid*QBLK)*PO;
  { bf16*stg=(bf16*)(shm+LDS_OST)+wid*2048;
    #pragma unroll
    for(int r=0;r<16;++r){const int orow=crow(r,hi);
      #pragma unroll
      for(int d0=0;d0<2;++d0)stg[orow*64+d0*32+r32]=__float2bfloat16(o[d0][r]*rli[r]);}
    asm volatile("s_waitcnt lgkmcnt(0)":::"memory");
    #pragma unroll
    for(int i=0;i<4;++i){const int row=i*8+(lane>>3),ch=lane&7; const u32x4 v=*(const u32x4*)(stg+row*64+ch*8); ATTN_STORE16(Ow+(long)row*PO+ch*8,v);} }
  asm volatile("s_waitcnt lgkmcnt(0)\n\ts_barrier":::"memory");
  #undef DMA_K
  #undef DMA_V
  #undef CMASK
  #undef START
  #undef RESC
  #undef ROT
}


#define PV128_RD(LO,HI,vp,goff) do{ _Pragma("unroll") for(int ks=0;ks<4;++ks){ LO[ks]=vtr((vp)+((goff)+ks*1024)); HI[ks]=vtr((vp)+((goff)+ks*1024+512)); } }while(0)
#define PV128_MM(O,LO,HI) do{ \
    O=__builtin_amdgcn_mfma_f32_32x32x16_bf16(pa0,(bf16x8){LO[0][0],LO[0][1],LO[0][2],LO[0][3],HI[0][0],HI[0][1],HI[0][2],HI[0][3]},O,0,0,0); \
    O=__builtin_amdgcn_mfma_f32_32x32x16_bf16(pa1,(bf16x8){LO[1][0],LO[1][1],LO[1][2],LO[1][3],HI[1][0],HI[1][1],HI[1][2],HI[1][3]},O,0,0,0); \
    O=__builtin_amdgcn_mfma_f32_32x32x16_bf16(pa2,(bf16x8){LO[2][0],LO[2][1],LO[2][2],LO[2][3],HI[2][0],HI[2][1],HI[2][2],HI[2][3]},O,0,0,0); \
    O=__builtin_amdgcn_mfma_f32_32x32x16_bf16(pa3,(bf16x8){LO[3][0],LO[3][1],LO[3][2],LO[3][3],HI[3][0],HI[3][1],HI[3][2],HI[3][3]},O,0,0,0); }while(0)
__device__ __forceinline__ void pv128(f32x16*o,lds_cptr vp,s16x4 (&loA)[4],s16x4 (&hiA)[4],bf16x8 pa0,bf16x8 pa1,bf16x8 pa2,bf16x8 pa3){
  s16x4 loB[4],hiB[4];
  PV128_RD(loB,hiB,vp,4096);      SBAR(); PV128_MM(o[0],loA,hiA); SBAR();
  PV128_RD(loA,hiA,vp,8192);      SBAR(); PV128_MM(o[1],loB,hiB); SBAR();
  PV128_RD(loB,hiB,vp,8192+4096); SBAR(); PV128_MM(o[2],loA,hiA); SBAR();
  PV128_MM(o[3],loB,hiB);
}
namespace dfa { constexpr int DK=0, DV=3*8192, DWS=DV+3*16384, DOST=0, BYTES=DWS+2048; }
template<int THR> __device__ __forceinline__ void diff_unit(int b,int qb,const bf16*Q,const bf16*__restrict__ K,const bf16*__restrict__ V,bf16*O,char*shm){
  int tid_=threadIdx.x; asm volatile("":"+v"(tid_)); const int tid=tid_,lane=tid&63,r32=lane&31,hi=lane>>5; const int wid=__builtin_amdgcn_readfirstlane(tid>>6);
  const long rowbase=(long)b*SEQ; const int q0=qb*QB;
  const bf16*Qw=Q+(rowbase+q0+wid*QBLK)*PQ;
  const bf16*Kh=K+rowbase*PQ,*Vh=V+rowbase*PQ;
  const unsigned lds0=(unsigned)(uintptr_t)shm;
  float*wsf=(float*)(shm+dfa::DWS)+wid*64;
  const bf16*ksrc=Kh+(long)lane*PQ+wid*8;
  const bf16*vsrc=Vh+(long)(16*(wid&3)+(lane>>2))*PQ+(wid>>2)*32+(lane&3)*8;
  const unsigned kdst=lds0+dfa::DK+wid*1024, vdst=lds0+dfa::DV+wid*1024;
  #define DFA_DMA(t,sK,sV) do{ glds16(ksrc+(long)(t)*KVBLK*PQ,(unsigned)__builtin_amdgcn_readfirstlane(kdst+(sK))); \
      glds16(vsrc+(long)(t)*KVBLK*PQ,(unsigned)__builtin_amdgcn_readfirstlane(vdst+(sV))); glds16(vsrc+(long)(t)*KVBLK*PQ+64,(unsigned)__builtin_amdgcn_readfirstlane(vdst+(sV)+8192)); }while(0)
  const lds_cptr vp0=(lds_cptr)shm+dfa::DV+((lane>>4)&1)*32+(lane&3)*8+(4*hi+((lane&15)>>2))*64;
  const int NT=(q0+QB)/KVBLK, tlast=NT-4+(wid>>1);
  DFA_DMA(0,0,0); DFA_DMA(1,8192,16384);
  bf16x8 qr[4];
  #pragma unroll
  for(int d0=0;d0<4;++d0)qr[d0]=*reinterpret_cast<const bf16x8*>(&Qw[(long)r32*PQ+d0*16+hi*8]);
  asm volatile("":"+v"(qr[0]),"+v"(qr[1]),"+v"(qr[2]),"+v"(qr[3]));
  float l_reg=0.f; f32x16 o[4]; o[0]=f32x16{}; o[1]=f32x16{}; o[2]=f32x16{}; o[3]=f32x16{}; f32x16 negm=f32x16{};
  int sK=0,sV=0,sK2=2*8192,sV2=2*16384;
  for(int t=0;t<NT;++t){
    if(t+1<NT){WAIT_BAR(3);}else{WAIT_BAR(0);}
    if(t+2<NT){DFA_DMA(t+2,sK2,sV2);}
    if(t<=tlast){
      f32x16 p0,p1; qkt(p0,p1,shm+dfa::DK+sK,qr,negm,r32,hi);
      const lds_cptr vpt=vp0+sV; s16x4 vlo0[4],vhi0[4]; PV128_RD(vlo0,vhi0,vpt,0); SBAR();
      float rm=p0[0];
      #pragma unroll
      for(int r=0;r<16;++r){rm=__builtin_fmaxf(rm,p0[r]);rm=__builtin_fmaxf(rm,p1[r]);}
      { auto rr=__builtin_amdgcn_permlane32_swap(__float_as_uint(rm),__float_as_uint(rm),false,false); rm=__builtin_fmaxf(__uint_as_float(rr[0]),__uint_as_float(rr[1])); }
      if(t==0||__any(rm>(float)THR)){
        const float dl=(t==0)?rm:__builtin_fmaxf(rm,0.f);
        #pragma unroll
        for(int r=0;r<16;++r){p0[r]-=dl;p1[r]-=dl;negm[r]-=dl;}
        if(t!=0){ const float f=__builtin_amdgcn_exp2f(-dl); l_reg*=f; if(hi==0)wsf[r32]=f; asm volatile("s_waitcnt lgkmcnt(0)":::"memory");
          #pragma unroll
          for(int r=0;r<16;++r){const float fr_=wsf[crow(r,hi)]; o[0][r]*=fr_; o[1][r]*=fr_; o[2][r]*=fr_; o[3][r]*=fr_;} }
      }
      float sacc=0.f;
      #pragma unroll
      for(int r=0;r<16;++r){p0[r]=__builtin_amdgcn_exp2f(p0[r]);p1[r]=__builtin_amdgcn_exp2f(p1[r]);sacc+=p0[r]+p1[r];}
      l_reg+=sacc;
      u32x4 pw0,pw1,pw2,pw3;
      pw0=(u32x4){cvtpk_s(p0[0],p0[1]),cvtpk_s(p0[2],p0[3]),cvtpk_s(p0[4],p0[5]),cvtpk_s(p0[6],p0[7])};
      pw1=(u32x4){cvtpk_s(p0[8],p0[9]),cvtpk_s(p0[10],p0[11]),cvtpk_s(p0[12],p0[13]),cvtpk_s(p0[14],p0[15])};
      pw2=(u32x4){cvtpk_s(p1[0],p1[1]),cvtpk_s(p1[2],p1[3]),cvtpk_s(p1[4],p1[5]),cvtpk_s(p1[6],p1[7])};
      pw3=(u32x4){cvtpk_s(p1[8],p1[9]),cvtpk_s(p1[10],p1[11]),cvtpk_s(p1[12],p1[13]),cvtpk_s(p1[14],p1[15])};
      SBAR(); pv128(o,vpt,vlo0,vhi0,__builtin_bit_cast(bf16x8,pw0),__builtin_bit_cast(bf16x8,pw1),__builtin_bit_cast(bf16x8,pw2),__builtin_bit_cast(bf16x8,pw3));
    }
    sK2=sK; sV2=sV; sK=(sK==2*8192)?0:sK+8192; sV=(sV==2*16384)?0:sV+16384;
  }
  asm volatile("s_waitcnt lgkmcnt(0)\n\ts_barrier":::"memory");
  {auto rr=__builtin_amdgcn_permlane32_swap(__float_as_uint(l_reg),__float_as_uint(l_reg),false,false);l_reg=__uint_as_float(rr[0])+__uint_as_float(rr[1]);}
  if(hi==0)wsf[32+r32]=l_reg;asm volatile("s_waitcnt lgkmcnt(0)":::"memory");
  float rli[16];
  #pragma unroll
  for(int r=0;r<16;++r)rli[r]=__builtin_amdgcn_rcpf(wsf[32+crow(r,hi)]);
  bf16*Ow=O+(rowbase+q0+wid*QBLK)*PO;
  { bf16*stg=(bf16*)(shm+dfa::DOST)+wid*4096;
    #pragma unroll
    for(int r=0;r<16;++r){const int orow=crow(r,hi);
      #pragma unroll
      for(int d0=0;d0<4;++d0)stg[orow*128+d0*32+r32]=__float2bfloat16(o[d0][r]*rli[r]);}
    asm volatile("s_waitcnt lgkmcnt(0)":::"memory");
    #pragma unroll
    for(int i=0;i<8;++i){const int idx=i*64+lane,row=idx>>4,ch=idx&15; const u32x4 v=*(const u32x4*)(stg+row*128+ch*8); ATTN_STORE16(Ow+(long)row*PO+ch*8,v);} }
  asm volatile("s_waitcnt lgkmcnt(0)\n\ts_barrier":::"memory");
  #undef DFA_DMA
}

namespace dfb { constexpr int NS=5, DK=0, DV=NS*8192, DWS=DV+NS*16384, DOST=0, BYTES=DWS+2048; }
template<int THR> __device__ __forceinline__ void diff_unit2(int b,int qb,const bf16*Q,const bf16*__restrict__ K,const bf16*__restrict__ V,bf16*O,char*shm){
  int tid_=threadIdx.x; asm volatile("":"+v"(tid_)); const int tid=tid_,lane=tid&63,r32=lane&31,hi=lane>>5; const int wid=__builtin_amdgcn_readfirstlane(tid>>6);
  const long rowbase=(long)b*SEQ; const int q0=qb*QB;
  const bf16*Qw=Q+(rowbase+q0+wid*QBLK)*PQ;
  const bf16*Kh=K+rowbase*PQ,*Vh=V+rowbase*PQ;
  const unsigned lds0=(unsigned)(uintptr_t)shm;
  float*wsf=(float*)(shm+dfb::DWS)+wid*64;
  const bf16*ksrc=Kh+(long)lane*PQ+wid*8;
  const bf16*vsrc=Vh+(long)(16*(wid&3)+(lane>>2))*PQ+(wid>>2)*32+(lane&3)*8;
  const unsigned kdst=lds0+dfb::DK+wid*1024, vdst=lds0+dfb::DV+wid*1024;
  #define DFB_DMA(t,s_) do{ glds16(ksrc+(long)(t)*KVBLK*PQ,(unsigned)__builtin_amdgcn_readfirstlane(kdst+s_*8192)); \
      glds16(vsrc+(long)(t)*KVBLK*PQ,(unsigned)__builtin_amdgcn_readfirstlane(vdst+s_*16384)); glds16(vsrc+(long)(t)*KVBLK*PQ+64,(unsigned)__builtin_amdgcn_readfirstlane(vdst+s_*16384+8192)); }while(0)
  const int vb0=(int)(lds0+dfb::DV)+((lane>>4)&1)*32+(lane&3)*8+(4*hi+((lane&15)>>2))*64;
  const int NT=(q0+QB)/KVBLK, tlast=NT-4+(wid>>1);
  const lds_cptr kp0=(lds_cptr)shm+dfb::DK+hi*1024+r32*16;
  DFB_DMA(0,0); DFB_DMA(1,1); DFB_DMA(2,2);
  bf16x8 qr[4];
  #pragma unroll
  for(int d0=0;d0<4;++d0)qr[d0]=*reinterpret_cast<const bf16x8*>(&Qw[(long)r32*PQ+d0*16+hi*8]);
  asm volatile("":"+v"(qr[0]),"+v"(qr[1]),"+v"(qr[2]),"+v"(qr[3]));
  float l_reg=0.f; f32x16 o[4]; o[0]=f32x16{}; o[1]=f32x16{}; o[2]=f32x16{}; o[3]=f32x16{}; f32x16 negm=f32x16{};
  f32x16 s0,s1;
  u32x4 pw0,pw1,pw2,pw3;
  #define DFB_SOFTMAX() do{ float sacc=0.f; _Pragma("unroll") for(int r=0;r<16;++r){s0[r]=__builtin_amdgcn_exp2f(s0[r]);s1[r]=__builtin_amdgcn_exp2f(s1[r]);sacc+=s0[r]+s1[r];} l_reg+=sacc; \
      pw0=(u32x4){cvtpk_s(s0[0],s0[1]),cvtpk_s(s0[2],s0[3]),cvtpk_s(s0[4],s0[5]),cvtpk_s(s0[6],s0[7])}; \
      pw1=(u32x4){cvtpk_s(s0[8],s0[9]),cvtpk_s(s0[10],s0[11]),cvtpk_s(s0[12],s0[13]),cvtpk_s(s0[14],s0[15])}; \
      pw2=(u32x4){cvtpk_s(s1[0],s1[1]),cvtpk_s(s1[2],s1[3]),cvtpk_s(s1[4],s1[5]),cvtpk_s(s1[6],s1[7])}; \
      pw3=(u32x4){cvtpk_s(s1[8],s1[9]),cvtpk_s(s1[10],s1[11]),cvtpk_s(s1[12],s1[13]),cvtpk_s(s1[14],s1[15])}; }while(0)
  #define DFB_PV(sv) do{ const int vbt=vb0+(sv)*16384; \
      pv(o,vbt,__builtin_bit_cast(bf16x8,pw0),__builtin_bit_cast(bf16x8,pw1),__builtin_bit_cast(bf16x8,pw2),__builtin_bit_cast(bf16x8,pw3)); \
      pv(o+2,vbt+8192,__builtin_bit_cast(bf16x8,pw0),__builtin_bit_cast(bf16x8,pw1),__builtin_bit_cast(bf16x8,pw2),__builtin_bit_cast(bf16x8,pw3)); }while(0)
  #define DFB_REF(FIRST) do{ float rm=s0[0]; _Pragma("unroll") for(int r=0;r<16;++r){rm=__builtin_fmaxf(rm,s0[r]);rm=__builtin_fmaxf(rm,s1[r]);} \
      { auto rr=__builtin_amdgcn_permlane32_swap(__float_as_uint(rm),__float_as_uint(rm),false,false); rm=__builtin_fmaxf(__uint_as_float(rr[0]),__uint_as_float(rr[1])); } \
      if((FIRST)||__any(rm>(float)THR)){ const float dl=(FIRST)?rm:__builtin_fmaxf(rm,0.f); \
        _Pragma("unroll") for(int r=0;r<16;++r){s0[r]-=dl;s1[r]-=dl;negm[r]-=dl;} \
        if(!(FIRST)){ const float f=__builtin_amdgcn_exp2f(-dl); l_reg*=f; if(hi==0)wsf[r32]=f; asm volatile("s_waitcnt lgkmcnt(0)":::"memory"); \
          _Pragma("unroll") for(int r=0;r<16;++r){const float fr_=wsf[crow(r,hi)]; o[0][r]*=fr_; o[1][r]*=fr_; o[2][r]*=fr_; o[3][r]*=fr_;} } } }while(0)
  WAIT_BAR(6); DFB_DMA(3,3);
  qkt(s0,s1,shm+dfb::DK,qr,negm,r32,hi);
  DFB_REF(true);
  int sc=1,sp=0,sn=4;
  for(int t=1;t<NT;++t){
    if(t+2<NT){WAIT_BAR(6);}else if(t+1<NT){WAIT_BAR(3);}else{WAIT_BAR(0);}
    if(t+3<NT){DFB_DMA(t+3,sn);}
    if(t<=tlast+1){
      DFB_SOFTMAX(); SBAR();
      if(t<=tlast){ qkt(s0,s1,shm+dfb::DK+sc*8192,qr,negm,r32,hi); SBAR(); }
      DFB_PV(sp); SBAR();
      if(t<=tlast){ DFB_REF(false); }
    }
    sp=sc; sc=(sc==4)?0:sc+1; sn=(sn==4)?0:sn+1;
  }
  if(tlast==NT-1){ DFB_SOFTMAX(); SBAR(); DFB_PV(sp); }
  asm volatile("s_waitcnt lgkmcnt(0)\n\ts_barrier":::"memory");
  {auto rr=__builtin_amdgcn_permlane32_swap(__float_as_uint(l_reg),__float_as_uint(l_reg),false,false);l_reg=__uint_as_float(rr[0])+__uint_as_float(rr[1]);}
  if(hi==0)wsf[32+r32]=l_reg;asm volatile("s_waitcnt lgkmcnt(0)":::"memory");
  float rli[16];
  #pragma unroll
  for(int r=0;r<16;++r)rli[r]=__builtin_amdgcn_rcpf(wsf[32+crow(r,hi)]);
  bf16*Ow=O+(rowbase+q0+wid*QBLK)*PO;
  { bf16*stg=(bf16*)(shm+dfb::DOST)+wid*4096;
    #pragma unroll
    for(int r=0;r<16;++r){const int orow=crow(r,hi);
      #pragma unroll
      for(int d0=0;d0<4;++d0)stg[orow*128+d0*32+r32]=__float2bfloat16(o[d0][r]*rli[r]);}
    asm volatile("s_waitcnt lgkmcnt(0)":::"memory");
    #pragma unroll
    for(int i=0;i<8;++i){const int idx=i*64+lane,row=idx>>4,ch=idx&15; const u32x4 v=*(const u32x4*)(stg+row*128+ch*8); ATTN_STORE16(Ow+(long)row*PO+ch*8,v);} }
  asm volatile("s_waitcnt lgkmcnt(0)\n\ts_barrier":::"memory");
  #undef DFB_DMA
  #undef DFB_SOFTMAX
  #undef DFB_PV
  #undef DFB_REF
}
constexpr int LDS_BIAS=LDS_BYTES;
__device__ __forceinline__ void band_unit(int b,int h,int qb,const bf16*Q,const bf16*__restrict__ K,const bf16*__restrict__ V,bf16*O,const float*__restrict__ relb,char*shm){
  int tid_=threadIdx.x; asm volatile("":"+v"(tid_)); const int tid=tid_,lane=tid&63,r32=lane&31,hi=lane>>5; const int wid=__builtin_amdgcn_readfirstlane(tid>>6);
  const long rowbase=(long)b*SEQ; const int q0=qb*QB;
  const bf16*Qw=Q+(rowbase+q0+wid*QBLK)*PQ;
  const bf16*Kh=K+rowbase*PQ,*Vh=V+rowbase*PQ;
  const unsigned lds0=(unsigned)(uintptr_t)shm;
  float*wsf=(float*)(shm+LDS_WS)+wid*64;
  float*biasL=(float*)(shm+LDS_BIAS);
  for(int i=tid;i<640;i+=512)biasL[i]=relb[h*513+(i<512?i:512)]*1.4426950408889634f;
  const bf16*ksrc=Kh+(long)lane*PQ+wid*8;
  const bf16*vsrc=Vh+(long)(16*(wid&3)+(lane>>2))*PQ+(wid>>2)*32+(lane&3)*8;
  const unsigned kdst=lds0+LDS_K+wid*1024, vdst=lds0+LDS_V+wid*1024;
  #define DMA_K(t,slot) glds16(ksrc+(long)(t)*KVBLK*PQ,(unsigned)__builtin_amdgcn_readfirstlane(kdst+(slot)))
  #define DMA_V(t,slot) glds16(vsrc+(long)(t)*KVBLK*PQ,(unsigned)__builtin_amdgcn_readfirstlane(vdst+(slot)))
  const int vb0=(int)(lds0+LDS_V)+((lane>>4)&1)*32+(lane&3)*8+(4*hi+((lane&15)>>2))*64;
  const char*Kbase=shm+LDS_K;
  const int c0=q0/KVBLK, cw=c0+(wid>>1);
  const int tlo=(c0<8)?0:c0-8, thi=c0+3;
  bf16x8 qr[4];
  #pragma unroll
  for(int d0=0;d0<4;++d0)qr[d0]=*reinterpret_cast<const bf16x8*>(&Qw[(long)r32*PQ+d0*16+hi*8]);
  asm volatile("":"+v"(qr[0]),"+v"(qr[1]),"+v"(qr[2]),"+v"(qr[3]));
  float m_run=-INFINITY,l_reg=0.f; f32x16 o[2]; o[0]=f32x16{}; o[1]=f32x16{}; const f32x16 zero=f32x16{};
  const int qabs=q0+wid*QBLK+r32;
  DMA_K(tlo,0);DMA_V(tlo,0);
  int sl=0;
  for(int t=tlo;t<=thi;++t){
    if(t<thi){DMA_K(t+1,sl^SLOTB);DMA_V(t+1,sl^SLOTB);WAIT_BAR(2);}else{WAIT_BAR(0);}
    if(t>=cw-8&&t<=cw){
      f32x16 p0,p1; qkt(p0,p1,Kbase+sl,qr,zero,r32,hi);
      if(cw-t>=5){ const float bc=biasL[512];
        #pragma unroll
        for(int r=0;r<16;++r){p0[r]+=bc;p1[r]+=bc;} }
      else{ const float*bp=biasL+(qabs-(t*KVBLK+4*hi)+256);
        #pragma unroll
        for(int r=0;r<16;++r){ p0[r]+=bp[-((r&3)+8*(r>>2))]; p1[r]+=bp[-((r&3)+8*(r>>2))-32]; } }
      float rm=p0[0];
      #pragma unroll
      for(int r=0;r<16;++r){rm=__builtin_fmaxf(rm,p0[r]);rm=__builtin_fmaxf(rm,p1[r]);}
      { auto rr=__builtin_amdgcn_permlane32_swap(__float_as_uint(rm),__float_as_uint(rm),false,false); rm=__builtin_fmaxf(__uint_as_float(rr[0]),__uint_as_float(rr[1])); }
      const float mn=__builtin_fmaxf(m_run,rm); const float f=__builtin_amdgcn_exp2f(m_run-mn); m_run=mn;
      float sacc=0.f;
      #pragma unroll
      for(int r=0;r<16;++r){p0[r]=__builtin_amdgcn_exp2f(p0[r]-mn);p1[r]=__builtin_amdgcn_exp2f(p1[r]-mn);sacc+=p0[r]+p1[r];}
      l_reg=l_reg*f+sacc;
      if(__any(f!=1.0f)){
      if(hi==0)wsf[r32]=f;
      asm volatile("s_waitcnt lgkmcnt(0)":::"memory");
      #pragma unroll
      for(int r=0;r<16;++r){const float fr_=wsf[crow(r,hi)]; o[0][r]*=fr_; o[1][r]*=fr_;} }
      u32x4 pw0,pw1,pw2,pw3;
      pw0=(u32x4){cvtpk_s(p0[0],p0[1]),cvtpk_s(p0[2],p0[3]),cvtpk_s(p0[4],p0[5]),cvtpk_s(p0[6],p0[7])};
      pw1=(u32x4){cvtpk_s(p0[8],p0[9]),cvtpk_s(p0[10],p0[11]),cvtpk_s(p0[12],p0[13]),cvtpk_s(p0[14],p0[15])};
      pw2=(u32x4){cvtpk_s(p1[0],p1[1]),cvtpk_s(p1[2],p1[3]),cvtpk_s(p1[4],p1[5]),cvtpk_s(p1[6],p1[7])};
      pw3=(u32x4){cvtpk_s(p1[8],p1[9]),cvtpk_s(p1[10],p1[11]),cvtpk_s(p1[12],p1[13]),cvtpk_s(p1[14],p1[15])};
      SBAR(); pv(o,vb0+sl,__builtin_bit_cast(bf16x8,pw0),__builtin_bit_cast(bf16x8,pw1),__builtin_bit_cast(bf16x8,pw2),__builtin_bit_cast(bf16x8,pw3));
    }
    asm volatile("s_waitcnt lgkmcnt(0)\n\ts_barrier":::"memory");
    sl^=SLOTB;
  }
  {auto rr=__builtin_amdgcn_permlane32_swap(__float_as_uint(l_reg),__float_as_uint(l_reg),false,false);l_reg=__uint_as_float(rr[0])+__uint_as_float(rr[1]);}
  if(hi==0)wsf[32+r32]=l_reg;asm volatile("s_waitcnt lgkmcnt(0)":::"memory");
  float rli[16];
  #pragma unroll
  for(int r=0;r<16;++r)rli[r]=__builtin_amdgcn_rcpf(wsf[32+crow(r,hi)]);
  bf16*Ow=O+(rowbase+q0+wid*QBLK)*PO;
  { bf16*stg=(bf16*)(shm+LDS_OST)+wid*2048;
    #pragma unroll
    for(int r=0;r<16;++r){const int orow=crow(r,hi);
      #pragma unroll
      for(int d0=0;d0<2;++d0)stg[orow*64+d0*32+r32]=__float2bfloat16(o[d0][r]*rli[r]);}
    asm volatile("s_waitcnt lgkmcnt(0)":::"memory");
    #pragma unroll
    for(int i=0;i<4;++i){const int row=i*8+(lane>>3),ch=lane&7; const u32x4 v=*(const u32x4*)(stg+row*64+ch*8); ATTN_STORE16(Ow+(long)row*PO+ch*8,v);} }
  asm volatile("s_waitcnt lgkmcnt(0)\n\ts_barrier":::"memory");
  #undef DMA_K
  #undef DMA_V
}
constexpr int ATTN_LDS_BYTES=LDS_BYTES+2560;
#undef SBAR
#undef WAIT_BAR
}


#define CFG_ONE_LAUNCH 1
#define CFG_ATTN 2
#define CFG_BAND 1
#define PROBE_REP_MASK 0x0

#define LAS __attribute__((address_space(3)))
__device__ __forceinline__ void p0_transpose_item(const float* W, int K, int N, bf16_t* WT, LAS float* scr, int item, int lane, bool up_il, const float* gain) {
    const int nblk = N / 32, kb = item / nblk, nb = item % nblk, k0 = 64 * kb, n0 = 32 * nb;
    const int rb = !up_il ? n0 : (n0 < DFF ? (n0 >> 7) * 256 + (n0 & 127) : ((n0 - DFF) >> 7) * 256 + 128 + ((n0 - DFF) & 127));
#pragma unroll 8
    for (int i = 0; i < 32; ++i) { const int kk = 2 * i + (lane >> 5); const float gk = gain ? gain[k0 + kk] : 1.0f; scr[kk * 33 + (lane & 31)] = W[(size_t)(k0 + kk) * N + n0 + (lane & 31)] * gk; }
    asm volatile("s_waitcnt lgkmcnt(0)" ::: "memory");
    const int c = lane & 7;
#pragma unroll
    for (int j = 0; j < 4; ++j) { const int n = (lane >> 3) + 8 * j; const LAS float* s = scr + (8 * c) * 33 + n;
        u32x4 o; o.x = cvtpk(s[0 * 33], s[1 * 33]); o.y = cvtpk(s[2 * 33], s[3 * 33]); o.z = cvtpk(s[4 * 33], s[5 * 33]); o.w = cvtpk(s[6 * 33], s[7 * 33]);
        *(u32x4*)(WT + (size_t)(rb + n) * K + k0 + 8 * c) = o; }
    asm volatile("s_waitcnt lgkmcnt(0)" ::: "memory");
}
__device__ __forceinline__ void transpose_phase(const Args& a, unsigned char* ws, LAS unsigned char* lds, int gw, int NGW, int wave, int lane) {
    LAS float* scr = (LAS float*)(lds + wave * 16384);
    constexpr int I_IN = (DM / 64) * (INW / 32), I_OUT = (DM / 64) * (DM / 32), I_UP = (DM / 64) * (UPW / 32), I_DN = (DFF / 64) * (DM / 32), I_L = I_IN + I_OUT + I_UP + I_DN;
    for (int it = gw; it < DEPTH * I_L; it += NGW) {
        const int l = it / I_L; int r = it % I_L; unsigned char* wl = ws + WS_W + (size_t)l * W_LAYER;
        if (r < I_IN) { p0_transpose_item(a.in[2] + (size_t)l * DM * INW, DM, INW, (bf16_t*)(wl + W_IN), scr, r, lane, false, a.in[1] + (size_t)l * DM); continue; } r -= I_IN;
        if (r < I_OUT) { p0_transpose_item(a.in[11] + (size_t)l * DM * DM, DM, DM, (bf16_t*)(wl + W_OUT), scr, r, lane, false, nullptr); continue; } r -= I_OUT;
        if (r < I_UP) { p0_transpose_item(a.in[13] + (size_t)l * DM * UPW, DM, UPW, (bf16_t*)(wl + W_UP), scr, r, lane, true, a.in[12] + (size_t)l * DM); continue; } r -= I_UP;
        p0_transpose_item(a.in[16] + (size_t)l * DFF * DM, DFF, DM, (bf16_t*)(wl + W_DOWN), scr, r, lane, false, nullptr);
    }
}

__device__ __forceinline__ void n_diff_item(const bf16_t* PROJ, bf16_t* AO, int chunk, int vh, int lane) {
    const int h = vh >> 2, m = (vh >> 1) & 1, e = vh & 1;
    const int t = chunk * 64 + lane, b = t / SEQ, kbeg = b * SEQ, kend = (chunk + 1) * 64;
    float q[64], o[64];
    { const u32x4* qp = (const u32x4*)(PROJ + (size_t)t * INW + h * 128 + m * 64);
#pragma unroll
      for (int i = 0; i < 8; ++i) { const u32x4 w = qp[i];
#pragma unroll
          for (int c = 0; c < 4; ++c) { q[i * 8 + 2 * c] = bflo(w[c]); q[i * 8 + 2 * c + 1] = bfhi(w[c]); } } }
#pragma unroll
    for (int d = 0; d < 64; ++d) o[d] = 0.f;
    float mx = -INFINITY, lsum = 0.f;
    for (int k = kbeg; k < kend; ++k) {
        const u32x4* kp = (const u32x4*)(PROJ + (size_t)k * INW + COL_KA + h * 128 + m * 64);
        const u32x4* vp = (const u32x4*)(PROJ + (size_t)k * INW + COL_VA + h * 128 + e * 64);
        float s = 0.f;
#pragma unroll
        for (int i = 0; i < 8; ++i) { const u32x4 w = kp[i];
#pragma unroll
            for (int c = 0; c < 4; ++c) { s += q[i * 8 + 2 * c] * bflo(w[c]); s += q[i * 8 + 2 * c + 1] * bfhi(w[c]); } }
        const float mn = fmaxf(mx, s), f = exp2f(mx - mn), p = exp2f(s - mn);
        lsum = lsum * f + p; mx = mn;
#pragma unroll
        for (int i = 0; i < 8; ++i) { const u32x4 w = vp[i];
#pragma unroll
            for (int c = 0; c < 4; ++c) { o[i * 8 + 2 * c] = o[i * 8 + 2 * c] * f + p * bflo(w[c]); o[i * 8 + 2 * c + 1] = o[i * 8 + 2 * c + 1] * f + p * bfhi(w[c]); } }
    }
    const float inv = 1.0f / lsum;
    u32x4* op = (u32x4*)(AO + (size_t)t * 1024 + vh * 64);
#pragma unroll
    for (int i = 0; i < 8; ++i) { u32x4 w;
#pragma unroll
        for (int c = 0; c < 4; ++c) w[c] = cvtpk(o[i * 8 + 2 * c] * inv, o[i * 8 + 2 * c + 1] * inv);
        op[i] = w; }
}
__device__ __forceinline__ void n_band_item(const bf16_t* PROJ, const float* relb, bf16_t* MIX, int chunk, int h, int lane) {
    const int t = chunk * 64 + lane, b = t / SEQ, cin = chunk % (SEQ / 64);
    const float* rb = relb + h * 513;
    float q[64], o[64];
    { const u32x4* qp = (const u32x4*)(PROJ + (size_t)t * INW + COL_QC + h * 64);
#pragma unroll
      for (int i = 0; i < 8; ++i) { const u32x4 w = qp[i];
#pragma unroll
          for (int c = 0; c < 4; ++c) { q[i * 8 + 2 * c] = bflo(w[c]); q[i * 8 + 2 * c + 1] = bfhi(w[c]); } } }
#pragma unroll
    for (int d = 0; d < 64; ++d) o[d] = 0.f;
    float mx = -INFINITY, lsum = 0.f;
    for (int j = 0; j < 9; ++j) {
        const int kc = cin - 8 + j; if (kc < 0) continue;
        for (int kk = 0; kk < 64; ++kk) {
            const int k = b * SEQ + kc * 64 + kk;
            int rel = t - k; rel = rel < -256 ? -256 : (rel > 256 ? 256 : rel);
            const u32x4* kp = (const u32x4*)(PROJ + (size_t)k * INW + COL_KC + h * 64);
            const u32x4* vp = (const u32x4*)(PROJ + (size_t)k * INW + COL_VC + h * 64);
            float s = rb[rel + 256] * LOG2E;
#pragma unroll
            for (int i = 0; i < 8; ++i) { const u32x4 w = kp[i];
#pragma unroll
                for (int c = 0; c < 4; ++c) { s += q[i * 8 + 2 * c] * bflo(w[c]); s += q[i * 8 + 2 * c + 1] * bfhi(w[c]); } }
            const float mn = fmaxf(mx, s), f = exp2f(mx - mn), p = exp2f(s - mn);
            lsum = lsum * f + p; mx = mn;
#pragma unroll
            for (int i = 0; i < 8; ++i) { const u32x4 w = vp[i];
#pragma unroll
                for (int c = 0; c < 4; ++c) { o[i * 8 + 2 * c] = o[i * 8 + 2 * c] * f + p * bflo(w[c]); o[i * 8 + 2 * c + 1] = o[i * 8 + 2 * c + 1] * f + p * bfhi(w[c]); } }
        }
    }
    const float inv = 1.0f / lsum;
    u32x4* op = (u32x4*)(MIX + (size_t)t * 1024 + 768 + h * 64);
#pragma unroll
    for (int i = 0; i < 8; ++i) { u32x4 w;
#pragma unroll
        for (int c = 0; c < 4; ++c) w[c] = cvtpk(o[i * 8 + 2 * c] * inv, o[i * 8 + 2 * c + 1] * inv);
        op[i] = w; }
}


__device__ __forceinline__ void convfix_rows(const Args& a, int l, unsigned char* ws, int pm, int tid) {
    const float* cw = a.in[14] + (size_t)l * 3 * DFF; const float* cb = a.in[15] + (size_t)l * DFF;
    const float* HA = (const float*)(ws + WS_HEADA); const float* HG = (const float*)(ws + WS_HEADG); const float* HL = (const float*)(ws + WS_HALO); bf16_t* ACT = (bf16_t*)(ws + WS_ACT);
    for (int i = tid; i < 4 * DFF; i += 512) { const int b4 = i / DFF, c = i % DFF, blk = pm * 4 + b4;
        const float a0 = HA[((size_t)blk * 2) * DFF + c], a1 = HA[((size_t)blk * 2 + 1) * DFF + c], g0 = HG[((size_t)blk * 2) * DFF + c], g1 = HG[((size_t)blk * 2 + 1) * DFF + c];
        float h0 = 0.f, h1 = 0.f; if ((blk % (SEQ / 64)) != 0) { h0 = HL[((size_t)(blk - 1) * 2) * DFF + c]; h1 = HL[((size_t)(blk - 1) * 2 + 1) * DFF + c]; }
        const float w0 = cw[c], w1 = cw[DFF + c], w2 = cw[2 * DFF + c], bb = cb[c];
        const float x0 = bb + w0 * h0 + w1 * h1 + w2 * a0, x1 = bb + w0 * h1 + w1 * a0 + w2 * a1;
        const float y0 = x0 * __builtin_amdgcn_rcpf(1.0f + __expf(-x0)) * g0, y1 = x1 * __builtin_amdgcn_rcpf(1.0f + __expf(-x1)) * g1;
        ACT[(size_t)(blk * 64) * DFF + c] = (bf16_t)(cvtpk(y0, 0.f) & 0xffffu); ACT[(size_t)(blk * 64 + 1) * DFF + c] = (bf16_t)(cvtpk(y1, 0.f) & 0xffffu); }
}
#define XB_TMO      128
#define XB_XCNT(j)  (256  + 64 * (j))
#define XB_XSUB(j)  (1280 + 64 * (j))
#define XB_XGEN(j)  (2304 + 64 * (j))
#define XB_TOP      3328
#define XB_TOPGEN   3392
#define XCD_BAR_WORDS 3456
#define XB_SPIN_CAP (1u << 18)

__device__ __forceinline__ unsigned xb_ld(unsigned* p)              { return __hip_atomic_load(p, __ATOMIC_RELAXED, __HIP_MEMORY_SCOPE_AGENT); }
__device__ __forceinline__ unsigned xb_add(unsigned* p, unsigned v) { return __hip_atomic_fetch_add(p, v, __ATOMIC_RELAXED, __HIP_MEMORY_SCOPE_AGENT); }
__device__ __forceinline__ unsigned xb_xcc_id() { return (unsigned)__builtin_amdgcn_s_getreg((3 << 11) | 20) & 0xFu; }
#define XB_SPIN(cond, bar) do { unsigned _sp = 0; while (cond) { \
    if ((++_sp & 255u) == 0u) { if (xb_ld(&(bar)[XB_TMO])) break; if (_sp > XB_SPIN_CAP) { atomicAdd(&(bar)[XB_TMO], 1u); break; } } } } while (0)

struct XcdBarrier {
    unsigned* bar; unsigned x;
    volatile LAS unsigned* st;
};

__device__ __forceinline__ XcdBarrier xcd_barrier_post(unsigned* bar, volatile LAS unsigned* st) {
    XcdBarrier b; b.bar = bar; b.x = xb_xcc_id(); b.st = st;
    if (threadIdx.x == 0) (void)xb_add(&bar[XB_XCNT(b.x)], 1u);
    return b;
}
__device__ __forceinline__ void xcd_barrier_complete(unsigned* bar, unsigned x, unsigned& nloc, unsigned& nx) {
    const unsigned G = gridDim.x * gridDim.y * gridDim.z;
    unsigned sum, cnt, mine, sp = 0u;
    for (;;) {
        sum = 0u; cnt = 0u; mine = 0u;
#pragma unroll
        for (unsigned j = 0; j < 16; ++j) { const unsigned c = xb_ld(&bar[XB_XCNT(j)]); sum += c; cnt += (c > 0u) ? 1u : 0u; mine = (j == x) ? c : mine; }
        if (sum == G) break;
        __builtin_amdgcn_s_sleep(1);
        if ((++sp & 255u) == 0u) { if (xb_ld(&bar[XB_TMO])) break; if (sp > XB_SPIN_CAP) { atomicAdd(&bar[XB_TMO], 1u); break; } }
    }
    nloc = mine > 0u ? mine : 1u; nx = cnt > 0u ? cnt : 1u;
}

__device__ __forceinline__ void xcd_barrier(const XcdBarrier& b) {
    asm volatile("s_waitcnt vmcnt(0)" ::: "memory");
    __syncthreads();
    if (threadIdx.x == 0) {
        unsigned* bar = b.bar;
        __builtin_amdgcn_s_waitcnt(0);
        unsigned nloc = b.st[0], nx = b.st[1];
        if (nloc == 0u) { xcd_barrier_complete(bar, b.x, nloc, nx); b.st[0] = nloc; b.st[1] = nx; }
        const unsigned old = xb_add(&bar[XB_XSUB(b.x)], 1u);
        const unsigned gen = old / nloc;
        if (old + 1u == (gen + 1u) * nloc) {
            __builtin_amdgcn_fence(__ATOMIC_RELEASE, "agent");
            asm volatile("s_waitcnt vmcnt(0)" ::: "memory");
            const unsigned og = xb_add(&bar[XB_TOP], 1u);
            const unsigned tg = og / nx;
            if (og + 1u == (tg + 1u) * nx) xb_add(&bar[XB_TOPGEN], 1u);
            else XB_SPIN(xb_ld(&bar[XB_TOPGEN]) == tg, bar);
            __builtin_amdgcn_fence(__ATOMIC_ACQUIRE, "agent");
            xb_add(&bar[XB_XGEN(b.x)], 1u);
            asm volatile("s_waitcnt vmcnt(0)" ::: "memory");
        } else {
            XB_SPIN(xb_ld(&bar[XB_XGEN(b.x)]) == gen, bar);
            __builtin_amdgcn_fence(__ATOMIC_ACQUIRE, "agent");
            asm volatile("s_waitcnt vmcnt(0)" ::: "memory");
        }
    }
    __syncthreads();
}

constexpr int LDS_BYTES = 147456;
__device__ __forceinline__ bool phase_exists(int p) { if (p == 0 || p == PH_FINAL) return true; const int s = (p - 1) % 10; return s != 9 && s != 7; }
__device__ __forceinline__ bool sync_after(int p) { if (p == 0) return true; const int s = (p - 1) % 10; return !(s == 1 || s == 2); }
__global__ void __launch_bounds__(512, 2) mega(Args a) {
    extern __shared__ __attribute__((aligned(16))) unsigned char lds[];
    cg::grid_group grid = cg::this_grid();
    const int G = gridDim.x, blk = blockIdx.x;
    const int vcu = (G % 8 == 0) ? (blk % 8) * (G / 8) + blk / 8 : blk;
    const int NGW = G * 8, NT = G * 512;
    unsigned char* ws = a.ws;
    float* rowss = (float*)(ws + WS_ROWSS);
    bf16_t* XG = (bf16_t*)(ws + WS_XG); bf16_t* PROJ = (bf16_t*)(ws + WS_PROJ); bf16_t* AO = (bf16_t*)(ws + WS_AO); bf16_t* MIX = (bf16_t*)(ws + WS_MIX);
    LAS unsigned char* lds3 = (LAS unsigned char*)lds;
    volatile LAS unsigned* bst = (volatile LAS unsigned*)(lds3 + 131072 + 64);
    if (threadIdx.x < 2) bst[threadIdx.x] = 0u;
    unsigned* barw = (unsigned*)ws;
    if (a.ph_hi - a.ph_lo > 1 && blk == 0) for (int i = threadIdx.x; i < XCD_BAR_WORDS; i += 512) __hip_atomic_store(barw + i, 0u, __ATOMIC_RELAXED, __HIP_MEMORY_SCOPE_AGENT);
    __syncthreads();
    XcdBarrier bar; bar.bar = barw; bar.x = 0; bar.st = bst; bool posted = false;
    for (int p = a.ph_lo; p < a.ph_hi; ++p) {
        if (!phase_exists(p)) continue;
        const int nrep = (p != 0 && p != PH_FINAL && ((PROBE_REP_MASK >> ((p - 1) % 10)) & 1)) ? 2 : ((p == 0 && (PROBE_REP_MASK & 0x400)) ? 2 : 1);
        for (int rep = 0; rep < nrep; ++rep) {
        if (rep) __syncthreads();
        int tid = threadIdx.x; asm volatile("" : "+v"(tid));
        const int lane = tid & 63, wave = __builtin_amdgcn_readfirstlane(tid >> 6), gw = blk * 8 + wave, gtid = blk * 512 + tid;
        if (p == 0) { transpose_phase(a, ws, lds3, gw, NGW, wave, lane); norm0_phase(a.in[0], XG, rowss, gw, NGW, lane); }
        else if (p == PH_FINAL) { final_phase(a.out, XG, rowss + (size_t)8 * RSS, a.in[17], gw, NGW, lane); }
        else {
            const int l = (p - 1) / 10, s = (p - 1) % 10;
            unsigned char* wl = ws + WS_W + (size_t)l * W_LAYER;
            if (s == 0) {
                pg8::Gemm g{XG, (const bf16_t*)(wl + W_IN), M, INW, DM, DM}; pg8::StaticOrder S; S.init(M, INW, G, blk);
                pg8::EpiScale E{PROJ, INW, rowss + (size_t)(2 * l) * RSS, 1};
                pg8::gemm_phase<pg8::EpiScale, pg8::StaticOrder, true, true>(lds3, g, S, E);
            } else if (s == 1) {
#if CFG_ATTN == 2
                for (int i = vcu; i < 512; i += G) { const int r = i >> 8, v = i & 255, combo = v >> 4, sI = v & 15;
                    const int qb = (r == 0) ? sI : 31 - sI, b = combo >> 3, hm = combo & 7, h = hm >> 1, m = hm & 1;
                    attn_body::diff_unit2<8>(b, qb, (const attn_body::bf16*)(PROJ + h * 128 + m * 64), (const attn_body::bf16*)(PROJ + COL_KA + h * 128 + m * 64),
                                            (const attn_body::bf16*)(PROJ + COL_VA + h * 128), (attn_body::bf16*)(AO + h * 256 + m * 128), (char*)lds); }
#elif CFG_ATTN
                for (int i = vcu; i < 1024; i += G) { const int r = i >> 8, v = i & 255, bh = v >> 3, sI = v & 7;
                    const int qb = (r == 0) ? sI : (r == 1) ? 15 - sI : (r == 2) ? 16 + sI : 31 - sI;
                    const int b = bh >> 4, vh = bh & 15, h = vh >> 2, m = (vh >> 1) & 1, e = vh & 1;
                    attn_body::attn_unit<8>(b, qb, (const attn_body::bf16*)(PROJ + h * 128 + m * 64), (const attn_body::bf16*)(PROJ + COL_KA + h * 128 + m * 64),
                                            (const attn_body::bf16*)(PROJ + COL_VA + h * 128 + e * 64), (attn_body::bf16*)(AO + vh * 64), (char*)lds); }
#else
                for (int it = gw; it < 4096; it += NGW) n_diff_item(PROJ, AO, 255 - (it >> 4), it & 15, lane);
#endif
                __syncthreads();
            } else if (s == 2) {
#if CFG_BAND
                for (int i = vcu; i < 256; i += G) { const int b = i >> 7, h = (i >> 5) & 3, qb = i & 31;
                    attn_body::band_unit(b, h, qb, (const attn_body::bf16*)(PROJ + COL_QC + h * 64), (const attn_body::bf16*)(PROJ + COL_KC + h * 64),
                                         (const attn_body::bf16*)(PROJ + COL_VC + h * 64), (attn_body::bf16*)(MIX + 768 + h * 64), a.in[10] + (size_t)l * 4 * 513, (char*)lds); }
#else
                for (int it = gw; it < 1024; it += NGW) n_band_item(PROJ, a.in[10] + (size_t)l * 4 * 513, MIX, it >> 2, it & 3, lane);
#endif
                __syncthreads();
            } else if (s == 3) pool_phase(a, l, PROJ, MIX, (float*)lds, blk, G, tid);
            else if (s == 4) combine_phase(a, l, AO, MIX, gw, NGW, lane);
            else if (s == 5) {
                pg8::Gemm g{MIX, (const bf16_t*)(wl + W_OUT), M, DM, DM, DM}; pg8::StaticOrder S; S.init(M, DM, G, blk);
                pg8::EpiResid E{XG, rowss + (size_t)(2 * l + 1) * RSS};
                pg8::gemm_phase<pg8::EpiResid, pg8::StaticOrder, true, true>(lds3, g, S, E);
            } else if (s == 6) {
                pg8::Gemm g{XG, (const bf16_t*)(wl + W_UP), M, UPW, DM, DM}; pg8::StaticOrder S; S.init(M, UPW, G, blk);
                pg8::EpiConvAct E{(bf16_t*)(ws + WS_ACT), rowss + (size_t)(2 * l + 1) * RSS, a.in[14] + (size_t)l * 3 * DFF, a.in[15] + (size_t)l * DFF, (float*)(ws + WS_HEADA), (float*)(ws + WS_HEADG), (float*)(ws + WS_HALO)};
                pg8::gemm_phase<pg8::EpiConvAct, pg8::StaticOrder, true, true>(lds3, g, S, E);
            }
            else if (s == 8) {
                pg8::Gemm g{(const bf16_t*)(ws + WS_ACT), (const bf16_t*)(wl + W_DOWN), M, DM, DFF, DFF}; pg8::StaticOrder S; S.init(M, DM, G, blk);
                { pg8::Unit u; for (int i = 0; S.next(i, u); ++i) convfix_rows(a, l, ws, u.pm, tid); }
                asm volatile("s_waitcnt vmcnt(0)" ::: "memory"); __syncthreads();
                pg8::EpiResid E{XG, rowss + (size_t)(2 * l + 2) * RSS};
                pg8::gemm_phase<pg8::EpiResid, pg8::StaticOrder, true, true>(lds3, g, S, E);
            }
        }
        }
        if (p + 1 < a.ph_hi) { if (sync_after(p)) { if (!posted) { grid.sync(); bar = xcd_barrier_post(barw, bst); posted = true; } else xcd_barrier(bar); } else __syncthreads(); }
    }
}

extern "C" void kernel_launch(void* const* d_in, const int* in_sizes, int n_in, void* d_out, int out_size, void* d_ws, size_t ws_size, hipStream_t stream) {
    static int grid = 0;
    if (grid == 0) {
        if (n_in != 18 || out_size != M * DM || ws_size < WS_END) { fprintf(stderr, "kernel_launch: unexpected shapes / workspace (n_in %d out %d ws %zu)\n", n_in, out_size, ws_size); grid = -1; return; }
        int dev = 0, cus = 0, per_cu = 0;
        (void)hipGetDevice(&dev); (void)hipDeviceGetAttribute(&cus, hipDeviceAttributeMultiprocessorCount, dev);
        if (hipFuncSetAttribute((const void*)mega, hipFuncAttributeMaxDynamicSharedMemorySize, LDS_BYTES) != hipSuccess) { fprintf(stderr, "hipFuncSetAttribute failed\n"); grid = -1; return; }
        if (hipOccupancyMaxActiveBlocksPerMultiprocessor(&per_cu, (const void*)mega, 512, LDS_BYTES) != hipSuccess || per_cu < 1) { fprintf(stderr, "occupancy query: %d\n", per_cu); per_cu = 1; }
        (void)hipGetLastError();
        grid = (cus > 0 ? cus : 256) * per_cu;
    }
    if (grid < 0) return;
    Args a{};
    for (int i = 0; i < 18; ++i) a.in[i] = (const float*)d_in[i];
    a.out = (float*)d_out; a.ws = (unsigned char*)d_ws;
    for (int l = 0; l < DEPTH; ++l) a.lam_init[l] = (float)(0.8 - 0.6 * exp(-0.3 * (double)l));
#if CFG_ONE_LAUNCH
    a.ph_lo = 0; a.ph_hi = PH_FINAL + 1;
    void* args[] = {&a};
    hipError_t e = hipLaunchCooperativeKernel((const void*)mega, dim3(grid), dim3(512), args, LDS_BYTES, stream);
    if (e != hipSuccess) fprintf(stderr, "cooperative launch failed: %s (grid %d)\n", hipGetErrorString(e), grid);
#else
    for (int p = 0; p <= PH_FINAL; ++p) { if (p != 0 && p != PH_FINAL && (((p - 1) % 10) == 9 || ((p - 1) % 10) == 7)) continue; a.ph_lo = p; a.ph_hi = p + 1; hipLaunchKernelGGL(mega, dim3(grid), dim3(512), LDS_BYTES, stream, a); }
#endif
}
```
